# Optimizing an MI355X kernel written in HIP

```python
import math
import jax, jax.numpy as jnp
from jax import lax
import numpy as np

D_MODEL = 2048
BATCH = 2
SEQ = 16384
DEPTH = 2

GRID_W = 64
CTX_LEN = 256
HEAD_DIM = 128
A_HEADS = D_MODEL // (2 * HEAD_DIM)
A_HALF = HEAD_DIM // 2
B_HEADS = D_MODEL // (2 * HEAD_DIM)
B_KV_HEADS = 2
B_GROUP = B_HEADS // B_KV_HEADS
WINDOW = 128
BLOCK = 128
ROPE_BASE = 10000.0
D_MIX = (A_HEADS + B_HEADS) * HEAD_DIM
Q_COLS = (A_HEADS + B_HEADS) * HEAD_DIM
KV_COLS = 2 * A_HEADS * HEAD_DIM + 2 * B_KV_HEADS * HEAD_DIM
KV_SPLITS = [A_HEADS * HEAD_DIM, 2 * A_HEADS * HEAD_DIM, 2 * A_HEADS * HEAD_DIM + B_KV_HEADS * HEAD_DIM]
IN_ATTN = Q_COLS + KV_COLS
HY_ORDER = 2
HY_EMB = 33
HY_FILTER_W = 64
HY_SHORT = 3
HY_DECAY_TARGET = 1e-2
HY_MAX_DECAY_PCT = 0.3
HY_MIN_DECAY_PCT = 1.5
D_FF = 5632
FFN_CONV = 3
EPS = 1e-6
NEG = -1e30

kernel_name = 'hybrid_diffattn_swa_hyena_dit'


def _rms(x, g):
    xf = x.astype(jnp.float32)
    y = xf * lax.rsqrt(jnp.mean(xf * xf, axis=-1, keepdims=True) + EPS)
    return (y * g.astype(jnp.float32)).astype(x.dtype)


def _dwconv(z, w, b):
    K = w.shape[0]
    pad = (K - 1) // 2
    L = z.shape[1]
    zp = jnp.pad(z, ((0, 0), (pad, pad), (0, 0)))
    out = zp[:, 0:L] * w[0] + b
    for k in range(1, K):
        out = out + zp[:, k:k + L] * w[k]
    return out


def _axial_rope_tables(L, dim):
    rows = L // GRID_W
    row = jnp.repeat(jnp.arange(rows, dtype=jnp.float32), GRID_W)
    col = jnp.tile(jnp.arange(GRID_W, dtype=jnp.float32), rows)
    n_f = dim // 4
    inv = ROPE_BASE ** (-jnp.arange(n_f, dtype=jnp.float32) / n_f)
    ang = jnp.stack([row[:, None] * inv, col[:, None] * inv], axis=1)
    return jnp.cos(ang), jnp.sin(ang)


def _apply_rope(x, cos, sin):
    shp = x.shape
    n_f = shp[-1] // 4
    xr = x.astype(jnp.float32).reshape(shp[:-1] + (2, 2, n_f))
    x1, x2 = xr[..., 0, :], xr[..., 1, :]
    bshape = (shp[1],) + (1,) * (x.ndim - 3) + (2, n_f)
    c = cos.reshape(bshape)
    s = sin.reshape(bshape)
    out = jnp.stack([x1 * c - x2 * s, x2 * c + x1 * s], axis=-2)
    return out.reshape(shp).astype(x.dtype)


def _q_heads(t):
    B_, n = t.shape[:2]
    qa, qb = jnp.split(t, [A_HEADS * HEAD_DIM], axis=-1)
    return (qa.reshape(B_, n, A_HEADS, 2, A_HALF),
            qb.reshape(B_, n, B_KV_HEADS, B_GROUP, HEAD_DIM))


def _kv_heads(t):
    B_, n = t.shape[:2]
    ka, va, kb, vb = jnp.split(t, KV_SPLITS, axis=-1)
    return (ka.reshape(B_, n, A_HEADS, 2, A_HALF), va.reshape(B_, n, A_HEADS, HEAD_DIM),
            kb.reshape(B_, n, B_KV_HEADS, HEAD_DIM), vb.reshape(B_, n, B_KV_HEADS, HEAD_DIM))


def _diff_softmax(q, k, v, lam):
    s = jnp.einsum('bqhmd,bkhmd->bhmqk', q, k, preferred_element_type=jnp.float32)
    p = jax.nn.softmax(s, axis=-1)
    w = p[:, :, 0] - lam * p[:, :, 1]
    return jnp.einsum('bhqk,bkhd->bqhd', w.astype(v.dtype), v)


def _diff_attn_blocks(q, k_all, v_all, lam):
    B_, L = q.shape[:2]
    nb = L // BLOCK
    qblocks = jnp.moveaxis(q.reshape((B_, nb, BLOCK) + q.shape[2:]), 1, 0)
    out = lax.map(lambda qi: _diff_softmax(qi, k_all, v_all, lam), qblocks)
    return jnp.moveaxis(out, 0, 1).reshape(B_, L, A_HEADS, HEAD_DIM)


def _sink_softmax(q, kc, vc, sink):
    s = jnp.einsum('bqgrd,bcgd->bgrqc', q, kc, preferred_element_type=jnp.float32)
    s_sink = jnp.broadcast_to(sink.astype(jnp.float32)[None, :, :, None, None], s.shape[:-1] + (1,))
    p = jax.nn.softmax(jnp.concatenate([s, s_sink], axis=-1), axis=-1)[..., :kc.shape[1]]
    return jnp.einsum('bgrqc,bcgd->bqgrd', p.astype(vc.dtype), vc)


def _window_attn_blocks(q, k, v, kc, vc, sink):
    B_, L = q.shape[:2]
    nb = L // BLOCK
    C = kc.shape[1]
    pad = ((0, 0), (BLOCK, BLOCK), (0, 0), (0, 0))
    kp = jnp.pad(k, pad)
    vp = jnp.pad(v, pad)
    qblocks = jnp.moveaxis(q.reshape((B_, nb, BLOCK) + q.shape[2:]), 1, 0)
    offs_q = jnp.arange(BLOCK)
    offs_k = jnp.arange(3 * BLOCK) - BLOCK

    def one(args):
        i, qi = args
        start = i * BLOCK
        kb = lax.dynamic_slice_in_dim(kp, start, 3 * BLOCK, axis=1)
        vb = lax.dynamic_slice_in_dim(vp, start, 3 * BLOCK, axis=1)
        qpos = start + offs_q
        kpos = start + offs_k
        valid = ((jnp.abs(kpos[None, :] - qpos[:, None]) <= WINDOW)
                 & (kpos >= 0)[None, :] & (kpos < L)[None, :])
        s_lat = jnp.where(valid, jnp.einsum('bqgrd,bkgd->bgrqk', qi, kb,
                                            preferred_element_type=jnp.float32), NEG)
        s_ctx = jnp.einsum('bqgrd,bcgd->bgrqc', qi, kc, preferred_element_type=jnp.float32)
        s_sink = jnp.broadcast_to(sink.astype(jnp.float32)[None, :, :, None, None], s_ctx.shape[:-1] + (1,))
        prob = jax.nn.softmax(jnp.concatenate([s_lat, s_ctx, s_sink], axis=-1), axis=-1)
        p_lat = prob[..., :3 * BLOCK].astype(v.dtype)
        p_ctx = prob[..., 3 * BLOCK:3 * BLOCK + C].astype(v.dtype)
        return (jnp.einsum('bgrqk,bkgd->bqgrd', p_lat, vb)
                + jnp.einsum('bgrqc,bcgd->bqgrd', p_ctx, vc))

    out = lax.map(one, (jnp.arange(nb), qblocks))
    return jnp.moveaxis(out, 0, 1).reshape(B_, L, B_HEADS, HEAD_DIM)


def _attn_mixer(h, hc, ctx_out, lam_init, w_in, w_out, a_q_g, a_k_g, lq1, lk1, lq2, lk2,
                a_sub_g, b_q_g, b_k_g, b_sink):
    B_, L, _ = h.shape
    f32 = jnp.float32
    lam = (jnp.exp(jnp.sum(lq1.astype(f32) * lk1.astype(f32)))
           - jnp.exp(jnp.sum(lq2.astype(f32) * lk2.astype(f32))) + lam_init)
    sink = b_sink.reshape(B_KV_HEADS, B_GROUP)
    cos_a, sin_a = _axial_rope_tables(L, A_HALF)
    cos_b, sin_b = _axial_rope_tables(L, HEAD_DIM)
    p = h @ w_in
    qa, qb = _q_heads(p[..., :Q_COLS])
    ka, va, kb, vb = _kv_heads(p[..., Q_COLS:])
    qa = _apply_rope(_rms(qa, a_q_g), cos_a, sin_a) * A_HALF ** -0.5
    ka = _apply_rope(_rms(ka, a_k_g), cos_a, sin_a)
    qb = _apply_rope(_rms(qb, b_q_g), cos_b, sin_b) * HEAD_DIM ** -0.5
    kb = _apply_rope(_rms(kb, b_k_g), cos_b, sin_b)
    pc = hc @ (w_in if ctx_out else w_in[:, Q_COLS:])
    kac, vac, kbc, vbc = _kv_heads(pc[..., -KV_COLS:])
    kac = _rms(kac, a_k_g)
    kbc = _rms(kbc, b_k_g)
    k_all = jnp.concatenate([kac, ka], axis=1)
    v_all = jnp.concatenate([vac, va], axis=1)
    oa = _rms(_diff_attn_blocks(qa, k_all, v_all, lam), a_sub_g) * (1.0 - lam_init)
    ob = _window_attn_blocks(qb, kb, vb, kbc, vbc, sink)
    y = jnp.concatenate([oa.reshape(B_, L, -1), ob.reshape(B_, L, -1)], axis=-1) @ w_out
    yc = None
    if ctx_out:
        C = hc.shape[1]
        qac, qbc = _q_heads(pc[..., :Q_COLS])
        qac = _rms(qac, a_q_g) * A_HALF ** -0.5
        qbc = _rms(qbc, b_q_g) * HEAD_DIM ** -0.5
        oac = _rms(_diff_softmax(qac, kac, vac, lam), a_sub_g) * (1.0 - lam_init)
        obc = _sink_softmax(qbc, kbc, vbc, sink)
        yc = jnp.concatenate([oac.reshape(B_, C, -1), obc.reshape(B_, C, -1)], axis=-1) @ w_out
    return y, yc


def _hyena_filters(L, f_w0, f_b0, f_w1, f_b1, f_w2, f_b2, f_freq, f_w3):
    f32 = jnp.float32
    t = jnp.linspace(0.0, 1.0, L, dtype=f32)[:, None]
    bands = (HY_EMB - 1) // 2
    w = 2.0 * math.pi * jnp.arange(L, dtype=f32)[:, None] / L
    f = jnp.linspace(1e-4, bands - 1, bands, dtype=f32)[None, :]
    z = jnp.concatenate([t, jnp.cos(f * w), -jnp.sin(f * w)], axis=-1)
    freq = f_freq.astype(f32)
    a = jnp.sin(freq * (z @ f_w0.astype(f32) + f_b0.astype(f32)))
    a = jnp.sin(freq * (a @ f_w1.astype(f32) + f_b1.astype(f32)))
    a = jnp.sin(freq * (a @ f_w2.astype(f32) + f_b2.astype(f32)))
    hf = (a @ f_w3.astype(f32)).reshape(L, HY_ORDER, 2, D_MODEL)
    max_decay = math.log(HY_DECAY_TARGET) / HY_MAX_DECAY_PCT
    min_decay = math.log(HY_DECAY_TARGET) / HY_MIN_DECAY_PCT
    deltas = jnp.linspace(min_decay, max_decay, D_MODEL, dtype=f32)
    decay = jnp.exp(-t * jnp.abs(deltas))
    return hf * decay[:, None, None, :]


def _bidir_long_conv(u, h_fwd, h_bwd, d_skip):
    L, D = u.shape[1], u.shape[2]
    filt = jnp.concatenate([h_fwd, jnp.zeros((1, D), h_fwd.dtype), h_bwd[:0:-1]], axis=0)
    filt = filt / jnp.sum(jnp.abs(filt), axis=0, keepdims=True)
    n = 2 * L
    uf = jnp.fft.rfft(u.astype(jnp.float32), n=n, axis=1)
    ff = jnp.fft.rfft(filt, n=n, axis=0)
    y = jnp.fft.irfft(uf * ff[None], n=n, axis=1)[:, :L]
    return (y + u.astype(jnp.float32) * d_skip.astype(jnp.float32)).astype(u.dtype)


def _hyena(h, w_in, b_in, sconv_w, sconv_b, f_w0, f_b0, f_w1, f_b1, f_w2, f_b2, f_freq, f_w3,
           d_skip, w_out):
    L = h.shape[1]
    z = _dwconv(h @ w_in + b_in, sconv_w, sconv_b)
    v, x1, x2 = jnp.split(z, 3, axis=-1)
    filt = _hyena_filters(L, f_w0, f_b0, f_w1, f_b1, f_w2, f_b2, f_freq, f_w3)
    y = v
    for o, gate in enumerate((x1, x2)):
        y = gate * _bidir_long_conv(y, filt[:, o, 0], filt[:, o, 1], d_skip[o])
    return y @ w_out


def _conv_ffn(h, w_gate, w_val, conv_w, conv_b, w_down):
    g = _dwconv(h @ w_gate, conv_w, conv_b)
    return (jax.nn.gelu(g) * (h @ w_val)) @ w_down


def _ctx_read_later(l):
    return any(j % 2 == 0 for j in range(l + 1, DEPTH))


def setup_inputs(seed: int = 0) -> dict:
    key = jax.random.key(seed)
    keys = iter(jax.random.split(key, 64))

    def nrm(shape, scale):
        return jax.random.normal(next(keys), shape, jnp.float32) * scale

    def gain(shape):
        return 1.0 + nrm(shape, 0.02)

    NA = (DEPTH + 1) // 2
    NH = DEPTH // 2
    D = D_MODEL
    return {
        'x': nrm((BATCH, SEQ, D), 1.0),
        'c': nrm((BATCH, D), 1.0),
        'ctx': nrm((BATCH, CTX_LEN, D), 1.0),
        'c_ctx': nrm((D,), 1.0),
        'ada_w': nrm((DEPTH, D, 6 * D), 0.5 * D ** -0.5),
        'ada_b': nrm((DEPTH, 6 * D), 0.02),
        'norm1_g': gain((DEPTH, D)),
        'norm2_g': gain((DEPTH, D)),
        'attn_w_in': nrm((NA, D, IN_ATTN), D ** -0.5),
        'attn_w_out': nrm((NA, D_MIX, D), D_MIX ** -0.5),
        'a_q_g': gain((NA, A_HALF)),
        'a_k_g': gain((NA, A_HALF)),
        'a_lam_q1': nrm((NA, A_HALF), 0.1),
        'a_lam_k1': nrm((NA, A_HALF), 0.1),
        'a_lam_q2': nrm((NA, A_HALF), 0.1),
        'a_lam_k2': nrm((NA, A_HALF), 0.1),
        'a_sub_g': gain((NA, HEAD_DIM)),
        'b_q_g': gain((NA, HEAD_DIM)),
        'b_k_g': gain((NA, HEAD_DIM)),
        'b_sink': nrm((NA, B_HEADS), 0.5),
        'hy_w_in': nrm((NH, D, 3 * D), D ** -0.5),
        'hy_b_in': nrm((NH, 3 * D), 0.02),
        'hy_sconv_w': nrm((NH, HY_SHORT, 3 * D), HY_SHORT ** -0.5),
        'hy_sconv_b': nrm((NH, 3 * D), 0.02),
        'hy_f_w0': nrm((NH, HY_EMB, HY_FILTER_W), HY_EMB ** -0.5),
        'hy_f_b0': nrm((NH, HY_FILTER_W), 0.02),
        'hy_f_w1': nrm((NH, HY_FILTER_W, HY_FILTER_W), HY_FILTER_W ** -0.5),
        'hy_f_b1': nrm((NH, HY_FILTER_W), 0.02),
        'hy_f_w2': nrm((NH, HY_FILTER_W, HY_FILTER_W), HY_FILTER_W ** -0.5),
        'hy_f_b2': nrm((NH, HY_FILTER_W), 0.02),
        'hy_f_freq': gain((NH, HY_FILTER_W)),
        'hy_f_w3': nrm((NH, HY_FILTER_W, HY_ORDER * 2 * D), HY_FILTER_W ** -0.5),
        'hy_d': nrm((NH, HY_ORDER, D), 0.5),
        'hy_w_out': nrm((NH, D, D), D ** -0.5),
        'ffn_w_gate': nrm((DEPTH, D, D_FF), D ** -0.5),
        'ffn_w_val': nrm((DEPTH, D, D_FF), D ** -0.5),
        'ffn_conv_w': nrm((DEPTH, FFN_CONV, D_FF), FFN_CONV ** -0.5),
        'ffn_conv_b': nrm((DEPTH, D_FF), 0.02),
        'ffn_w_down': nrm((DEPTH, D_FF, D), D_FF ** -0.5),
    }


def reference(x, c, ctx, c_ctx, ada_w, ada_b, norm1_g, norm2_g,
              attn_w_in, attn_w_out, a_q_g, a_k_g, a_lam_q1, a_lam_k1, a_lam_q2, a_lam_k2, a_sub_g,
              b_q_g, b_k_g, b_sink,
              hy_w_in, hy_b_in, hy_sconv_w, hy_sconv_b, hy_f_w0, hy_f_b0, hy_f_w1, hy_f_b1,
              hy_f_w2, hy_f_b2, hy_f_freq, hy_f_w3, hy_d, hy_w_out,
              ffn_w_gate, ffn_w_val, ffn_conv_w, ffn_conv_b, ffn_w_down):
    s_lat = jax.nn.silu(c)
    s_ctx = jax.nn.silu(c_ctx)
    xs, cs = x, ctx
    for l in range(DEPTH):
        ctx_out = _ctx_read_later(l)
        ctx_in = (l % 2 == 0) or ctx_out
        i = l // 2
        m = s_lat @ ada_w[l] + ada_b[l]
        sh1, sc1, g1, sh2, sc2, g2 = (t[:, None, :] for t in jnp.split(m, 6, axis=-1))
        h = _rms(xs, norm1_g[l]) * (1.0 + sc1) + sh1
        hc = None
        if ctx_in:
            mc = s_ctx @ ada_w[l] + ada_b[l]
            csh1, csc1, cg1, csh2, csc2, cg2 = jnp.split(mc, 6)
            hc = _rms(cs, norm1_g[l]) * (1.0 + csc1) + csh1
        if l % 2 == 0:
            y, yc = _attn_mixer(h, hc, ctx_out, 0.8 - 0.6 * math.exp(-0.3 * l),
                                attn_w_in[i], attn_w_out[i], a_q_g[i], a_k_g[i],
                                a_lam_q1[i], a_lam_k1[i], a_lam_q2[i], a_lam_k2[i], a_sub_g[i],
                                b_q_g[i], b_k_g[i], b_sink[i])
        else:
            hy = (hy_w_in[i], hy_b_in[i], hy_sconv_w[i], hy_sconv_b[i], hy_f_w0[i], hy_f_b0[i],
                  hy_f_w1[i], hy_f_b1[i], hy_f_w2[i], hy_f_b2[i], hy_f_freq[i], hy_f_w3[i],
                  hy_d[i], hy_w_out[i])
            y = _hyena(h, *hy)
            yc = _hyena(hc, *hy) if ctx_out else None
        xs = xs + g1 * y
        ffn = (ffn_w_gate[l], ffn_w_val[l], ffn_conv_w[l], ffn_conv_b[l], ffn_w_down[l])
        xs = xs + g2 * _conv_ffn(_rms(xs, norm2_g[l]) * (1.0 + sc2) + sh2, *ffn)
        if ctx_out:
            cs = cs + cg1 * yc
            cs = cs + cg2 * _conv_ffn(_rms(cs, norm2_g[l]) * (1.0 + csc2) + csh2, *ffn)
    return xs
```

```cpp
#include <hip/hip_runtime.h>
#include <cstdio>
#include <cstdint>
namespace pg8 {
#define PG8_LAS __attribute__((address_space(3)))
typedef unsigned short bf16_t;
typedef short bf16x8 __attribute__((ext_vector_type(8)));
typedef float f32x4 __attribute__((ext_vector_type(4)));
typedef unsigned u32x4 __attribute__((ext_vector_type(4)));
constexpr int BM = 256, BK = 64, HALF = 128, HTB = HALF * BK * 2  , STAGE_BYTES = 8 * HTB, NXCD = 8, WGM = 8;

__host__ __device__ __forceinline__ int lds_byte(int r, int c) { const int st = (r >> 4) * 2 + (c >> 5), rr = r & 15, cc = c & 31, ob = rr * 64 + cc * 2; return st * 1024 + (ob ^ (((ob >> 9) & 1) << 5)); }
__host__ __device__ __forceinline__ void stage_rc(int b, int& R, int& C) { const int st = b / 1024, sb = b % 1024, swz = sb ^ (((sb >> 9) & 1) << 5); R = (st >> 1) * 16 + swz / 64; C = (st & 1) * 32 + (swz % 64) / 2; }
__host__ __device__ __forceinline__ int perm32(int rho) { const int n = rho >> 4, i = rho & 15; return 8 * (i >> 2) + 4 * n + (i & 3); }

struct Unit { int pm, pn; };
struct Gemm { const bf16_t* A; const bf16_t* Bt; int M, N, K; };

struct StaticOrder {
    int nM, nN, nwg, G, c;
    __host__ __device__ void init(int M, int N, int G_, int c_) { nM = M / BM; nN = N / BM; nwg = nM * nN; G = G_; c = c_; }
    __host__ __device__ bool next(int i, Unit& u) const {
        const long L = (long)i * G + c; if (L >= nwg) return false;
        int wgid = (int)L; { const int q = nwg / NXCD, r = nwg % NXCD, xcd = wgid % NXCD, off = wgid / NXCD; wgid = (xcd < r ? xcd * (q + 1) : r * (q + 1) + (xcd - r) * q) + off; }
        const int nig = WGM * nN, gid = wgid / nig, fm = gid * WGM, gsz = (nM - fm) < WGM ? (nM - fm) : WGM;
        u.pm = fm + ((wgid % nig) % gsz); u.pn = (wgid % nig) / gsz; return true;
    }
    __device__ __forceinline__ void a_ready(const Unit&) const {}
    __device__ __forceinline__ void done(const Unit&) const {}
};

__device__ __forceinline__ unsigned cvt_pk_bf16(float lo, float hi) { unsigned r; asm volatile("v_cvt_pk_bf16_f32 %0, %1, %2" : "=v"(r) : "v"(lo), "v"(hi)); return r; }
typedef float f32x2 __attribute__((ext_vector_type(2)));
__device__ __forceinline__ f32x2 gelu_pk(f32x2 v) {
    const f32x2 av = __builtin_elementwise_abs(v), d = av * 0.2316418882f + 1.0f;
    f32x2 t; t.x = __builtin_amdgcn_rcpf(d.x); t.y = __builtin_amdgcn_rcpf(d.y);
    f32x2 q = t * 0.5307027145f + (-0.7265760135f); q = q * t + 0.7107068705f; q = q * t + (-0.142248368f); q = q * t + 0.127414796f; q = q * t;
    const f32x2 s = (v * v) * (-0.72134752044f);
    f32x2 e; e.x = __builtin_amdgcn_exp2f(s.x); e.y = __builtin_amdgcn_exp2f(s.y);
    const f32x2 m = v * (q * e), r = v - m;
    f32x2 o; o.x = v.x < 0.f ? m.x : r.x; o.y = v.y < 0.f ? m.y : r.y; return o;
}

template <int ACT  > struct EpiBf16 {
    static constexpr bool PERM = true, AFTER_DRAIN = false; static_assert(ACT == 0 || ACT == 1, "EpiBf16: ACT is 0 (none) or 1 (gelu_pk)");
    bf16_t* O; int ldc; const float* bias; int split_cols; size_t split_stride; float scale0;
    __device__ __forceinline__ void operator()(const f32x4 (&acc)[2][2][4][2], const Unit& u, int wr, int wc, int fr, int fq) const {
        const int row0 = u.pm * BM + wr * 64 + fr; int colt = u.pn * BM; bf16_t* base = O;
        float sc = 1.f; if (split_cols) { const int t = colt / split_cols; base += (size_t)t * split_stride; colt -= t * split_cols; if (t == 0) sc = scale0; }
        const int col0 = colt + wc * 32 + 8 * fq, bcol0 = u.pn * BM + wc * 32 + 8 * fq;
        f32x4 bv[2][2];
#pragma unroll
        for (int bj = 0; bj < 2; ++bj)
#pragma unroll
            for (int n = 0; n < 2; ++n) bv[bj][n] = bias ? *(const f32x4*)(bias + bcol0 + bj * HALF + 4 * n) : (f32x4){0.f, 0.f, 0.f, 0.f};
#pragma unroll
        for (int ai = 0; ai < 2; ++ai)
#pragma unroll
            for (int m = 0; m < 4; ++m) { bf16_t* rowp = base + (size_t)(row0 + ai * HALF + m * 16) * ldc + col0;
#pragma unroll
                for (int bj = 0; bj < 2; ++bj) { f32x4 v0 = acc[ai][bj][m][0] + bv[bj][0], v1 = acc[ai][bj][m][1] + bv[bj][1];
                    if (ACT == 1) { f32x2 a = gelu_pk((f32x2){v0[0], v0[1]}), b = gelu_pk((f32x2){v0[2], v0[3]}), c = gelu_pk((f32x2){v1[0], v1[1]}), d = gelu_pk((f32x2){v1[2], v1[3]});
                        v0 = (f32x4){a.x, a.y, b.x, b.y}; v1 = (f32x4){c.x, c.y, d.x, d.y}; }
                    v0 = v0 * sc; v1 = v1 * sc; u32x4 w; w.x = cvt_pk_bf16(v0[0], v0[1]); w.y = cvt_pk_bf16(v0[2], v0[3]); w.z = cvt_pk_bf16(v1[0], v1[1]); w.w = cvt_pk_bf16(v1[2], v1[3]);
                    *(u32x4*)(rowp + bj * HALF) = w; } }
    }
};
struct EpiRes {
    static constexpr bool PERM = false, AFTER_DRAIN = false;
    const float* base; float* out; int ldc; const float* gm; const float* gb;
    __device__ __forceinline__ void operator()(const f32x4 (&acc)[2][2][4][2], const Unit& u, int wr, int wc, int fr, int fq) const {
        const int col0 = u.pn * BM + wc * 32 + 4 * fq; const int b = u.pm >> 6;
        const float* gmb = gm + (size_t)b * 12288;
#pragma unroll
        for (int bj = 0; bj < 2; ++bj)
#pragma unroll
            for (int n = 0; n < 2; ++n) { const int c = col0 + bj * HALF + n * 16;
                const f32x4 gt = *(const f32x4*)(gmb + c) + *(const f32x4*)(gb + c);
#pragma unroll
                for (int ai = 0; ai < 2; ++ai)
#pragma unroll
                    for (int m = 0; m < 4; ++m) { const size_t off = (size_t)(u.pm * BM + ai * HALF + wr * 64 + m * 16 + fr) * ldc + c;
                        const f32x4 bs = *(const f32x4*)(base + off); *(f32x4*)(out + off) = bs + gt * acc[ai][bj][m][n]; }
                asm volatile("" ::: "memory"); }
    }
};
struct EpiGlu {
    static constexpr bool PERM = true, AFTER_DRAIN = false;
    const bf16_t* G; bf16_t* U; int ldc; const float* cw; const float* cb;
    __device__ __forceinline__ void operator()(const f32x4 (&acc)[2][2][4][2], const Unit& u, int wr, int wc, int fr, int fq) const {
        typedef unsigned u32x2 __attribute__((ext_vector_type(2)));
        const int row0 = u.pm * BM + wr * 64 + fr;
#pragma unroll
        for (int bj = 0; bj < 2; ++bj)
#pragma unroll
            for (int n = 0; n < 2; ++n) { const int c0 = u.pn * BM + bj * HALF + wc * 32 + 8 * fq + 4 * n;
                const f32x4 w0 = *(const f32x4*)(cw + c0), w1 = *(const f32x4*)(cw + ldc + c0), w2 = *(const f32x4*)(cw + 2 * ldc + c0), bb = *(const f32x4*)(cb + c0);
#pragma unroll
                for (int ai = 0; ai < 2; ++ai)
#pragma unroll
                    for (int m = 0; m < 4; ++m) { const int row = row0 + ai * HALF + m * 16; const int t = row & 16383;
                        const bf16_t* gp = G + (size_t)row * ldc + c0;
                        const u32x2 g0 = *(const u32x2*)gp;
                        const u32x2 gm = *(const u32x2*)(t > 0 ? gp - ldc : gp); const u32x2 gn = *(const u32x2*)(t < 16383 ? gp + ldc : gp);
                        const float fm = t > 0 ? 1.f : 0.f, fn = t < 16383 ? 1.f : 0.f;
                        u32x2 o;
#pragma unroll
                        for (int e = 0; e < 2; ++e) {
                            float r2[2];
#pragma unroll
                            for (int hh = 0; hh < 2; ++hh) {
                                const float a0 = hh ? __uint_as_float(g0[e] & 0xffff0000u) : __uint_as_float(g0[e] << 16);
                                const float am = (hh ? __uint_as_float(gm[e] & 0xffff0000u) : __uint_as_float(gm[e] << 16)) * fm;
                                const float an = (hh ? __uint_as_float(gn[e] & 0xffff0000u) : __uint_as_float(gn[e] << 16)) * fn;
                                const float g = w0[2 * e + hh] * am + w1[2 * e + hh] * a0 + w2[2 * e + hh] * an + bb[2 * e + hh];
                                const float ex = __builtin_amdgcn_exp2f(-2.3022082f * g * (1.f + 0.044715f * g * g));
                                r2[hh] = g * __builtin_amdgcn_rcpf(1.f + ex) * acc[ai][bj][m][n][2 * e + hh];
                            }
                            o[e] = cvt_pk_bf16(r2[0], r2[1]);
                        }
                        *(u32x2*)(U + (size_t)row * ldc + c0) = o;
                        if (m & 1) asm volatile("" ::: "memory"); }
            }
    }
};
template <class Epi, class Sched, bool ALIGN_EPI = false, bool SP2 = false>
__device__ __forceinline__ void gemm_phase(PG8_LAS unsigned char* lds, const Gemm g, const Sched& S, const Epi& E) {
    const int tid = threadIdx.x, wid = __builtin_amdgcn_readfirstlane(tid >> 6), lane = tid & 63, wr = wid >> 2, wc = wid & 3, fr = lane & 15, fq = lane >> 4;
    const int K = g.K, nt = K / BK;
    unsigned voffA[2], voffB[2];
#pragma unroll
    for (int i = 0; i < 2; ++i) { int R, C; stage_rc(tid * 16 + i * 8192, R, C); const int Rb = Epi::PERM ? ((R & ~31) + perm32(R & 31)) : R;
        voffA[i] = (unsigned)(R * K + C) * 2u; voffB[i] = (unsigned)(Rb * K + C) * 2u; }
    const size_t kstep = (size_t)(BK * 2);
    const size_t hstep = (size_t)HALF * K * 2;
    const size_t tstep = 2 * hstep;
    const unsigned ldsw = (unsigned)wid * 1024u;
    const int aoff = lds_byte(wr * 64 + fr, fq * 8), boff = lds_byte(wc * 32 + fr, fq * 8);
#define PG8_SA(b, h) (((b) * 2 + (h)) * HTB)
#define PG8_SB(b, h) ((4 + (b) * 2 + (h)) * HTB)
#define PG8_STAGE(bufoff, gbase, voff) do { _Pragma("unroll") for (int _i = 0; _i < 2; ++_i) \
        __builtin_amdgcn_global_load_lds((const unsigned*)((const char*)(gbase) + (voff)[_i]), (PG8_LAS unsigned*)(lds + (bufoff) + ldsw + _i * 8192), 16, 0, 0); } while (0)
#define PG8_LDA(dst, b, h) do { _Pragma("unroll") for (int m = 0; m < 4; ++m) _Pragma("unroll") for (int k = 0; k < 2; ++k) dst[m][k] = *(const PG8_LAS bf16x8*)(lds + PG8_SA(b, h) + aoff + m * 2048 + k * 1024); } while (0)
#define PG8_LDB(dst, b, h) do { _Pragma("unroll") for (int n = 0; n < 2; ++n) _Pragma("unroll") for (int k = 0; k < 2; ++k) dst[n][k] = *(const PG8_LAS bf16x8*)(lds + PG8_SB(b, h) + boff + n * 2048 + k * 1024); } while (0)
#define PG8_MMA(ai, bj, At, Bt) do { __builtin_amdgcn_s_setprio(1); _Pragma("unroll") for (int m = 0; m < 4; ++m) _Pragma("unroll") for (int n = 0; n < 2; ++n) _Pragma("unroll") for (int k = 0; k < 2; ++k) \
        acc[ai][bj][m][n] = __builtin_amdgcn_mfma_f32_16x16x32_bf16(Bt[n][k], At[m][k], acc[ai][bj][m][n], 0, 0, 0); __builtin_amdgcn_s_setprio(0); } while (0)
#define PG8_WAIT_V(n) asm volatile("s_waitcnt vmcnt(" #n ")" ::: "memory")
#define PG8_WAIT_L(n) asm volatile("s_waitcnt lgkmcnt(" #n ")" ::: "memory")
#define PG8_BAR __builtin_amdgcn_s_barrier()
#define PG8_SCHED __builtin_amdgcn_sched_barrier(0)
    Unit cur, nxt; int ui = 0;
    if (!S.next(0, cur)) return;
    f32x4 acc[2][2][4][2];
#pragma unroll
    for (int a = 0; a < 2; ++a)
#pragma unroll
        for (int b = 0; b < 2; ++b)
#pragma unroll
            for (int m = 0; m < 4; ++m)
#pragma unroll
                for (int n = 0; n < 2; ++n) acc[a][b][m][n] = (f32x4){0.f, 0.f, 0.f, 0.f};
    bf16x8 At[4][2], B0[2][2], B1[2][2];
    const char* cA = (const char*)g.A + (size_t)cur.pm * tstep; const char* cB = (const char*)g.Bt + (size_t)cur.pn * tstep;
    S.a_ready(cur);
    if constexpr (SP2) {
        PG8_STAGE(PG8_SB(0, 0), cB, voffB); PG8_STAGE(PG8_SB(0, 1), cB + hstep, voffB); PG8_STAGE(PG8_SA(0, 0), cA, voffA); PG8_STAGE(PG8_SA(0, 1), cA + hstep, voffA);
        if (wr == 1) PG8_BAR;
        PG8_WAIT_V(2); PG8_BAR;
        PG8_STAGE(PG8_SB(1, 0), cB + kstep, voffB); PG8_STAGE(PG8_SA(1, 0), cA + kstep, voffA); PG8_STAGE(PG8_SB(1, 1), cB + hstep + kstep, voffB);
        PG8_WAIT_V(6); PG8_BAR;
    } else {
        PG8_STAGE(PG8_SB(0, 0), cB, voffB); PG8_STAGE(PG8_SA(0, 0), cA, voffA); PG8_STAGE(PG8_SB(0, 1), cB + hstep, voffB); PG8_STAGE(PG8_SA(0, 1), cA + hstep, voffA);
        if (wr == 1) PG8_BAR;
        PG8_WAIT_V(4); PG8_BAR;
        PG8_STAGE(PG8_SB(1, 0), cB + kstep, voffB); PG8_STAGE(PG8_SA(1, 0), cA + kstep, voffA); PG8_STAGE(PG8_SB(1, 1), cB + hstep + kstep, voffB);
        PG8_WAIT_V(6); PG8_BAR;
    }
    for (;;) {
        const bool has_next = S.next(ui + 1, nxt);
        const char* nA = has_next ? (const char*)g.A + (size_t)nxt.pm * tstep : cA; const char* nB = has_next ? (const char*)g.Bt + (size_t)nxt.pn * tstep : cB;
        for (int t = 0; t < nt; t += 2) {
            const bool last = (t == nt - 2);
            const char* a1 = cA + (size_t)(t + 1) * kstep;
            const char* a2 = last ? nA : cA + (size_t)(t + 2) * kstep; const char* b2 = last ? nB : cB + (size_t)(t + 2) * kstep;
            const char* a3 = a2 + kstep; const char* b3 = b2 + kstep;
            if (last && has_next) S.a_ready(nxt);
            if constexpr (SP2) {
            PG8_LDB(B0, 0, 0); PG8_LDB(B1, 0, 1); PG8_SCHED; PG8_LDA(At, 0, 0); PG8_STAGE(PG8_SA(1, 1), a1 + hstep, voffA);
            PG8_WAIT_V(8); PG8_WAIT_L(0); PG8_BAR; PG8_MMA(0, 0, At, B0); PG8_MMA(0, 1, At, B1); PG8_BAR; PG8_SCHED;
            PG8_LDA(At, 0, 1); PG8_STAGE(PG8_SB(0, 0), b2, voffB); PG8_STAGE(PG8_SB(0, 1), b2 + hstep, voffB); PG8_STAGE(PG8_SA(0, 0), a2, voffA);
            PG8_WAIT_V(8); PG8_WAIT_L(0); PG8_BAR; PG8_MMA(1, 0, At, B0); PG8_MMA(1, 1, At, B1); PG8_BAR; PG8_SCHED;
            PG8_LDB(B0, 1, 0); PG8_LDB(B1, 1, 1); PG8_SCHED; PG8_LDA(At, 1, 0); PG8_STAGE(PG8_SA(0, 1), a2 + hstep, voffA);
            PG8_WAIT_V(8); PG8_WAIT_L(0); PG8_BAR; PG8_MMA(0, 0, At, B0); PG8_MMA(0, 1, At, B1); PG8_BAR; PG8_SCHED;
            PG8_LDA(At, 1, 1); PG8_STAGE(PG8_SB(1, 0), b3, voffB); PG8_STAGE(PG8_SB(1, 1), b3 + hstep, voffB); PG8_STAGE(PG8_SA(1, 0), a3, voffA);
            PG8_WAIT_V(8); PG8_WAIT_L(0); PG8_BAR; PG8_MMA(1, 0, At, B0); PG8_MMA(1, 1, At, B1); PG8_BAR; PG8_SCHED;
            } else {
            PG8_LDB(B0, 0, 0); PG8_SCHED; PG8_LDA(At, 0, 0); PG8_STAGE(PG8_SA(1, 1), a1 + hstep, voffA);
            PG8_WAIT_L(8); PG8_BAR; PG8_WAIT_L(0); PG8_MMA(0, 0, At, B0); PG8_BAR; PG8_SCHED;
            PG8_LDB(B1, 0, 1); PG8_STAGE(PG8_SB(0, 0), b2, voffB);
            PG8_BAR; PG8_WAIT_L(0); PG8_MMA(0, 1, At, B1); PG8_BAR;
            PG8_LDA(At, 0, 1); PG8_STAGE(PG8_SA(0, 0), a2, voffA);
            PG8_BAR; PG8_WAIT_L(0); PG8_MMA(1, 0, At, B0); PG8_BAR; PG8_SCHED;
            PG8_STAGE(PG8_SB(0, 1), b2 + hstep, voffB);
            PG8_WAIT_V(6); PG8_BAR; PG8_MMA(1, 1, At, B1); PG8_BAR;
            PG8_LDB(B0, 1, 0); PG8_SCHED; PG8_LDA(At, 1, 0); PG8_STAGE(PG8_SA(0, 1), a2 + hstep, voffA);
            PG8_WAIT_L(8); PG8_BAR; PG8_WAIT_L(0); PG8_MMA(0, 0, At, B0); PG8_BAR; PG8_SCHED;
            PG8_LDB(B1, 1, 1); PG8_STAGE(PG8_SB(1, 0), b3, voffB);
            PG8_BAR; PG8_WAIT_L(0); PG8_MMA(0, 1, At, B1); PG8_BAR;
            PG8_LDA(At, 1, 1); PG8_STAGE(PG8_SA(1, 0), a3, voffA);
            PG8_BAR; PG8_WAIT_L(0); PG8_MMA(1, 0, At, B0); PG8_BAR; PG8_SCHED;
            PG8_STAGE(PG8_SB(1, 1), b3 + hstep, voffB);
            PG8_WAIT_V(6); PG8_BAR; PG8_MMA(1, 1, At, B1); PG8_BAR;
            }
        }
        if constexpr (ALIGN_EPI) { if (wr == 0) PG8_BAR; }
        if constexpr (!Epi::AFTER_DRAIN) { E(acc, cur, wr, wc, fr, fq); S.done(cur); }
        if (!has_next) break;
#pragma unroll
        for (int a = 0; a < 2; ++a)
#pragma unroll
            for (int b = 0; b < 2; ++b)
#pragma unroll
                for (int m = 0; m < 4; ++m)
#pragma unroll
                    for (int n = 0; n < 2; ++n) acc[a][b][m][n] = (f32x4){0.f, 0.f, 0.f, 0.f};
        cur = nxt; cA = nA; cB = nB; ++ui;
        if constexpr (ALIGN_EPI) { if (wr == 1) PG8_BAR; }
    }
    PG8_WAIT_V(0);
    if constexpr (!ALIGN_EPI) { if (wr == 0) PG8_BAR; }
    PG8_BAR;
    if constexpr (Epi::AFTER_DRAIN) { E.fused(acc, cur, wr, wc, fr, fq, lds, wid, lane); S.done(cur); }
#undef PG8_SA
#undef PG8_SB
#undef PG8_STAGE
#undef PG8_LDA
#undef PG8_LDB
#undef PG8_MMA
#undef PG8_WAIT_V
#undef PG8_WAIT_L
#undef PG8_BAR
#undef PG8_SCHED
}
}
#include <hip/hip_cooperative_groups.h>
namespace cg = cooperative_groups;

constexpr int DM = 2048, NBATCH = 2, SEQ = 16384, CTXL = 256, MT = NBATCH * SEQ, MC = NBATCH * CTXL, MALL = MT + MC;
constexpr int INA = 4608, DFF = 5632, HY3 = 6144, NKEY = CTXL + SEQ  , NVH = 10;
constexpr float EPSN = 1e-6f, LOG2E = 1.4426950408889634f;
constexpr size_t MiB = 1u << 20;
constexpr size_t WS_M = 0;
constexpr size_t CTL_ZERO_BYTES = 512 * 1024;
constexpr size_t WS_LAM = 1 * MiB;
constexpr size_t WS_A3T = 2 * MiB;
constexpr size_t WS_W = 12 * MiB;
constexpr size_t WS_H = 110 * MiB;
constexpr size_t WS_P = 240 * MiB;
constexpr size_t WS_VT = 533 * MiB;
constexpr size_t WS_U = 592 * MiB;
constexpr size_t WS_T = 624 * MiB;
constexpr size_t WS_FILT = 238 * MiB + 2 * MiB;
constexpr size_t WS_SPEC = 500 * MiB;
constexpr size_t SPEC_SLOT = 135168;
constexpr size_t WS_END = 1024 * MiB;
static_assert(WS_FILT == WS_P, "filters overlay Z");
static_assert(WS_W + 98 * MiB <= WS_H && WS_H + (size_t)MALL * DM * 2 <= WS_P && WS_P + (size_t)MALL * INA * 2 <= WS_VT, "ws map 1");
static_assert(WS_VT + (size_t)NBATCH * NVH * 128 * NKEY * 2 <= WS_U + 30 * MiB, "ws map 2");
static_assert(WS_P + (size_t)MT * DFF * 2 <= WS_U && WS_U + (size_t)MT * DFF * 2 <= WS_END, "ws map 3");
static_assert(WS_P + (size_t)MT * HY3 * 2 <= WS_T && WS_T + (size_t)3 * MT * DM * 2 <= WS_END, "ws map 4");
static_assert(WS_FILT + (size_t)4 * DM * SEQ * 2 <= WS_SPEC && WS_SPEC + 256 * SPEC_SLOT <= WS_T, "ws map 5");
constexpr size_t W0_IN = 0, W0_OUT = W0_IN + (size_t)INA * DM, W0_G = W0_OUT + (size_t)DM * DM, W0_V = W0_G + (size_t)DFF * DM, W0_D = W0_V + (size_t)DFF * DM;
constexpr size_t W1_IN = 0, W1_OUT = W1_IN + (size_t)HY3 * DM, W1_G = W1_OUT + (size_t)DM * DM, W1_V = W1_G + (size_t)DFF * DM, W1_D = W1_V + (size_t)DFF * DM;
static_assert((W1_D + (size_t)DFF * DM) * 2 <= 98 * MiB, "weights region");

constexpr int RING_BYTES = 131072, LDS_BYTES = 147456;
#define LAS __attribute__((address_space(3)))
typedef unsigned short bf16;
typedef unsigned v4u __attribute__((ext_vector_type(4)));
typedef unsigned v2u __attribute__((ext_vector_type(2)));
typedef float f32x4 __attribute__((ext_vector_type(4)));
typedef float f32x16 __attribute__((ext_vector_type(16)));
typedef short bf16x8 __attribute__((ext_vector_type(8)));
typedef float f32x2_t __attribute__((ext_vector_type(2))); typedef __bf16 bf16x2_t __attribute__((ext_vector_type(2)));
#define DI __device__ __forceinline__
DI unsigned cvtpk(float lo, float hi) { f32x2_t v = {lo, hi}; bf16x2_t b = __builtin_convertvector(v, bf16x2_t); return __builtin_bit_cast(unsigned, b); }
DI float bflo(unsigned w) { return __uint_as_float(w << 16); }
DI float bfhi(unsigned w) { return __uint_as_float(w & 0xffff0000u); }
DI float bf1(unsigned short v) { return __uint_as_float((unsigned)v << 16); }
DI float wave_sum(float v) {
#pragma unroll
    for (int o = 1; o < 64; o <<= 1) v += __shfl_xor(v, o);
    return v;
}
DI float fsin_rev(float r) { return __builtin_amdgcn_sinf(r); }
DI float fcos_rev(float r) { return __builtin_amdgcn_cosf(r); }
DI float fsin_rad(float x) { return __builtin_amdgcn_sinf(x * 0.15915494309189535f); }

struct Frame {
    unsigned char* lds; int tid, lane, wave, gw, NGW;
    const float* in[39]; float* out; unsigned char* ws;
};
#define WSF(off) ((float*)(F.ws + (off)))
#define WSB(off) ((bf16*)(F.ws + (off)))

DI void transpose_item(const float* W, int K, int N, bf16* WT, float* scr, int item, int lane) {
    const int nblk = N / 32, kb = item / nblk, nb = item % nblk, k0 = 64 * kb, n0 = 32 * nb;
#pragma unroll 8
    for (int i = 0; i < 32; ++i) { const int kk = 2 * i + (lane >> 5); scr[kk * 33 + (lane & 31)] = W[(size_t)(k0 + kk) * N + n0 + (lane & 31)]; }
    __builtin_amdgcn_fence(__ATOMIC_RELEASE, "wavefront"); asm volatile("s_waitcnt lgkmcnt(0)" ::: "memory");
    const int c = lane & 7;
#pragma unroll
    for (int j = 0; j < 4; ++j) { const int n = (lane >> 3) + 8 * j; const float* s = scr + (8 * c) * 33 + n;
        v4u o; o.x = cvtpk(s[0 * 33], s[1 * 33]); o.y = cvtpk(s[2 * 33], s[3 * 33]); o.z = cvtpk(s[4 * 33], s[5 * 33]); o.w = cvtpk(s[6 * 33], s[7 * 33]);
        *(v4u*)(WT + (size_t)(n0 + n) * K + k0 + 8 * c) = o; }
    asm volatile("s_waitcnt lgkmcnt(0)" ::: "memory");
}
struct TJob { const float* W; int K, N; bf16* WT; };
template <int NJ> DI void transpose_jobs(Frame& F, const TJob (&jobs)[NJ]) {
    float* scr = (float*)(F.lds + F.wave * 16384);
    int tot = 0;
#pragma unroll
    for (int j = 0; j < NJ; ++j) tot += (jobs[j].K / 64) * (jobs[j].N / 32);
    for (int it = F.gw; it < tot; it += F.NGW) {
        int r = it;
#pragma unroll
        for (int j = 0; j < NJ; ++j) { const int n = (jobs[j].K / 64) * (jobs[j].N / 32);
            if (r >= 0 && r < n) transpose_item(jobs[j].W, jobs[j].K, jobs[j].N, jobs[j].WT, scr, r, F.lane);
            r -= n; }
    }
}
DI float silu(float x) { return x / (1.f + __expf(-x)); }

DI void p0_ada(Frame& F) {
    const float* ada_w = F.in[4]; const float* c = F.in[1]; const float* cctx = F.in[3]; float* M = WSF(WS_M);
    for (int it = F.gw; it < 1536; it += F.NGW) {
        const int l = it / 768, rem = it % 768, kc = rem / 48, ng = rem % 48;
        const float* W = ada_w + (size_t)l * DM * 12288 + (size_t)(kc * 128) * 12288 + ng * 256 + F.lane * 4;
        f32x4 a0 = {0, 0, 0, 0}, a1 = a0, a2 = a0;
#pragma unroll 8
        for (int k = 0; k < 128; ++k) { const f32x4 w = *(const f32x4*)(W + (size_t)k * 12288); const int kk = kc * 128 + k;
            const float s0 = silu(c[kk]), s1 = silu(c[DM + kk]), s2 = silu(cctx[kk]);
            a0 += w * s0; a1 += w * s1; a2 += w * s2; }
        float* m0 = M + (size_t)(l * 3) * 12288 + ng * 256 + F.lane * 4;
#pragma unroll
        for (int e = 0; e < 4; ++e) { unsafeAtomicAdd(m0 + e, a0[e]); unsafeAtomicAdd(m0 + 12288 + e, a1[e]); unsafeAtomicAdd(m0 + 2 * 12288 + e, a2[e]); }
    }
}
DI void p0_hyena_mlp(Frame& F) {
    const float *w0 = F.in[24], *b0 = F.in[25], *w1 = F.in[26], *b1 = F.in[27], *w2 = F.in[28], *b2 = F.in[29], *fq = F.in[30];
    float* a3t = WSF(WS_A3T); const int lane = F.lane; const float freq = fq[lane];
    for (int pg = F.gw; pg < 2048; pg += F.NGW) {
        float a[8], acc[8];
#pragma unroll
        for (int q = 0; q < 8; ++q) { const float pos = (float)(pg * 8 + q); float z = 0.f;
            if (lane == 0) z = pos / 16383.f;
            else if (lane <= 32) { const int i = (lane - 1) & 15; const float f = 1e-4f + (float)i * ((15.f - 1e-4f) / 15.f); const float rev = f * pos * (1.f / 16384.f);
                z = lane <= 16 ? fcos_rev(rev) : -fsin_rev(rev); }
            a[q] = z; acc[q] = b0[lane]; }
        for (int i = 0; i < 33; ++i) { const float w = w0[i * 64 + lane];
#pragma unroll
            for (int q = 0; q < 8; ++q) acc[q] += __shfl(a[q], i) * w; }
#pragma unroll
        for (int q = 0; q < 8; ++q) { a[q] = fsin_rad(freq * acc[q]); acc[q] = b1[lane]; }
        for (int i = 0; i < 64; ++i) { const float w = w1[i * 64 + lane];
#pragma unroll
            for (int q = 0; q < 8; ++q) acc[q] += __shfl(a[q], i) * w; }
#pragma unroll
        for (int q = 0; q < 8; ++q) { a[q] = fsin_rad(freq * acc[q]); acc[q] = b2[lane]; }
        for (int i = 0; i < 64; ++i) { const float w = w2[i * 64 + lane];
#pragma unroll
            for (int q = 0; q < 8; ++q) acc[q] += __shfl(a[q], i) * w; }
        f32x4 o0, o1;
#pragma unroll
        for (int q = 0; q < 4; ++q) { o0[q] = fsin_rad(freq * acc[q]); o1[q] = fsin_rad(freq * acc[4 + q]); }
        *(f32x4*)(a3t + (size_t)lane * SEQ + pg * 8) = o0; *(f32x4*)(a3t + (size_t)lane * SEQ + pg * 8 + 4) = o1;
    }
}
DI void p0_lam(Frame& F) {
    if (blockIdx.x == 0 && F.wave == 0) {
        const float s1 = wave_sum(F.in[12][F.lane] * F.in[13][F.lane]), s2 = wave_sum(F.in[14][F.lane] * F.in[15][F.lane]);
        if (F.lane == 0) WSF(WS_LAM)[0] = __expf(s1) - __expf(s2) + 0.2f;
    }
}
DI void norm_rows(Frame& F, const float* src, int srow0, int nrows, bf16* dst, int drow0, const float* g, const float* msc, const float* bsc, const float* msh, const float* bsh) {
    f32x4 A[8], B[8];
#pragma unroll
    for (int j = 0; j < 8; ++j) { const int c = 4 * F.lane + 256 * j;
        const f32x4 sc = *(const f32x4*)(msc + c) + *(const f32x4*)(bsc + c); A[j] = *(const f32x4*)(g + c) * (sc + 1.0f); B[j] = *(const f32x4*)(msh + c) + *(const f32x4*)(bsh + c); }
    for (int r = F.gw; r < nrows; r += F.NGW) {
        const f32x4* xr = (const f32x4*)(src + (size_t)(srow0 + r) * DM) + F.lane;
        f32x4 v[8]; float ss = 0.f;
#pragma unroll
        for (int j = 0; j < 8; ++j) { v[j] = xr[64 * j]; ss += (v[j].x * v[j].x + v[j].y * v[j].y) + (v[j].z * v[j].z + v[j].w * v[j].w); }
        const float rstd = rsqrtf(wave_sum(ss) * (1.f / DM) + EPSN);
        v2u* o = (v2u*)(dst + (size_t)(drow0 + r) * DM) + F.lane;
#pragma unroll
        for (int j = 0; j < 8; ++j) { const f32x4 y = v[j] * rstd * A[j] + B[j]; v2u w; w.x = cvtpk(y.x, y.y); w.y = cvtpk(y.z, y.w); o[64 * j] = w; }
    }
}
DI void norm_phase(Frame& F, const float* src, int l, int which, bool with_ctx) {
    const float* M = WSF(WS_M) + (size_t)l * 3 * 12288; const float* ab = F.in[5] + (size_t)l * 12288;
    const float* g = (which ? F.in[7] : F.in[6]) + (size_t)l * DM; const int csh = which ? 3 : 0, csc = which ? 4 : 1;
    for (int b = 0; b < NBATCH; ++b)
        norm_rows(F, src, b * SEQ, SEQ, WSB(WS_H), b * SEQ, g, M + b * 12288 + csc * DM, ab + csc * DM, M + b * 12288 + csh * DM, ab + csh * DM);
    if (with_ctx) norm_rows(F, F.in[2], 0, MC, WSB(WS_H), MT, g, M + 2 * 12288 + csc * DM, ab + csc * DM, M + 2 * 12288 + csh * DM, ab + csh * DM);
}
template <int SEGL> DI void qk_step(bf16* p, const float* gain, float scale, bool rope, int prow, int pcol, int lane, bool store) {
    const v4u raw = *(const v4u*)p;
    float x[8];
#pragma unroll
    for (int e = 0; e < 4; ++e) { x[2 * e] = bflo(raw[e]); x[2 * e + 1] = bfhi(raw[e]); }
    float ss = 0.f;
#pragma unroll
    for (int e = 0; e < 8; ++e) ss += x[e] * x[e];
#pragma unroll
    for (int o = 1; o < SEGL; o <<= 1) ss += __shfl_xor(ss, o);
    const float rstd = rsqrtf(ss * (1.f / (8 * SEGL)) + EPSN);
    const int k = lane & (SEGL - 1);
    const f32x4 g0 = *(const f32x4*)(gain + 8 * k), g1 = *(const f32x4*)(gain + 8 * k + 4);
#pragma unroll
    for (int e = 0; e < 8; ++e) x[e] *= rstd * (e < 4 ? g0[e & 3] : g1[e & 3]);
    if (rope) {
        constexpr int NF = 2 * SEGL;
        const int axis = k / (SEGL / 2), half = (k / (SEGL / 4)) & 1, f0 = 8 * (k & (SEGL / 4 - 1));
        const float pos = (float)(axis ? pcol : prow);
#pragma unroll
        for (int e = 0; e < 8; ++e) {
            const float xp = __shfl_xor(x[e], SEGL / 4);
            const float inv = __builtin_amdgcn_exp2f(-(float)(f0 + e) * (13.287712379549449f / NF));
            const float rev = pos * inv * 0.15915494309189535f;
            const float c = fcos_rev(rev), s = fsin_rev(rev);
            x[e] = half ? (x[e] * c + xp * s) : (x[e] * c - xp * s);
        }
    }
    if (store) { v4u o;
#pragma unroll
        for (int e = 0; e < 4; ++e) o[e] = cvtpk(x[2 * e] * scale, x[2 * e + 1] * scale);
        *(v4u*)p = o; }
}
DI int vt_perm_key(int pos) { const int gq = pos >> 4, h = (pos >> 3) & 1, j = pos & 7; return 16 * gq + 8 * (j >> 2) + 4 * h + (j & 3); }
DI void p3_rope(Frame& F) {
    bf16* P = WSB(WS_P); const int lane = F.lane;
    const float *aq = F.in[10], *ak = F.in[11], *bq = F.in[17], *bk = F.in[18];
    for (int r = F.gw; r < MALL; r += F.NGW) {
        bf16* row = P + (size_t)r * INA + 8 * lane;
        if (r < MT) { const int t = r & (SEQ - 1), prow = t >> 6, pcol = t & 63;
            qk_step<8>(row, aq, 0.125f * LOG2E, true, prow, pcol, lane, true); qk_step<8>(row + 512, aq, 0.125f * LOG2E, true, prow, pcol, lane, true);
            qk_step<16>(row + 1024, bq, 0.08838834764831845f * LOG2E, true, prow, pcol, lane, true); qk_step<16>(row + 1536, bq, 0.08838834764831845f * LOG2E, true, prow, pcol, lane, true);
            qk_step<8>(row + 2048, ak, 1.f, true, prow, pcol, lane, true); qk_step<8>(row + 2560, ak, 1.f, true, prow, pcol, lane, true);
            qk_step<16>(row + 4096, bk, 1.f, true, prow, pcol, lane, lane < 32);
        } else {
            qk_step<8>(row + 2048, ak, 1.f, false, 0, 0, lane, true); qk_step<8>(row + 2560, ak, 1.f, false, 0, 0, lane, true);
            qk_step<16>(row + 4096, bk, 1.f, false, 0, 0, lane, lane < 32);
        }
    }
    unsigned char* scr = F.lds + F.wave * 17408;
    bf16* VT = WSB(WS_VT);
    for (int it = F.gw; it < NBATCH * 260 * NVH; it += F.NGW) {
        const int vh = it % NVH, kc = (it / NVH) % 260, b = it / (NVH * 260);
        const int srow0 = kc < 4 ? MT + b * CTXL + kc * 64 : b * SEQ + (kc - 4) * 64;
        const int scol = vh < 8 ? 3072 + vh * 128 : 4352 + (vh - 8) * 128;
#pragma unroll 4
        for (int i = 0; i < 16; ++i) { const int rr = 4 * i + (lane >> 4), ch = lane & 15;
            *(v4u*)(scr + rr * 272 + ch * 16) = *(const v4u*)(P + (size_t)(srow0 + rr) * INA + scol + ch * 8); }
        asm volatile("s_waitcnt vmcnt(0) lgkmcnt(0)" ::: "memory");
#pragma unroll 4
        for (int i = 0; i < 16; ++i) { const int pair = i * 64 + lane, d = pair >> 3, oct = pair & 7;
            unsigned short e[8];
#pragma unroll
            for (int j = 0; j < 8; ++j) e[j] = *(const unsigned short*)(scr + vt_perm_key(8 * oct + j) * 272 + 2 * d);
            v4u o; o.x = e[0] | ((unsigned)e[1] << 16); o.y = e[2] | ((unsigned)e[3] << 16); o.z = e[4] | ((unsigned)e[5] << 16); o.w = e[6] | ((unsigned)e[7] << 16);
            *(v4u*)(VT + ((size_t)(b * NVH + vh) * 128 + d) * NKEY + kc * 64 + 8 * oct) = o; }
        asm volatile("s_waitcnt lgkmcnt(0)" ::: "memory");
    }
}
#define MFMA32(a, b, c) __builtin_amdgcn_mfma_f32_32x32x16_bf16((a), (b), (c), 0, 0, 0)
DI int crow(int r, int hi) { return (r & 3) + 8 * (r >> 2) + 4 * hi; }
template <int DQK, bool WIN> DI void attn_pass(Frame& F, const bf16* P, const bf16* VTh, int b, int q0, int qcol, int kcol, f32x16 (&o)[4], float& lsum) {
    constexpr int KS = DQK / 16, KROWB = DQK * 2 + 16, KT_BYTES = 64 * KROWB, VROWB = 144, STG = KT_BYTES + 128 * VROWB, KLD = DQK / 64;
    const int tid = F.tid, lane = F.lane, r32 = lane & 31, hi = lane >> 5, wid = F.wave;
    unsigned char* lds = F.lds;
    bf16x8 qf[KS];
    { const bf16* qp = P + (size_t)(b * SEQ + q0 + wid * 32 + r32) * INA + qcol + 8 * hi;
#pragma unroll
      for (int s = 0; s < KS; ++s) qf[s] = *(const bf16x8*)(qp + 16 * s); }
#pragma unroll
    for (int d = 0; d < 4; ++d)
#pragma unroll
        for (int i = 0; i < 16; ++i) o[d][i] = 0.f;
    float l = 0.f;
    int band0 = 0, NT;
    if (WIN) { band0 = q0 - 128 < 0 ? 0 : q0 - 128; const int band1 = q0 + 384 > SEQ ? SEQ : q0 + 384; NT = 4 + (band1 - band0) / 64; } else NT = NKEY / 64;
    v4u kreg[KLD], vreg[2];
#define ATT_ISSUE(t_) do { const int t__ = (t_); \
        const int kk0 = WIN ? (t__ < 4 ? 64 * t__ : CTXL + band0 + 64 * (t__ - 4)) : 64 * t__; \
        _Pragma("unroll") for (int i = 0; i < KLD; ++i) { const int idx = tid + 512 * i, rr = idx / (DQK / 8), ch = idx % (DQK / 8); const int kk = kk0 + rr; \
            const int prow = kk < CTXL ? MT + b * CTXL + kk : b * SEQ + kk - CTXL; \
            kreg[i] = *(const v4u*)(P + (size_t)prow * INA + kcol + ch * 8); } \
        _Pragma("unroll") for (int i = 0; i < 2; ++i) { const int idx = tid + 512 * i, d = idx >> 3, ch = idx & 7; \
            vreg[i] = *(const v4u*)(VTh + (size_t)d * NKEY + kk0 + ch * 8); } } while (0)
#define ATT_COMMIT(st_) do { unsigned char* kb_ = lds + (st_) * STG; unsigned char* vb_ = kb_ + KT_BYTES; \
        _Pragma("unroll") for (int i = 0; i < KLD; ++i) { const int idx = tid + 512 * i, rr = idx / (DQK / 8), ch = idx % (DQK / 8); *(v4u*)(kb_ + rr * KROWB + ch * 16) = kreg[i]; } \
        _Pragma("unroll") for (int i = 0; i < 2; ++i) { const int idx = tid + 512 * i, d = idx >> 3, ch = idx & 7; *(v4u*)(vb_ + d * VROWB + ch * 16) = vreg[i]; } } while (0)
    __syncthreads();
    ATT_ISSUE(0); ATT_COMMIT(0); __syncthreads();
    const int qpos = q0 + wid * 32 + r32;
    for (int t = 0; t < NT; ++t) {
        if (t + 1 < NT) ATT_ISSUE(t + 1);
        const unsigned char* kb = lds + (t & 1) * STG; const unsigned char* vb = kb + KT_BYTES;
        f32x16 p0, p1;
#pragma unroll
        for (int i = 0; i < 16; ++i) { p0[i] = 0.f; p1[i] = 0.f; }
#pragma unroll
        for (int s = 0; s < KS; ++s) {
            const bf16x8 a0 = *(const bf16x8*)(kb + r32 * KROWB + (16 * s + 8 * hi) * 2);
            const bf16x8 a1 = *(const bf16x8*)(kb + (32 + r32) * KROWB + (16 * s + 8 * hi) * 2);
            p0 = MFMA32(a0, qf[s], p0); p1 = MFMA32(a1, qf[s], p1);
        }
        if (WIN && t >= 4) { const int kp0 = band0 + 64 * (t - 4);
#pragma unroll
            for (int i = 0; i < 16; ++i) { const int d0 = kp0 + crow(i, hi) - qpos, d1 = d0 + 32;
                p0[i] = (d0 >= -128 && d0 <= 128) ? __builtin_amdgcn_exp2f(p0[i]) : 0.f; p1[i] = (d1 >= -128 && d1 <= 128) ? __builtin_amdgcn_exp2f(p1[i]) : 0.f; }
        } else {
#pragma unroll
            for (int i = 0; i < 16; ++i) { p0[i] = __builtin_amdgcn_exp2f(p0[i]); p1[i] = __builtin_amdgcn_exp2f(p1[i]); }
        }
        float sa = 0.f, sb = 0.f;
#pragma unroll
        for (int i = 0; i < 16; ++i) { sa += p0[i]; sb += p1[i]; }
        l += sa + sb;
        bf16x8 pb[4];
#pragma unroll
        for (int s = 0; s < 2; ++s) {
            v4u w0, w1;
#pragma unroll
            for (int e = 0; e < 4; ++e) { w0[e] = cvtpk(p0[8 * s + 2 * e], p0[8 * s + 2 * e + 1]); w1[e] = cvtpk(p1[8 * s + 2 * e], p1[8 * s + 2 * e + 1]); }
            pb[s] = __builtin_bit_cast(bf16x8, w0); pb[2 + s] = __builtin_bit_cast(bf16x8, w1);
        }
#pragma unroll
        for (int db = 0; db < 4; ++db)
#pragma unroll
            for (int ks = 0; ks < 4; ++ks) {
                const bf16x8 a = *(const bf16x8*)(vb + (32 * db + r32) * VROWB + (16 * ks + 8 * hi) * 2);
                o[db] = MFMA32(a, pb[ks], o[db]);
            }
        if (t + 1 < NT) ATT_COMMIT((t + 1) & 1);
        __syncthreads();
    }
    lsum = l + __shfl_xor(l, 32);
#undef ATT_ISSUE
#undef ATT_COMMIT
}
DI void p4_attention(Frame& F) {
    const bf16* P = WSB(WS_P); const bf16* VT = WSB(WS_VT); bf16* O = WSB(WS_H);
    const int lane = F.lane, r32 = lane & 31, hi = lane >> 5, wid = F.wave;
    const float lam = WSF(WS_LAM)[0];
    for (int u = blockIdx.x; u < 2048; u += gridDim.x) {
        if (u < 1024) {
            const int b = u >> 9, head = (u >> 6) & 7, q0 = (u & 63) * 256;
            const bf16* VTh = VT + (size_t)(b * NVH + head) * 128 * NKEY;
            f32x16 o[4]; float l;
            attn_pass<64, false>(F, P, VTh, b, q0, head * 128, 2048 + head * 128, o, l);
            v4u* stash = (v4u*)(F.lds + 73728 + F.tid * 128);
            { const float rl = 1.f / l;
#pragma unroll
              for (int d = 0; d < 4; ++d)
#pragma unroll
                  for (int e4 = 0; e4 < 2; ++e4) { v4u w;
#pragma unroll
                      for (int e = 0; e < 4; ++e) w[e] = cvtpk(o[d][8 * e4 + 2 * e] * rl, o[d][8 * e4 + 2 * e + 1] * rl);
                      stash[d * 2 + e4] = w; } }
            attn_pass<64, false>(F, P, VTh, b, q0, head * 128 + 64, 2048 + head * 128 + 64, o, l);
            const float rl2 = lam / l; float ss = 0.f;
#pragma unroll
            for (int d = 0; d < 4; ++d)
#pragma unroll
                for (int e4 = 0; e4 < 2; ++e4) { const v4u w = stash[d * 2 + e4];
#pragma unroll
                    for (int e = 0; e < 4; ++e) { const float v0 = bflo(w[e]) - rl2 * o[d][8 * e4 + 2 * e], v1 = bfhi(w[e]) - rl2 * o[d][8 * e4 + 2 * e + 1]; o[d][8 * e4 + 2 * e] = v0; o[d][8 * e4 + 2 * e + 1] = v1; ss += v0 * v0 + v1 * v1; } }
            ss += __shfl_xor(ss, 32);
            const float rstd = rsqrtf(ss * (1.f / 128.f) + EPSN) * 0.8f;
            const float* sg = F.in[16];
            bf16* orow = O + (size_t)(b * SEQ + q0 + wid * 32 + r32) * DM + head * 128;
#pragma unroll
            for (int d = 0; d < 4; ++d)
#pragma unroll
                for (int g4 = 0; g4 < 4; ++g4) { const int dd = 32 * d + 8 * g4 + 4 * hi; const f32x4 gg = *(const f32x4*)(sg + dd);
                    v2u w; w.x = cvtpk(o[d][4 * g4] * rstd * gg.x, o[d][4 * g4 + 1] * rstd * gg.y); w.y = cvtpk(o[d][4 * g4 + 2] * rstd * gg.z, o[d][4 * g4 + 3] * rstd * gg.w);
                    *(v2u*)(orow + dd) = w; }
        } else {
            const int uu = u - 1024, b = uu >> 9, qh = (uu >> 6) & 7, q0 = (uu & 63) * 256, g = qh >> 2;
            const bf16* VTh = VT + (size_t)(b * NVH + 8 + g) * 128 * NKEY;
            f32x16 o[4]; float l;
            attn_pass<128, true>(F, P, VTh, b, q0, 1024 + qh * 128, 4096 + g * 128, o, l);
            const float rl = 1.f / (l + __expf(F.in[19][qh]));
            bf16* orow = O + (size_t)(b * SEQ + q0 + wid * 32 + r32) * DM + 1024 + qh * 128;
#pragma unroll
            for (int d = 0; d < 4; ++d)
#pragma unroll
                for (int g4 = 0; g4 < 4; ++g4) { const int dd = 32 * d + 8 * g4 + 4 * hi;
                    v2u w; w.x = cvtpk(o[d][4 * g4] * rl, o[d][4 * g4 + 1] * rl); w.y = cvtpk(o[d][4 * g4 + 2] * rl, o[d][4 * g4 + 3] * rl);
                    *(v2u*)(orow + dd) = w; }
        }
    }
}
DI void p12_shortconv(Frame& F) {
    const bf16* Z = WSB(WS_P); bf16* T = WSB(WS_T); const float* cw = F.in[22]; const float* cb = F.in[23]; const int lane = F.lane;
    unsigned char* scr = F.lds + F.wave * 18432;
    for (int it = F.gw; it < NBATCH * 256 * 48; it += F.NGW) {
        const int cc = it % 48, tc = (it / 48) & 255, b = it / (48 * 256); const int t0 = tc * 64, c0 = cc * 128;
        for (int i = 0; i < 17; ++i) { const int rr = 4 * i + (lane >> 4), ch = lane & 15; const int t = t0 - 1 + rr;
            if (rr < 66) { v4u v = {0, 0, 0, 0}; if (t >= 0 && t < SEQ) v = *(const v4u*)(Z + (size_t)(b * SEQ + t) * HY3 + c0 + ch * 8); *(v4u*)(scr + rr * 272 + ch * 16) = v; } }
        asm volatile("s_waitcnt vmcnt(0) lgkmcnt(0)" ::: "memory");
#pragma unroll 2
        for (int i = 0; i < 16; ++i) { const int pair = i * 64 + lane, c = pair >> 3, oct = pair & 7; const int col = c0 + c;
            const float w0 = cw[col], w1 = cw[HY3 + col], w2 = cw[2 * HY3 + col], bb = cb[col];
            float z[10];
#pragma unroll
            for (int j = 0; j < 10; ++j) z[j] = bf1(*(const unsigned short*)(scr + (8 * oct + j) * 272 + 2 * c));
            v4u o;
#pragma unroll
            for (int e = 0; e < 4; ++e) { const float y0 = w0 * z[2 * e] + w1 * z[2 * e + 1] + w2 * z[2 * e + 2] + bb, y1 = w0 * z[2 * e + 1] + w1 * z[2 * e + 2] + w2 * z[2 * e + 3] + bb; o[e] = cvtpk(y0, y1); }
            const int which = col >> 11, ch = col & 2047;
            *(v4u*)(T + (((size_t)which * NBATCH + b) * DM + ch) * SEQ + t0 + 8 * oct) = o; }
        asm volatile("s_waitcnt lgkmcnt(0)" ::: "memory");
    }
}
DI void p13_filters(Frame& F) {
    const float* a3t = WSF(WS_A3T); const float* w3 = F.in[31]; bf16* FILT = WSB(WS_FILT); const int lane = F.lane;
    float* scr = (float*)(F.lds + F.wave * 17408);
    for (int it = F.gw; it < 256 * 128; it += F.NGW) {
        const int nc = it & 127, tc = it >> 7; const int n0 = nc * 64, t0 = tc * 64;
        float a[64];
#pragma unroll
        for (int j = 0; j < 64; ++j) a[j] = a3t[(size_t)j * SEQ + t0 + lane];
#pragma unroll 8
        for (int j = 0; j < 64; ++j) scr[lane * 68 + j] = w3[(size_t)j * 8192 + n0 + lane];
        asm volatile("s_waitcnt vmcnt(0) lgkmcnt(0)" ::: "memory");
        for (int n = 0; n < 64; ++n) { float acc = 0.f;
#pragma unroll
            for (int j4 = 0; j4 < 16; ++j4) { const f32x4 w = *(const f32x4*)(scr + n * 68 + 4 * j4); acc += a[4 * j4] * w.x + a[4 * j4 + 1] * w.y + a[4 * j4 + 2] * w.z + a[4 * j4 + 3] * w.w; }
            FILT[(size_t)(n0 + n) * SEQ + t0 + lane] = (bf16)(cvtpk(acc, 0.f) & 0xffffu); }
        asm volatile("s_waitcnt lgkmcnt(0)" ::: "memory");
    }
}
typedef float2 cf;
constexpr int FM = 16384;
#define FPAD(i) ((i) + (((i) >> 6) << 2))
DI cf cmul(cf a, cf b) { return make_float2(a.x * b.x - a.y * b.y, a.x * b.y + a.y * b.x); }
DI cf cmulc(cf a, cf b) { return make_float2(a.x * b.x + a.y * b.y, a.y * b.x - a.x * b.y); }
DI cf cadd(cf a, cf b) { return make_float2(a.x + b.x, a.y + b.y); }
DI cf csub(cf a, cf b) { return make_float2(a.x - b.x, a.y - b.y); }
template <bool INV> DI void r4(cf& a0, cf& a1, cf& a2, cf& a3) {
    const cf t0 = cadd(a0, a2), t1 = csub(a0, a2), t2 = cadd(a1, a3), t3 = csub(a1, a3);
    a0 = cadd(t0, t2); a2 = csub(t0, t2);
    if (!INV) { a1 = make_float2(t1.x + t3.y, t1.y - t3.x); a3 = make_float2(t1.x - t3.y, t1.y + t3.x); }
    else      { a1 = make_float2(t1.x - t3.y, t1.y + t3.x); a3 = make_float2(t1.x + t3.y, t1.y - t3.x); }
}
template <bool INV> DI void fft16(cf (&v)[16]) {
    constexpr float C1 = 0.9238795325112867f, S1 = 0.3826834323650898f, C2 = 0.7071067811865476f;
    const cf W[10] = {make_float2(1.f, 0.f), make_float2(C1, -S1), make_float2(C2, -C2), make_float2(S1, -C1), make_float2(0.f, -1.f), make_float2(-S1, -C1), make_float2(-C2, -C2), make_float2(-C1, -S1), make_float2(-1.f, 0.f), make_float2(-C1, S1)};
    if (!INV) {
#pragma unroll
        for (int i0 = 0; i0 < 4; ++i0) r4<false>(v[i0], v[4 + i0], v[8 + i0], v[12 + i0]);
#pragma unroll
        for (int m = 1; m < 4; ++m)
#pragma unroll
            for (int i0 = 1; i0 < 4; ++i0) v[4 * m + i0] = cmul(v[4 * m + i0], W[i0 * m]);
#pragma unroll
        for (int m = 0; m < 4; ++m) r4<false>(v[4 * m], v[4 * m + 1], v[4 * m + 2], v[4 * m + 3]);
    } else {
#pragma unroll
        for (int m = 0; m < 4; ++m) r4<true>(v[4 * m], v[4 * m + 1], v[4 * m + 2], v[4 * m + 3]);
#pragma unroll
        for (int m = 1; m < 4; ++m)
#pragma unroll
            for (int i0 = 1; i0 < 4; ++i0) v[4 * m + i0] = cmulc(v[4 * m + i0], W[i0 * m]);
#pragma unroll
        for (int i0 = 0; i0 < 4; ++i0) r4<true>(v[i0], v[4 + i0], v[8 + i0], v[12 + i0]);
    }
}
template <int S, bool INV> DI void fft_pass16(cf* cx, int tid) {
    constexpr int stride = S / 16;
    constexpr int estr = stride + (stride >= 64 ? 4 * (stride / 64) : 0);
    asm volatile("" : "+v"(tid));
#pragma unroll 1
    for (int u = tid; u < FM / 16; u += 512) {
        const int blk = u / stride, i = u % stride, base = blk * S + i;
        cf* p = cx + FPAD(base);
        const float rev = (float)i * (1.f / S);
        const cf w1 = make_float2(fcos_rev(rev), -fsin_rev(rev));
        cf v[16];
        if (!INV) {
#pragma unroll
            for (int j = 0; j < 16; ++j) v[j] = p[j * estr];
            fft16<false>(v);
            cf w = w1; p[0] = v[0];
#pragma unroll
            for (int f = 1; f < 16; ++f) { const int q = 4 * (f & 3) + (f >> 2); p[f * estr] = cmul(v[q], w); w = cmul(w, w1); }
        } else {
            cf w = w1; v[0] = p[0];
#pragma unroll
            for (int f = 1; f < 16; ++f) { const int q = 4 * (f & 3) + (f >> 2); v[q] = cmulc(p[f * estr], w); w = cmul(w, w1); }
            fft16<true>(v);
#pragma unroll
            for (int j = 0; j < 16; ++j) p[j * estr] = v[j];
        }
    }
}
template <bool INV> DI void fft_pass4(cf* cx, int tid) {
    asm volatile("" : "+v"(tid));
#pragma unroll 1
    for (int u = tid; u < FM / 4; u += 512) { cf* p = cx + FPAD(4 * u);
        cf a0 = p[0], a1 = p[1], a2 = p[2], a3 = p[3];
        r4<INV>(a0, a1, a2, a3);
        p[0] = a0; p[1] = a1; p[2] = a2; p[3] = a3; }
}
DI void fft_fwd(cf* cx, int tid) {
    fft_pass16<16384, false>(cx, tid); __syncthreads(); fft_pass16<1024, false>(cx, tid); __syncthreads(); fft_pass16<64, false>(cx, tid); __syncthreads(); fft_pass4<false>(cx, tid); __syncthreads();
}
DI void fft_inv(cf* cx, int tid) {
    fft_pass4<true>(cx, tid); __syncthreads(); fft_pass16<64, true>(cx, tid); __syncthreads(); fft_pass16<1024, true>(cx, tid); __syncthreads(); fft_pass16<16384, true>(cx, tid); __syncthreads();
}
DI int fpos(int k) { return FPAD(((k & 15) << 10) | (((k >> 4) & 15) << 6) | (((k >> 8) & 15) << 2) | (k >> 12)); }
DI void rsplit(cf Zk, cf Zm, cf w, cf& Uk, cf& Um) {
    const cf E = make_float2(0.5f * (Zk.x + Zm.x), 0.5f * (Zk.y - Zm.y)), O = make_float2(0.5f * (Zk.y + Zm.y), -0.5f * (Zk.x - Zm.x));
    const cf T = cmul(w, O);
    Uk = cadd(E, T); Um = make_float2(E.x - T.x, -(E.y - T.y));
}
DI void p14_longconv(Frame& F) {
    cf* cx = (cf*)F.lds; float* red = (float*)(F.lds + 139264); int tid = F.tid;
    const bf16* FILT = WSB(WS_FILT); bf16* T = WSB(WS_T); const float* dsk = F.in[32];
    cf* spec = (cf*)(F.ws + WS_SPEC + (size_t)blockIdx.x * SPEC_SLOT);
    for (int c = blockIdx.x; c < DM; c += gridDim.x) {
        const float delta = fabsf(-3.0701134573253944f + (float)c * ((-15.350567286626972f + 3.0701134573253944f) / 2047.f));
        const float dk = delta * (1.f / 16383.f) * LOG2E;
        for (int ord = 0; ord < 2; ++ord) {
            const bf16* hf = FILT + ((size_t)(ord * 2 + 0) * DM + c) * SEQ; const bf16* hb = FILT + ((size_t)(ord * 2 + 1) * DM + c) * SEQ;
            __syncthreads();
            asm volatile("" : "+v"(tid));
            float asum = 0.f;
#pragma unroll 1
            for (int n = tid; n < FM; n += 512) {
                float v0, v1;
                if (n < FM / 2) { const unsigned w = *(const unsigned*)(hf + 2 * n); v0 = bflo(w) * __builtin_amdgcn_exp2f(-(float)(2 * n) * dk); v1 = bfhi(w) * __builtin_amdgcn_exp2f(-(float)(2 * n + 1) * dk); }
                else { const int m0 = 2 * n, m1 = 2 * n + 1;
                    const int s0 = 2 * SEQ - m0, s1 = 2 * SEQ - m1;
                    v0 = (m0 == SEQ) ? 0.f : bf1(hb[s0]) * __builtin_amdgcn_exp2f(-(float)s0 * dk); v1 = bf1(hb[s1]) * __builtin_amdgcn_exp2f(-(float)s1 * dk); }
                asum += fabsf(v0) + fabsf(v1); cx[FPAD(n)] = make_float2(v0, v1);
            }
            asum = wave_sum(asum); if (F.lane == 0) red[F.wave] = asum;
            __syncthreads();
            float tot = 0.f;
#pragma unroll
            for (int w = 0; w < 8; ++w) tot += red[w];
            const float fscale = 1.f / (tot * (float)FM);
            fft_fwd(cx, tid);
#pragma unroll 1
            for (int k = tid; k <= FM / 2; k += 512) {
                if (k == 0) { const cf z = cx[fpos(0)]; spec[0] = make_float2((z.x + z.y) * fscale, 0.f); spec[FM] = make_float2((z.x - z.y) * fscale, 0.f); }
                else { const float rev = (float)k * (1.f / (2 * FM)); const cf w = make_float2(fcos_rev(rev), -fsin_rev(rev)); cf Uk, Um;
                    rsplit(cx[fpos(k)], cx[fpos(FM - k)], w, Uk, Um); spec[k] = make_float2(Uk.x * fscale, Uk.y * fscale); spec[FM - k] = make_float2(Um.x * fscale, Um.y * fscale); }
            }
            __threadfence_block();
            const float dskip = dsk[ord * DM + c];
            for (int b = 0; b < NBATCH; ++b) {
                bf16* u = T + ((size_t)(0 * NBATCH + b) * DM + c) * SEQ;
                const bf16* gate = T + ((size_t)((1 + ord) * NBATCH + b) * DM + c) * SEQ;
                __syncthreads();
                asm volatile("" : "+v"(tid));
#pragma unroll 1
                for (int n = tid; n < FM; n += 512) { cf z = make_float2(0.f, 0.f); if (n < FM / 2) { const unsigned w = *(const unsigned*)(u + 2 * n); z = make_float2(bflo(w), bfhi(w)); } cx[FPAD(n)] = z; }
                __syncthreads();
                fft_fwd(cx, tid);
#pragma unroll 1
                for (int k = tid; k <= FM / 2; k += 512) {
                    if (k == 0) { const cf z = cx[fpos(0)]; const float y0 = (z.x + z.y) * spec[0].x, ym = (z.x - z.y) * spec[FM].x; cx[fpos(0)] = make_float2(0.5f * (y0 + ym), 0.5f * (y0 - ym)); }
                    else { const float rev = (float)k * (1.f / (2 * FM)); const cf w = make_float2(fcos_rev(rev), -fsin_rev(rev)); cf Uk, Um;
                        const int pk = fpos(k), pm = fpos(FM - k);
                        rsplit(cx[pk], cx[pm], w, Uk, Um);
                        const cf Yk = cmul(Uk, spec[k]), Ym = cmul(Um, spec[FM - k]);
                        const cf E = make_float2(0.5f * (Yk.x + Ym.x), 0.5f * (Yk.y - Ym.y)), D = make_float2(0.5f * (Yk.x - Ym.x), 0.5f * (Yk.y + Ym.y));
                        const cf O = cmulc(D, w);
                        cx[pk] = make_float2(E.x - O.y, E.y + O.x); cx[pm] = make_float2(E.x + O.y, -E.y + O.x); }
                }
                __syncthreads();
                fft_inv(cx, tid);
#pragma unroll 1
                for (int n = tid; n < FM / 2; n += 512) { const cf y = cx[FPAD(n)]; const unsigned uw = *(const unsigned*)(u + 2 * n), gw = *(const unsigned*)(gate + 2 * n);
                    const float r0 = (y.x + dskip * bflo(uw)) * bflo(gw), r1 = (y.y + dskip * bfhi(uw)) * bfhi(gw);
                    *(unsigned*)(u + 2 * n) = cvtpk(r0, r1); }
                __threadfence_block();
            }
        }
    }
}
DI void p15_transpose_y(Frame& F) {
    const bf16* T = WSB(WS_T); bf16* Y = WSB(WS_H); const int lane = F.lane;
    unsigned char* scr = F.lds + F.wave * 9216;
    for (int it = F.gw; it < NBATCH * 256 * 32; it += F.NGW) {
        const int cc = it & 31, tc = (it >> 5) & 255, b = it >> 13; const int c0 = cc * 64, t0 = tc * 64;
#pragma unroll
        for (int i = 0; i < 8; ++i) { const int rr = 8 * i + (lane >> 3), ch = lane & 7;
            *(v4u*)(scr + rr * 144 + ch * 16) = *(const v4u*)(T + ((size_t)b * DM + c0 + rr) * SEQ + t0 + ch * 8); }
        asm volatile("s_waitcnt vmcnt(0) lgkmcnt(0)" ::: "memory");
#pragma unroll 2
        for (int i = 0; i < 8; ++i) { const int pair = i * 64 + lane, t = pair >> 3, oct = pair & 7;
            unsigned short e[8];
#pragma unroll
            for (int j = 0; j < 8; ++j) e[j] = *(const unsigned short*)(scr + (8 * oct + j) * 144 + 2 * t);
            v4u o; o.x = e[0] | ((unsigned)e[1] << 16); o.y = e[2] | ((unsigned)e[3] << 16); o.z = e[4] | ((unsigned)e[5] << 16); o.w = e[6] | ((unsigned)e[7] << 16);
            *(v4u*)(Y + (size_t)(b * SEQ + t0 + t) * DM + c0 + 8 * oct) = o; }
        asm volatile("s_waitcnt lgkmcnt(0)" ::: "memory");
    }
}
template <class Epi> DI void run_gemm(Frame& F, const bf16* A, const bf16* Bt, int M, int N, int K, const Epi& E) {
    __syncthreads();
    pg8::Gemm g{A, Bt, M, N, K}; pg8::StaticOrder S; S.init(M, N, (int)gridDim.x, (int)blockIdx.x);
    pg8::gemm_phase<Epi, pg8::StaticOrder, true, true>((PG8_LAS unsigned char*)F.lds, g, S, E);
    __syncthreads();
}
DI void ffn_phases(Frame& F, int l, int sub, size_t wg, size_t wv, size_t wd) {
    const bf16* W = WSB(WS_W);
    if (sub == 0) { pg8::EpiBf16<0> E{WSB(WS_P), DFF, nullptr, 0, 0, 1.f}; run_gemm(F, WSB(WS_H), W + wg, MT, DFF, DM, E); }
    else if (sub == 1) { pg8::EpiGlu E{WSB(WS_P), WSB(WS_U), DFF, F.in[36] + (size_t)l * 3 * DFF, F.in[37] + (size_t)l * DFF}; run_gemm(F, WSB(WS_H), W + wv, MT, DFF, DM, E); }
    else { pg8::EpiRes E{F.out, F.out, DM, WSF(WS_M) + (size_t)l * 3 * 12288 + 5 * DM, F.in[5] + (size_t)l * 12288 + 5 * DM}; run_gemm(F, WSB(WS_U), W + wd, MT, DM, DFF, E); }
}
struct Args { const float* in[39]; float* out; unsigned char* ws; int ph_lo, ph_hi; };
constexpr int NPHASE = 21;
__global__ void __launch_bounds__(512, 2) mega_fwd(Args args) {
    extern __shared__ __attribute__((aligned(16))) unsigned char lds_raw[];
    cg::grid_group grid = cg::this_grid();
    Frame F;
    F.lds = lds_raw; F.tid = threadIdx.x; F.lane = F.tid & 63; F.wave = __builtin_amdgcn_readfirstlane(F.tid >> 6);
    F.gw = blockIdx.x * 8 + F.wave; F.NGW = gridDim.x * 8;
#pragma unroll
    for (int i = 0; i < 39; ++i) F.in[i] = args.in[i];
    F.out = args.out; F.ws = args.ws;
    const int lo = args.ph_lo, hi = args.ph_hi;
#ifndef ONLY_PHASE
#define ONLY_PHASE -1
#endif
#define IN(k) ((ONLY_PHASE < 0 || ONLY_PHASE == (k)) && lo <= (k) && (k) < hi)
#define SEAM(k) do { if (IN(k) && IN((k) + 1)) grid.sync(); } while (0)
    bf16* W = WSB(WS_W);
    if (IN(0)) {
        const TJob jobs[5] = {{F.in[8], DM, INA, W + W0_IN}, {F.in[9], DM, DM, W + W0_OUT}, {F.in[34], DM, DFF, W + W0_G}, {F.in[35], DM, DFF, W + W0_V}, {F.in[38], DFF, DM, W + W0_D}};
        transpose_jobs<5>(F, jobs); p0_ada(F); p0_lam(F); p0_hyena_mlp(F);
    }
    SEAM(0);
    if (IN(1)) norm_phase(F, F.in[0], 0, 0, true);
    SEAM(1);
    if (IN(2)) { pg8::EpiBf16<0> E{WSB(WS_P), INA, nullptr, 0, 0, 1.f}; run_gemm(F, WSB(WS_H), W + W0_IN, MALL, INA, DM, E); }
    SEAM(2);
    if (IN(3)) p3_rope(F);
    SEAM(3);
    if (IN(4)) p4_attention(F);
    SEAM(4);
    if (IN(5)) { pg8::EpiRes E{F.in[0], F.out, DM, WSF(WS_M) + 2 * DM, F.in[5] + 2 * DM}; run_gemm(F, WSB(WS_H), W + W0_OUT, MT, DM, DM, E); }
    SEAM(5);
    if (IN(6)) norm_phase(F, F.out, 0, 1, false);
    SEAM(6);
    if (IN(7)) ffn_phases(F, 0, 0, W0_G, W0_V, W0_D);
    SEAM(7);
    if (IN(8)) ffn_phases(F, 0, 1, W0_G, W0_V, W0_D);
    SEAM(8);
    if (IN(9)) ffn_phases(F, 0, 2, W0_G, W0_V, W0_D);
    SEAM(9);
    if (IN(10)) {
        const TJob jobs[5] = {{F.in[20], DM, HY3, W + W1_IN}, {F.in[33], DM, DM, W + W1_OUT}, {F.in[34] + (size_t)DM * DFF, DM, DFF, W + W1_G}, {F.in[35] + (size_t)DM * DFF, DM, DFF, W + W1_V}, {F.in[38] + (size_t)DFF * DM, DFF, DM, W + W1_D}};
        transpose_jobs<5>(F, jobs); norm_phase(F, F.out, 1, 0, false);
    }
    SEAM(10);
    if (IN(11)) { pg8::EpiBf16<0> E{WSB(WS_P), HY3, F.in[21], 0, 0, 1.f}; run_gemm(F, WSB(WS_H), W + W1_IN, MT, HY3, DM, E); }
    SEAM(11);
    if (IN(12)) p12_shortconv(F);
    SEAM(12);
    if (IN(13)) p13_filters(F);
    SEAM(13);
    if (IN(14)) p14_longconv(F);
    SEAM(14);
    if (IN(15)) p15_transpose_y(F);
    SEAM(15);
    if (IN(16)) { pg8::EpiRes E{F.out, F.out, DM, WSF(WS_M) + 3 * 12288 + 2 * DM, F.in[5] + 12288 + 2 * DM}; run_gemm(F, WSB(WS_H), W + W1_OUT, MT, DM, DM, E); }
    SEAM(16);
    if (IN(17)) norm_phase(F, F.out, 1, 1, false);
    SEAM(17);
    if (IN(18)) ffn_phases(F, 1, 0, W1_G, W1_V, W1_D);
    SEAM(18);
    if (IN(19)) ffn_phases(F, 1, 1, W1_G, W1_V, W1_D);
    SEAM(19);
    if (IN(20)) ffn_phases(F, 1, 2, W1_G, W1_V, W1_D);
#undef IN
#undef SEAM
}
#ifndef MK_MULTI
#define MK_MULTI 0
#endif
extern "C" void kernel_launch(void* const* d_in, const int* in_sizes, int n_in, void* d_out, int out_size, void* d_ws, size_t ws_size, hipStream_t stream) {
    static int grid = 0;
    if (grid == 0) {
        if (n_in != 39 || in_sizes[0] != MT * DM || out_size != MT * DM || ws_size < WS_END) { fprintf(stderr, "kernel_launch: unexpected shapes (n_in %d in0 %d out %d ws %zu)\n", n_in, n_in > 0 ? in_sizes[0] : -1, out_size, ws_size); grid = -1; return; }
        int dev = 0, cus = 0, per_cu = 0;
        hipGetDevice(&dev); hipDeviceGetAttribute(&cus, hipDeviceAttributeMultiprocessorCount, dev);
        if (hipFuncSetAttribute((const void*)mega_fwd, hipFuncAttributeMaxDynamicSharedMemorySize, LDS_BYTES) != hipSuccess) { fprintf(stderr, "kernel_launch: hipFuncSetAttribute failed\n"); grid = -1; return; }
        if (hipOccupancyMaxActiveBlocksPerMultiprocessor(&per_cu, (const void*)mega_fwd, 512, LDS_BYTES) != hipSuccess || per_cu < 1) { fprintf(stderr, "kernel_launch: occupancy query says %d\n", per_cu); per_cu = 1; }
        (void)hipGetLastError();
        grid = cus * per_cu;
    }
    if (grid < 0) return;
    hipMemsetAsync((char*)d_ws + WS_M, 0, CTL_ZERO_BYTES, stream);
    Args a{};
    for (int i = 0; i < 39; ++i) a.in[i] = (const float*)d_in[i];
    a.out = (float*)d_out; a.ws = (unsigned char*)d_ws;
#if MK_MULTI
    for (int p = 0; p < NPHASE; ++p) { a.ph_lo = p; a.ph_hi = p + 1; hipLaunchKernelGGL(mega_fwd, dim3(grid), dim3(512), LDS_BYTES, stream, a); }
#else
    a.ph_lo = 0; a.ph_hi = NPHASE;
    void* kargs[] = {&a};
    hipError_t e = hipLaunchCooperativeKernel((const void*)mega_fwd, dim3(grid), dim3(512), kargs, LDS_BYTES, stream);
    if (e != hipSuccess) fprintf(stderr, "cooperative launch failed: %s (grid %d)\n", hipGetErrorString(e), grid);
#endif
}
```

```cpp
#include <hip/hip_runtime.h>
#include <cstdio>
#include <cstdint>
namespace pg8 {
#define PG8_LAS __attribute__((address_space(3)))
typedef unsigned short bf16_t;
typedef short bf16x8 __attribute__((ext_vector_type(8)));
typedef float f32x4 __attribute__((ext_vector_type(4)));
typedef unsigned u32x4 __attribute__((ext_vector_type(4)));
constexpr int BM = 256, BK = 64, HALF = 128, HTB = HALF * BK * 2  , STAGE_BYTES = 8 * HTB, NXCD = 8, WGM = 8;

__host__ __device__ __forceinline__ int lds_byte(int r, int c) { const int st = (r >> 4) * 2 + (c >> 5), rr = r & 15, cc = c & 31, ob = rr * 64 + cc * 2; return st * 1024 + (ob ^ (((ob >> 9) & 1) << 5)); }
__host__ __device__ __forceinline__ void stage_rc(int b, int& R, int& C) { const int st = b / 1024, sb = b % 1024, swz = sb ^ (((sb >> 9) & 1) << 5); R = (st >> 1) * 16 + swz / 64; C = (st & 1) * 32 + (swz % 64) / 2; }
__host__ __device__ __forceinline__ int perm32(int rho) { const int n = rho >> 4, i = rho & 15; return 8 * (i >> 2) + 4 * n + (i & 3); }

struct Unit { int pm, pn; };
struct Gemm { const bf16_t* A; const bf16_t* Bt; int M, N, K; };

struct StaticOrder {
    int nM, nN, nwg, G, c;
    __host__ __device__ void init(int M, int N, int G_, int c_) { nM = M / BM; nN = N / BM; nwg = nM * nN; G = G_; c = c_; }
    __host__ __device__ bool next(int i, Unit& u) const {
        const long L = (long)i * G + c; if (L >= nwg) return false;
        int wgid = (int)L; { const int q = nwg / NXCD, r = nwg % NXCD, xcd = wgid % NXCD, off = wgid / NXCD; wgid = (xcd < r ? xcd * (q + 1) : r * (q + 1) + (xcd - r) * q) + off; }
        const int nig = WGM * nN, gid = wgid / nig, fm = gid * WGM, gsz = (nM - fm) < WGM ? (nM - fm) : WGM;
        u.pm = fm + ((wgid % nig) % gsz); u.pn = (wgid % nig) / gsz; return true;
    }
    __device__ __forceinline__ void a_ready(const Unit&) const {}
    __device__ __forceinline__ void done(const Unit&) const {}
};

__device__ __forceinline__ unsigned cvt_pk_bf16(float lo, float hi) { unsigned r; asm volatile("v_cvt_pk_bf16_f32 %0, %1, %2" : "=v"(r) : "v"(lo), "v"(hi)); return r; }
typedef float f32x2 __attribute__((ext_vector_type(2)));
__device__ __forceinline__ f32x2 gelu_pk(f32x2 v) {
    const f32x2 av = __builtin_elementwise_abs(v), d = av * 0.2316418882f + 1.0f;
    f32x2 t; t.x = __builtin_amdgcn_rcpf(d.x); t.y = __builtin_amdgcn_rcpf(d.y);
    f32x2 q = t * 0.5307027145f + (-0.7265760135f); q = q * t + 0.7107068705f; q = q * t + (-0.142248368f); q = q * t + 0.127414796f; q = q * t;
    const f32x2 s = (v * v) * (-0.72134752044f);
    f32x2 e; e.x = __builtin_amdgcn_exp2f(s.x); e.y = __builtin_amdgcn_exp2f(s.y);
    const f32x2 m = v * (q * e), r = v - m;
    f32x2 o; o.x = v.x < 0.f ? m.x : r.x; o.y = v.y < 0.f ? m.y : r.y; return o;
}

template <int ACT  > struct EpiBf16 {
    static constexpr bool PERM = true, AFTER_DRAIN = false; static_assert(ACT == 0 || ACT == 1, "EpiBf16: ACT is 0 (none) or 1 (gelu_pk)");
    bf16_t* O; int ldc; const float* bias; int split_cols; size_t split_stride; float scale0;
    __device__ __forceinline__ void operator()(const f32x4 (&acc)[2][2][4][2], const Unit& u, int wr, int wc, int fr, int fq) const {
        const int row0 = u.pm * BM + wr * 64 + fr; int colt = u.pn * BM; bf16_t* base = O;
        float sc = 1.f; if (split_cols) { const int t = colt / split_cols; base += (size_t)t * split_stride; colt -= t * split_cols; if (t == 0) sc = scale0; }
        const int col0 = colt + wc * 32 + 8 * fq, bcol0 = u.pn * BM + wc * 32 + 8 * fq;
        f32x4 bv[2][2];
#pragma unroll
        for (int bj = 0; bj < 2; ++bj)
#pragma unroll
            for (int n = 0; n < 2; ++n) bv[bj][n] = bias ? *(const f32x4*)(bias + bcol0 + bj * HALF + 4 * n) : (f32x4){0.f, 0.f, 0.f, 0.f};
#pragma unroll
        for (int ai = 0; ai < 2; ++ai)
#pragma unroll
            for (int m = 0; m < 4; ++m) { bf16_t* rowp = base + (size_t)(row0 + ai * HALF + m * 16) * ldc + col0;
#pragma unroll
                for (int bj = 0; bj < 2; ++bj) { f32x4 v0 = acc[ai][bj][m][0] + bv[bj][0], v1 = acc[ai][bj][m][1] + bv[bj][1];
                    if (ACT == 1) { f32x2 a = gelu_pk((f32x2){v0[0], v0[1]}), b = gelu_pk((f32x2){v0[2], v0[3]}), c = gelu_pk((f32x2){v1[0], v1[1]}), d = gelu_pk((f32x2){v1[2], v1[3]});
                        v0 = (f32x4){a.x, a.y, b.x, b.y}; v1 = (f32x4){c.x, c.y, d.x, d.y}; }
                    v0 = v0 * sc; v1 = v1 * sc; u32x4 w; w.x = cvt_pk_bf16(v0[0], v0[1]); w.y = cvt_pk_bf16(v0[2], v0[3]); w.z = cvt_pk_bf16(v1[0], v1[1]); w.w = cvt_pk_bf16(v1[2], v1[3]);
                    *(u32x4*)(rowp + bj * HALF) = w; } }
    }
};
struct EpiRes {
    static constexpr bool PERM = false, AFTER_DRAIN = false;
    const float* base; float* out; int ldc; const float* gm; const float* gb;
    __device__ __forceinline__ void operator()(const f32x4 (&acc)[2][2][4][2], const Unit& u, int wr, int wc, int fr, int fq) const {
        const int col0 = u.pn * BM + wc * 32 + 4 * fq; const int b = u.pm >> 6;
        const float* gmb = gm + (size_t)b * 12288;
        const size_t rowoff = (size_t)(u.pm * BM + wr * 64 + fr) * ldc;
#pragma unroll
        for (int bj = 0; bj < 2; ++bj)
#pragma unroll
          for (int ai = 0; ai < 2; ++ai) {
            f32x4 gt[2], bs[4][2];
#pragma unroll
            for (int n = 0; n < 2; ++n) { const int c = col0 + bj * HALF + n * 16; gt[n] = *(const f32x4*)(gmb + c) + *(const f32x4*)(gb + c); }
#pragma unroll
                for (int m = 0; m < 4; ++m)
#pragma unroll
                    for (int n = 0; n < 2; ++n) bs[m][n] = *(const f32x4*)(base + rowoff + (size_t)(ai * HALF + m * 16) * ldc + col0 + bj * HALF + n * 16);
#pragma unroll
                for (int m = 0; m < 4; ++m)
#pragma unroll
                    for (int n = 0; n < 2; ++n) *(f32x4*)(out + rowoff + (size_t)(ai * HALF + m * 16) * ldc + col0 + bj * HALF + n * 16) = bs[m][n] + gt[n] * acc[ai][bj][m][n];
            asm volatile("" ::: "memory"); }
    }
};
struct EpiGlu {
    static constexpr bool PERM = true, AFTER_DRAIN = false;
    const bf16_t* G; bf16_t* U; int ldc; const float* cw; const float* cb;
    __device__ __forceinline__ void operator()(const f32x4 (&acc)[2][2][4][2], const Unit& u, int wr, int wc, int fr, int fq) const {
        typedef unsigned u32x2 __attribute__((ext_vector_type(2)));
        const int row0 = u.pm * BM + wr * 64 + fr;
#pragma unroll
        for (int bj = 0; bj < 2; ++bj)
#pragma unroll
            for (int n = 0; n < 2; ++n) { const int c0 = u.pn * BM + bj * HALF + wc * 32 + 8 * fq + 4 * n;
                const f32x4 w0 = *(const f32x4*)(cw + c0), w1 = *(const f32x4*)(cw + ldc + c0), w2 = *(const f32x4*)(cw + 2 * ldc + c0), bb = *(const f32x4*)(cb + c0);
                u32x2 g0[8], gm[8], gn[8];
#pragma unroll
                for (int it = 0; it < 8; ++it) { const int row = row0 + (it >> 2) * HALF + (it & 3) * 16; const int t = row & 16383;
                    const bf16_t* gp = G + (size_t)row * ldc + c0;
                    g0[it] = *(const u32x2*)gp; gm[it] = *(const u32x2*)(t > 0 ? gp - ldc : gp); gn[it] = *(const u32x2*)(t < 16383 ? gp + ldc : gp); }
#pragma unroll
                for (int it = 0; it < 8; ++it) { const int ai = it >> 2, m = it & 3; const int row = row0 + ai * HALF + m * 16; const int t = row & 16383;
                    const float fm = t > 0 ? 1.f : 0.f, fn = t < 16383 ? 1.f : 0.f;
                    u32x2 o;
#pragma unroll
                    for (int e = 0; e < 2; ++e) {
                        float r2[2];
#pragma unroll
                        for (int hh = 0; hh < 2; ++hh) {
                            const float a0 = hh ? __uint_as_float(g0[it][e] & 0xffff0000u) : __uint_as_float(g0[it][e] << 16);
                            const float am = (hh ? __uint_as_float(gm[it][e] & 0xffff0000u) : __uint_as_float(gm[it][e] << 16)) * fm;
                            const float an = (hh ? __uint_as_float(gn[it][e] & 0xffff0000u) : __uint_as_float(gn[it][e] << 16)) * fn;
                            const float g = w0[2 * e + hh] * am + w1[2 * e + hh] * a0 + w2[2 * e + hh] * an + bb[2 * e + hh];
                            const float ex = __builtin_amdgcn_exp2f(-2.3022082f * g * (1.f + 0.044715f * g * g));
                            r2[hh] = g * __builtin_amdgcn_rcpf(1.f + ex) * acc[ai][bj][m][n][2 * e + hh];
                        }
                        o[e] = cvt_pk_bf16(r2[0], r2[1]);
                    }
                    *(u32x2*)(U + (size_t)row * ldc + c0) = o; }
                asm volatile("" ::: "memory");
            }
    }
};
template <class Epi, class Sched, bool ALIGN_EPI = false, bool SP2 = false>
__device__ __forceinline__ void gemm_phase(PG8_LAS unsigned char* lds, const Gemm g, const Sched& S, const Epi& E) {
    const int tid = threadIdx.x, wid = __builtin_amdgcn_readfirstlane(tid >> 6), lane = tid & 63, wr = wid >> 2, wc = wid & 3, fr = lane & 15, fq = lane >> 4;
    const int K = g.K, nt = K / BK;
    unsigned voffA[2], voffB[2];
#pragma unroll
    for (int i = 0; i < 2; ++i) { int R, C; stage_rc(tid * 16 + i * 8192, R, C); const int Rb = Epi::PERM ? ((R & ~31) + perm32(R & 31)) : R;
        voffA[i] = (unsigned)(R * K + C) * 2u; voffB[i] = (unsigned)(Rb * K + C) * 2u; }
    const size_t kstep = (size_t)(BK * 2);
    const size_t hstep = (size_t)HALF * K * 2;
    const size_t tstep = 2 * hstep;
    const unsigned ldsw = (unsigned)wid * 1024u;
    const int aoff = lds_byte(wr * 64 + fr, fq * 8), boff = lds_byte(wc * 32 + fr, fq * 8);
#define PG8_SA(b, h) (((b) * 2 + (h)) * HTB)
#define PG8_SB(b, h) ((4 + (b) * 2 + (h)) * HTB)
#define PG8_STAGE(bufoff, gbase, voff) do { _Pragma("unroll") for (int _i = 0; _i < 2; ++_i) \
        __builtin_amdgcn_global_load_lds((const unsigned*)((const char*)(gbase) + (voff)[_i]), (PG8_LAS unsigned*)(lds + (bufoff) + ldsw + _i * 8192), 16, 0, 0); } while (0)
#define PG8_LDA(dst, b, h) do { _Pragma("unroll") for (int m = 0; m < 4; ++m) _Pragma("unroll") for (int k = 0; k < 2; ++k) dst[m][k] = *(const PG8_LAS bf16x8*)(lds + PG8_SA(b, h) + aoff + m * 2048 + k * 1024); } while (0)
#define PG8_LDB(dst, b, h) do { _Pragma("unroll") for (int n = 0; n < 2; ++n) _Pragma("unroll") for (int k = 0; k < 2; ++k) dst[n][k] = *(const PG8_LAS bf16x8*)(lds + PG8_SB(b, h) + boff + n * 2048 + k * 1024); } while (0)
#define PG8_MMA(ai, bj, At, Bt) do { __builtin_amdgcn_s_setprio(1); _Pragma("unroll") for (int m = 0; m < 4; ++m) _Pragma("unroll") for (int n = 0; n < 2; ++n) _Pragma("unroll") for (int k = 0; k < 2; ++k) \
        acc[ai][bj][m][n] = __builtin_amdgcn_mfma_f32_16x16x32_bf16(Bt[n][k], At[m][k], acc[ai][bj][m][n], 0, 0, 0); __builtin_amdgcn_s_setprio(0); } while (0)
#define PG8_WAIT_V(n) asm volatile("s_waitcnt vmcnt(" #n ")" ::: "memory")
#define PG8_WAIT_L(n) asm volatile("s_waitcnt lgkmcnt(" #n ")" ::: "memory")
#define PG8_BAR __builtin_amdgcn_s_barrier()
#define PG8_SCHED __builtin_amdgcn_sched_barrier(0)
    Unit cur, nxt; int ui = 0;
    if (!S.next(0, cur)) return;
    f32x4 acc[2][2][4][2];
#pragma unroll
    for (int a = 0; a < 2; ++a)
#pragma unroll
        for (int b = 0; b < 2; ++b)
#pragma unroll
            for (int m = 0; m < 4; ++m)
#pragma unroll
                for (int n = 0; n < 2; ++n) acc[a][b][m][n] = (f32x4){0.f, 0.f, 0.f, 0.f};
    bf16x8 At[4][2], B0[2][2], B1[2][2];
    const char* cA = (const char*)g.A + (size_t)cur.pm * tstep; const char* cB = (const char*)g.Bt + (size_t)cur.pn * tstep;
    S.a_ready(cur);
    if constexpr (SP2) {
        PG8_STAGE(PG8_SB(0, 0), cB, voffB); PG8_STAGE(PG8_SB(0, 1), cB + hstep, voffB); PG8_STAGE(PG8_SA(0, 0), cA, voffA); PG8_STAGE(PG8_SA(0, 1), cA + hstep, voffA);
        if (wr == 1) PG8_BAR;
        PG8_WAIT_V(2); PG8_BAR;
        PG8_STAGE(PG8_SB(1, 0), cB + kstep, voffB); PG8_STAGE(PG8_SA(1, 0), cA + kstep, voffA); PG8_STAGE(PG8_SB(1, 1), cB + hstep + kstep, voffB);
        PG8_WAIT_V(6); PG8_BAR;
    } else {
        PG8_STAGE(PG8_SB(0, 0), cB, voffB); PG8_STAGE(PG8_SA(0, 0), cA, voffA); PG8_STAGE(PG8_SB(0, 1), cB + hstep, voffB); PG8_STAGE(PG8_SA(0, 1), cA + hstep, voffA);
        if (wr == 1) PG8_BAR;
        PG8_WAIT_V(4); PG8_BAR;
        PG8_STAGE(PG8_SB(1, 0), cB + kstep, voffB); PG8_STAGE(PG8_SA(1, 0), cA + kstep, voffA); PG8_STAGE(PG8_SB(1, 1), cB + hstep + kstep, voffB);
        PG8_WAIT_V(6); PG8_BAR;
    }
    for (;;) {
        const bool has_next = S.next(ui + 1, nxt);
        const char* nA = has_next ? (const char*)g.A + (size_t)nxt.pm * tstep : cA; const char* nB = has_next ? (const char*)g.Bt + (size_t)nxt.pn * tstep : cB;
        for (int t = 0; t < nt; t += 2) {
            const bool last = (t == nt - 2);
            const char* a1 = cA + (size_t)(t + 1) * kstep;
            const char* a2 = last ? nA : cA + (size_t)(t + 2) * kstep; const char* b2 = last ? nB : cB + (size_t)(t + 2) * kstep;
            const char* a3 = a2 + kstep; const char* b3 = b2 + kstep;
            if (last && has_next) S.a_ready(nxt);
            if constexpr (SP2) {
            PG8_LDB(B0, 0, 0); PG8_LDB(B1, 0, 1); PG8_SCHED; PG8_LDA(At, 0, 0); PG8_STAGE(PG8_SA(1, 1), a1 + hstep, voffA);
            PG8_WAIT_V(8); PG8_WAIT_L(0); PG8_BAR; PG8_MMA(0, 0, At, B0); PG8_MMA(0, 1, At, B1); PG8_BAR; PG8_SCHED;
            PG8_LDA(At, 0, 1); PG8_STAGE(PG8_SB(0, 0), b2, voffB); PG8_STAGE(PG8_SB(0, 1), b2 + hstep, voffB); PG8_STAGE(PG8_SA(0, 0), a2, voffA);
            PG8_WAIT_V(8); PG8_WAIT_L(0); PG8_BAR; PG8_MMA(1, 0, At, B0); PG8_MMA(1, 1, At, B1); PG8_BAR; PG8_SCHED;
            PG8_LDB(B0, 1, 0); PG8_LDB(B1, 1, 1); PG8_SCHED; PG8_LDA(At, 1, 0); PG8_STAGE(PG8_SA(0, 1), a2 + hstep, voffA);
            PG8_WAIT_V(8); PG8_WAIT_L(0); PG8_BAR; PG8_MMA(0, 0, At, B0); PG8_MMA(0, 1, At, B1); PG8_BAR; PG8_SCHED;
            PG8_LDA(At, 1, 1); PG8_STAGE(PG8_SB(1, 0), b3, voffB); PG8_STAGE(PG8_SB(1, 1), b3 + hstep, voffB); PG8_STAGE(PG8_SA(1, 0), a3, voffA);
            PG8_WAIT_V(8); PG8_WAIT_L(0); PG8_BAR; PG8_MMA(1, 0, At, B0); PG8_MMA(1, 1, At, B1); PG8_BAR; PG8_SCHED;
            } else {
            PG8_LDB(B0, 0, 0); PG8_SCHED; PG8_LDA(At, 0, 0); PG8_STAGE(PG8_SA(1, 1), a1 + hstep, voffA);
            PG8_WAIT_L(8); PG8_BAR; PG8_WAIT_L(0); PG8_MMA(0, 0, At, B0); PG8_BAR; PG8_SCHED;
            PG8_LDB(B1, 0, 1); PG8_STAGE(PG8_SB(0, 0), b2, voffB);
            PG8_BAR; PG8_WAIT_L(0); PG8_MMA(0, 1, At, B1); PG8_BAR;
            PG8_LDA(At, 0, 1); PG8_STAGE(PG8_SA(0, 0), a2, voffA);
            PG8_BAR; PG8_WAIT_L(0); PG8_MMA(1, 0, At, B0); PG8_BAR; PG8_SCHED;
            PG8_STAGE(PG8_SB(0, 1), b2 + hstep, voffB);
            PG8_WAIT_V(6); PG8_BAR; PG8_MMA(1, 1, At, B1); PG8_BAR;
            PG8_LDB(B0, 1, 0); PG8_SCHED; PG8_LDA(At, 1, 0); PG8_STAGE(PG8_SA(0, 1), a2 + hstep, voffA);
            PG8_WAIT_L(8); PG8_BAR; PG8_WAIT_L(0); PG8_MMA(0, 0, At, B0); PG8_BAR; PG8_SCHED;
            PG8_LDB(B1, 1, 1); PG8_STAGE(PG8_SB(1, 0), b3, voffB);
            PG8_BAR; PG8_WAIT_L(0); PG8_MMA(0, 1, At, B1); PG8_BAR;
            PG8_LDA(At, 1, 1); PG8_STAGE(PG8_SA(1, 0), a3, voffA);
            PG8_BAR; PG8_WAIT_L(0); PG8_MMA(1, 0, At, B0); PG8_BAR; PG8_SCHED;
            PG8_STAGE(PG8_SB(1, 1), b3 + hstep, voffB);
            PG8_WAIT_V(6); PG8_BAR; PG8_MMA(1, 1, At, B1); PG8_BAR;
            }
        }
        if constexpr (ALIGN_EPI) { if (wr == 0) PG8_BAR; }
        if constexpr (!Epi::AFTER_DRAIN) { E(acc, cur, wr, wc, fr, fq); S.done(cur); }
        if (!has_next) break;
#pragma unroll
        for (int a = 0; a < 2; ++a)
#pragma unroll
            for (int b = 0; b < 2; ++b)
#pragma unroll
                for (int m = 0; m < 4; ++m)
#pragma unroll
                    for (int n = 0; n < 2; ++n) acc[a][b][m][n] = (f32x4){0.f, 0.f, 0.f, 0.f};
        cur = nxt; cA = nA; cB = nB; ++ui;
        if constexpr (ALIGN_EPI) { if (wr == 1) PG8_BAR; }
    }
    PG8_WAIT_V(0);
    if constexpr (!ALIGN_EPI) { if (wr == 0) PG8_BAR; }
    PG8_BAR;
    if constexpr (Epi::AFTER_DRAIN) { E.fused(acc, cur, wr, wc, fr, fq, lds, wid, lane); S.done(cur); }
#undef PG8_SA
#undef PG8_SB
#undef PG8_STAGE
#undef PG8_LDA
#undef PG8_LDB
#undef PG8_MMA
#undef PG8_WAIT_V
#undef PG8_WAIT_L
#undef PG8_BAR
#undef PG8_SCHED
}
}
#include <hip/hip_cooperative_groups.h>
namespace cg = cooperative_groups;

constexpr int DM = 2048, NBATCH = 2, SEQ = 16384, CTXL = 256, MT = NBATCH * SEQ, MC = NBATCH * CTXL, MALL = MT + MC;
constexpr int INA = 4608, DFF = 5632, HY3 = 6144, NKEY = CTXL + SEQ  , NVH = 10;
constexpr float EPSN = 1e-6f, LOG2E = 1.4426950408889634f;
constexpr size_t MiB = 1u << 20;
constexpr size_t WS_M = 0;
constexpr size_t CTL_ZERO_BYTES = 512 * 1024;
constexpr size_t WS_LAM = 1 * MiB;
constexpr size_t WS_A3 = 2 * MiB;
constexpr size_t WS_W3T = 1008 * MiB;
constexpr size_t WS_W = 12 * MiB;
constexpr size_t WS_H = 110 * MiB;
constexpr size_t WS_P = 240 * MiB;
constexpr size_t WS_VT = 533 * MiB;
constexpr size_t WS_U = 592 * MiB;
constexpr size_t WS_T = 624 * MiB;
constexpr size_t WS_FILT = 238 * MiB + 2 * MiB;
constexpr size_t WS_SPEC = 500 * MiB;
constexpr size_t SPEC_SLOT = 135168;
constexpr size_t WS_END = 1024 * MiB;
static_assert(WS_FILT == WS_P, "filters overlay Z");
static_assert(WS_W + 98 * MiB <= WS_H && WS_H + (size_t)MALL * DM * 2 <= WS_P && WS_P + (size_t)MALL * INA * 2 <= WS_VT, "ws map 1");
static_assert(WS_VT + (size_t)NBATCH * NVH * 128 * NKEY * 2 <= WS_U + 30 * MiB, "ws map 2");
static_assert(WS_P + (size_t)MT * DFF * 2 <= WS_U && WS_U + (size_t)MT * DFF * 2 <= WS_END, "ws map 3");
static_assert(WS_P + (size_t)MT * HY3 * 2 <= WS_T && WS_T + (size_t)3 * MT * DM * 2 <= WS_END, "ws map 4");
static_assert(WS_FILT + (size_t)4 * DM * SEQ * 2 <= WS_SPEC && WS_SPEC + 256 * SPEC_SLOT <= WS_T, "ws map 5");
constexpr size_t W0_IN = 0, W0_OUT = W0_IN + (size_t)INA * DM, W0_G = W0_OUT + (size_t)DM * DM, W0_V = W0_G + (size_t)DFF * DM, W0_D = W0_V + (size_t)DFF * DM;
constexpr size_t W1_IN = 0, W1_OUT = W1_IN + (size_t)HY3 * DM, W1_G = W1_OUT + (size_t)DM * DM, W1_V = W1_G + (size_t)DFF * DM, W1_D = W1_V + (size_t)DFF * DM;
static_assert((W1_D + (size_t)DFF * DM) * 2 <= 98 * MiB, "weights region");

constexpr int RING_BYTES = 131072, MISC_OFF = 147456, LDS_BYTES = 147456 + 256;
constexpr size_t WS_BAR = 384 * 1024;
#define LAS __attribute__((address_space(3)))
typedef unsigned short bf16;
typedef unsigned v4u __attribute__((ext_vector_type(4)));
typedef unsigned v2u __attribute__((ext_vector_type(2)));
typedef float f32x4 __attribute__((ext_vector_type(4)));
typedef float f32x16 __attribute__((ext_vector_type(16)));
typedef short bf16x8 __attribute__((ext_vector_type(8)));
typedef float f32x2_t __attribute__((ext_vector_type(2))); typedef __bf16 bf16x2_t __attribute__((ext_vector_type(2)));
#define DI __device__ __forceinline__
DI unsigned cvtpk(float lo, float hi) { f32x2_t v = {lo, hi}; bf16x2_t b = __builtin_convertvector(v, bf16x2_t); return __builtin_bit_cast(unsigned, b); }
DI float bflo(unsigned w) { return __uint_as_float(w << 16); }
DI float bfhi(unsigned w) { return __uint_as_float(w & 0xffff0000u); }
DI float bf1(unsigned short v) { return __uint_as_float((unsigned)v << 16); }
DI float wave_sum(float v) {
#pragma unroll
    for (int o = 1; o < 64; o <<= 1) v += __shfl_xor(v, o);
    return v;
}
DI float fsin_rev(float r) { return __builtin_amdgcn_sinf(r); }
DI float fcos_rev(float r) { return __builtin_amdgcn_cosf(r); }
DI float fsin_rad(float x) { return __builtin_amdgcn_sinf(x * 0.15915494309189535f); }

struct Frame {
    unsigned char* lds; int tid, lane, wave, gw, NGW;
    const float* in[39]; float* out; unsigned char* ws;
};
#define WSF(off) ((float*)(F.ws + (off)))
#define WSB(off) ((bf16*)(F.ws + (off)))

DI void transpose_item(const float* W, int K, int N, bf16* WT, float* scr, int item, int lane) {
    const int nblk = N / 32, kb = item / nblk, nb = item % nblk, k0 = 64 * kb, n0 = 32 * nb;
#pragma unroll 8
    for (int i = 0; i < 32; ++i) { const int kk = 2 * i + (lane >> 5); scr[kk * 33 + (lane & 31)] = W[(size_t)(k0 + kk) * N + n0 + (lane & 31)]; }
    __builtin_amdgcn_fence(__ATOMIC_RELEASE, "wavefront"); asm volatile("s_waitcnt lgkmcnt(0)" ::: "memory");
    const int c = lane & 7;
#pragma unroll
    for (int j = 0; j < 4; ++j) { const int n = (lane >> 3) + 8 * j; const float* s = scr + (8 * c) * 33 + n;
        v4u o; o.x = cvtpk(s[0 * 33], s[1 * 33]); o.y = cvtpk(s[2 * 33], s[3 * 33]); o.z = cvtpk(s[4 * 33], s[5 * 33]); o.w = cvtpk(s[6 * 33], s[7 * 33]);
        *(v4u*)(WT + (size_t)(n0 + n) * K + k0 + 8 * c) = o; }
    asm volatile("s_waitcnt lgkmcnt(0)" ::: "memory");
}
struct TJob { const float* W; int K, N; bf16* WT; };
template <int NJ> DI void transpose_jobs(Frame& F, const TJob (&jobs)[NJ]) {
    float* scr = (float*)(F.lds + F.wave * 16384);
    int tot = 0;
#pragma unroll
    for (int j = 0; j < NJ; ++j) tot += (jobs[j].K / 64) * (jobs[j].N / 32);
    for (int it = F.gw; it < tot; it += F.NGW) {
        int r = it;
#pragma unroll
        for (int j = 0; j < NJ; ++j) { const int n = (jobs[j].K / 64) * (jobs[j].N / 32);
            if (r >= 0 && r < n) transpose_item(jobs[j].W, jobs[j].K, jobs[j].N, jobs[j].WT, scr, r, F.lane);
            r -= n; }
    }
}
DI float silu(float x) { return x / (1.f + __expf(-x)); }

DI void p0_ada(Frame& F) {
    const float* ada_w = F.in[4]; const float* c = F.in[1]; const float* cctx = F.in[3]; float* M = WSF(WS_M);
    for (int it = F.gw; it < 1536; it += F.NGW) {
        const int l = it / 768, rem = it % 768, kc = rem / 48, ng = rem % 48;
        const float* W = ada_w + (size_t)l * DM * 12288 + (size_t)(kc * 128) * 12288 + ng * 256 + F.lane * 4;
        f32x4 a0 = {0, 0, 0, 0}, a1 = a0, a2 = a0;
#pragma unroll 8
        for (int k = 0; k < 128; ++k) { const f32x4 w = *(const f32x4*)(W + (size_t)k * 12288); const int kk = kc * 128 + k;
            const float s0 = silu(c[kk]), s1 = silu(c[DM + kk]), s2 = silu(cctx[kk]);
            a0 += w * s0; a1 += w * s1; a2 += w * s2; }
        float* m0 = M + (size_t)(l * 3) * 12288 + ng * 256 + F.lane * 4;
#pragma unroll
        for (int e = 0; e < 4; ++e) { unsafeAtomicAdd(m0 + e, a0[e]); unsafeAtomicAdd(m0 + 12288 + e, a1[e]); unsafeAtomicAdd(m0 + 2 * 12288 + e, a2[e]); }
    }
}
DI void p0_hyena_mlp(Frame& F) {
    const float *w0 = F.in[24], *b0 = F.in[25], *w1 = F.in[26], *b1 = F.in[27], *w2 = F.in[28], *b2 = F.in[29], *fq = F.in[30];
    bf16* a3 = WSB(WS_A3); const int lane = F.lane; const float freq = fq[lane];
    for (int pg = F.gw; pg < 2048; pg += F.NGW) {
        float a[8], acc[8];
#pragma unroll
        for (int q = 0; q < 8; ++q) { const float pos = (float)(pg * 8 + q); float z = 0.f;
            if (lane == 0) z = pos / 16383.f;
            else if (lane <= 32) { const int i = (lane - 1) & 15; const float f = 1e-4f + (float)i * ((15.f - 1e-4f) / 15.f); const float rev = f * pos * (1.f / 16384.f);
                z = lane <= 16 ? fcos_rev(rev) : -fsin_rev(rev); }
            a[q] = z; acc[q] = b0[lane]; }
        for (int i = 0; i < 33; ++i) { const float w = w0[i * 64 + lane];
#pragma unroll
            for (int q = 0; q < 8; ++q) acc[q] += __shfl(a[q], i) * w; }
#pragma unroll
        for (int q = 0; q < 8; ++q) { a[q] = fsin_rad(freq * acc[q]); acc[q] = b1[lane]; }
        for (int i = 0; i < 64; ++i) { const float w = w1[i * 64 + lane];
#pragma unroll
            for (int q = 0; q < 8; ++q) acc[q] += __shfl(a[q], i) * w; }
#pragma unroll
        for (int q = 0; q < 8; ++q) { a[q] = fsin_rad(freq * acc[q]); acc[q] = b2[lane]; }
        for (int i = 0; i < 64; ++i) { const float w = w2[i * 64 + lane];
#pragma unroll
            for (int q = 0; q < 8; ++q) acc[q] += __shfl(a[q], i) * w; }
#pragma unroll
        for (int q = 0; q < 8; ++q) { const float v = fsin_rad(freq * acc[q]); const unsigned hi = cvtpk(v, 0.f) & 0xffffu; const unsigned lo = cvtpk(v - __uint_as_float(hi << 16), 0.f) & 0xffffu;
            bf16* o = a3 + (size_t)(pg * 8 + q) * 256 + lane; o[0] = (bf16)hi; o[64] = (bf16)lo; o[128] = (bf16)hi; o[192] = 0; }
    }
    { const float* w3 = F.in[31]; bf16* w3t = WSB(WS_W3T);
      for (int idx = blockIdx.x * 512 + F.tid; idx < 64 * 8192; idx += gridDim.x * 512) { const int j = idx >> 13, n = idx & 8191; const float v = w3[idx];
          const unsigned hi = cvtpk(v, 0.f) & 0xffffu; const unsigned lo = cvtpk(v - __uint_as_float(hi << 16), 0.f) & 0xffffu;
          bf16* o = w3t + (size_t)n * 256 + j; o[0] = (bf16)hi; o[64] = (bf16)hi; o[128] = (bf16)lo; o[192] = 0; } }
}
DI void p0_lam(Frame& F) {
    if (blockIdx.x == 0 && F.wave == 0) {
        const float s1 = wave_sum(F.in[12][F.lane] * F.in[13][F.lane]), s2 = wave_sum(F.in[14][F.lane] * F.in[15][F.lane]);
        if (F.lane == 0) WSF(WS_LAM)[0] = __expf(s1) - __expf(s2) + 0.2f;
    }
}
DI void norm_rows(Frame& F, const float* src, int srow0, int nrows, bf16* dst, int drow0, const float* g, const float* msc, const float* bsc, const float* msh, const float* bsh) {
    f32x4 A[8], B[8];
#pragma unroll
    for (int j = 0; j < 8; ++j) { const int c = 4 * F.lane + 256 * j;
        const f32x4 sc = *(const f32x4*)(msc + c) + *(const f32x4*)(bsc + c); A[j] = *(const f32x4*)(g + c) * (sc + 1.0f); B[j] = *(const f32x4*)(msh + c) + *(const f32x4*)(bsh + c); }
#ifndef NORM_REP
#define NORM_REP 1
#endif
#pragma unroll 1
    for (int rep = 0; rep < NORM_REP; ++rep)
    for (int r = F.gw; r < nrows; r += F.NGW) {
        const f32x4* xr = (const f32x4*)(src + (size_t)(srow0 + r) * DM) + F.lane;
        f32x4 v[8]; float ss = 0.f;
#pragma unroll
        for (int j = 0; j < 8; ++j) { v[j] = xr[64 * j]; ss += (v[j].x * v[j].x + v[j].y * v[j].y) + (v[j].z * v[j].z + v[j].w * v[j].w); }
        const float rstd = rsqrtf(wave_sum(ss) * (1.f / DM) + EPSN);
        v2u* o = (v2u*)(dst + (size_t)(drow0 + r) * DM) + F.lane;
#pragma unroll
        for (int j = 0; j < 8; ++j) { const f32x4 y = v[j] * rstd * A[j] + B[j]; v2u w; w.x = cvtpk(y.x, y.y); w.y = cvtpk(y.z, y.w); o[64 * j] = w; }
    }
}
DI void norm_phase(Frame& F, const float* src, int l, int which, bool with_ctx) {
    const float* M = WSF(WS_M) + (size_t)l * 3 * 12288; const float* ab = F.in[5] + (size_t)l * 12288;
    const float* g = (which ? F.in[7] : F.in[6]) + (size_t)l * DM; const int csh = which ? 3 : 0, csc = which ? 4 : 1;
    for (int b = 0; b < NBATCH; ++b)
        norm_rows(F, src, b * SEQ, SEQ, WSB(WS_H), b * SEQ, g, M + b * 12288 + csc * DM, ab + csc * DM, M + b * 12288 + csh * DM, ab + csh * DM);
    if (with_ctx) norm_rows(F, F.in[2], 0, MC, WSB(WS_H), MT, g, M + 2 * 12288 + csc * DM, ab + csc * DM, M + 2 * 12288 + csh * DM, ab + csh * DM);
}
template <int SEGL> DI void qk_step(bf16* p, const float* gain, float scale, bool rope, int prow, int pcol, int lane, bool store) {
    const v4u raw = *(const v4u*)p;
    float x[8];
#pragma unroll
    for (int e = 0; e < 4; ++e) { x[2 * e] = bflo(raw[e]); x[2 * e + 1] = bfhi(raw[e]); }
    float ss = 0.f;
#pragma unroll
    for (int e = 0; e < 8; ++e) ss += x[e] * x[e];
#pragma unroll
    for (int o = 1; o < SEGL; o <<= 1) ss += __shfl_xor(ss, o);
    const float rstd = rsqrtf(ss * (1.f / (8 * SEGL)) + EPSN);
    const int k = lane & (SEGL - 1);
    const f32x4 g0 = *(const f32x4*)(gain + 8 * k), g1 = *(const f32x4*)(gain + 8 * k + 4);
#pragma unroll
    for (int e = 0; e < 8; ++e) x[e] *= rstd * (e < 4 ? g0[e & 3] : g1[e & 3]);
    if (rope) {
        constexpr int NF = 2 * SEGL;
        const int axis = k / (SEGL / 2), half = (k / (SEGL / 4)) & 1, f0 = 8 * (k & (SEGL / 4 - 1));
        const float pos = (float)(axis ? pcol : prow);
#pragma unroll
        for (int e = 0; e < 8; ++e) {
            const float xp = __shfl_xor(x[e], SEGL / 4);
            const float inv = __builtin_amdgcn_exp2f(-(float)(f0 + e) * (13.287712379549449f / NF));
            const float rev = pos * inv * 0.15915494309189535f;
            const float c = fcos_rev(rev), s = fsin_rev(rev);
            x[e] = half ? (x[e] * c + xp * s) : (x[e] * c - xp * s);
        }
    }
    if (store) { v4u o;
#pragma unroll
        for (int e = 0; e < 4; ++e) o[e] = cvtpk(x[2 * e] * scale, x[2 * e + 1] * scale);
        *(v4u*)p = o; }
}
DI int vt_perm_key(int pos) { const int gq = pos >> 4, h = (pos >> 3) & 1, j = pos & 7; return 16 * gq + 8 * (j >> 2) + 4 * h + (j & 3); }
DI void p3_rope(Frame& F, bool dry) {
    bf16* P = WSB(WS_P); const int lane = F.lane;
    const float *aq = F.in[10], *ak = F.in[11], *bq = F.in[17], *bk = F.in[18];
    for (int r = F.gw; r < MALL; r += F.NGW) {
        bf16* row = P + (size_t)r * INA + 8 * lane;
        if (r < MT) { const int t = r & (SEQ - 1), prow = t >> 6, pcol = t & 63;
            qk_step<8>(row, aq, 0.125f * LOG2E, true, prow, pcol, lane, !dry); qk_step<8>(row + 512, aq, 0.125f * LOG2E, true, prow, pcol, lane, !dry);
            qk_step<16>(row + 1024, bq, 0.08838834764831845f * LOG2E, true, prow, pcol, lane, !dry); qk_step<16>(row + 1536, bq, 0.08838834764831845f * LOG2E, true, prow, pcol, lane, !dry);
            qk_step<8>(row + 2048, ak, 1.f, true, prow, pcol, lane, !dry); qk_step<8>(row + 2560, ak, 1.f, true, prow, pcol, lane, !dry);
            qk_step<16>(row + 4096, bk, 1.f, true, prow, pcol, lane, !dry && lane < 32);
        } else {
            qk_step<8>(row + 2048, ak, 1.f, false, 0, 0, lane, !dry); qk_step<8>(row + 2560, ak, 1.f, false, 0, 0, lane, !dry);
            qk_step<16>(row + 4096, bk, 1.f, false, 0, 0, lane, !dry && lane < 32);
        }
    }
    unsigned char* scr = F.lds + F.wave * 17408;
    bf16* VT = WSB(WS_VT);
    for (int it = F.gw; it < NBATCH * 260 * NVH; it += F.NGW) {
        const int vh = it % NVH, kc = (it / NVH) % 260, b = it / (NVH * 260);
        const int srow0 = kc < 4 ? MT + b * CTXL + kc * 64 : b * SEQ + (kc - 4) * 64;
        const int scol = vh < 8 ? 3072 + vh * 128 : 4352 + (vh - 8) * 128;
#pragma unroll 4
        for (int i = 0; i < 16; ++i) { const int rr = 4 * i + (lane >> 4), ch = lane & 15;
            *(v4u*)(scr + rr * 272 + ch * 16) = *(const v4u*)(P + (size_t)(srow0 + rr) * INA + scol + ch * 8); }
        asm volatile("s_waitcnt vmcnt(0) lgkmcnt(0)" ::: "memory");
#pragma unroll 4
        for (int i = 0; i < 16; ++i) { const int pair = i * 64 + lane, d = pair >> 3, oct = pair & 7;
            unsigned short e[8];
#pragma unroll
            for (int j = 0; j < 8; ++j) e[j] = *(const unsigned short*)(scr + vt_perm_key(8 * oct + j) * 272 + 2 * d);
            v4u o; o.x = e[0] | ((unsigned)e[1] << 16); o.y = e[2] | ((unsigned)e[3] << 16); o.z = e[4] | ((unsigned)e[5] << 16); o.w = e[6] | ((unsigned)e[7] << 16);
            *(v4u*)(VT + ((size_t)(b * NVH + vh) * 128 + d) * NKEY + kc * 64 + 8 * oct) = o; }
        asm volatile("s_waitcnt lgkmcnt(0)" ::: "memory");
    }
}
#define MFMA32(a, b, c) __builtin_amdgcn_mfma_f32_32x32x16_bf16((a), (b), (c), 0, 0, 0)
DI int crow(int r, int hi) { return (r & 3) + 8 * (r >> 2) + 4 * hi; }
template <int DQK, bool WIN> DI void attn_pass(Frame& F, const bf16* P, const bf16* VTh, int b, int q0, int qcol, int kcol, f32x16 (&o)[4], float& lsum) {
    constexpr int KS = DQK / 16, KROWB = DQK * 2 + 16, KT_BYTES = 64 * KROWB, VROWB = 144, STG = KT_BYTES + 128 * VROWB, KLD = DQK / 64;
    const int tid = F.tid, lane = F.lane, r32 = lane & 31, hi = lane >> 5, wid = F.wave;
    unsigned char* lds = F.lds;
    bf16x8 qf[KS];
    { const bf16* qp = P + (size_t)(b * SEQ + q0 + wid * 32 + r32) * INA + qcol + 8 * hi;
#pragma unroll
      for (int s = 0; s < KS; ++s) qf[s] = *(const bf16x8*)(qp + 16 * s); }
#pragma unroll
    for (int d = 0; d < 4; ++d)
#pragma unroll
        for (int i = 0; i < 16; ++i) o[d][i] = 0.f;
    float l = 0.f;
    int band0 = 0, NT;
    if (WIN) { band0 = q0 - 128 < 0 ? 0 : q0 - 128; const int band1 = q0 + 384 > SEQ ? SEQ : q0 + 384; NT = 4 + (band1 - band0) / 64; } else NT = NKEY / 64;
    v4u kreg[KLD], vreg[2];
#define ATT_ISSUE(t_) do { const int t__ = (t_); \
        const int kk0 = WIN ? (t__ < 4 ? 64 * t__ : CTXL + band0 + 64 * (t__ - 4)) : 64 * t__; \
        _Pragma("unroll") for (int i = 0; i < KLD; ++i) { const int idx = tid + 512 * i, rr = idx / (DQK / 8), ch = idx % (DQK / 8); const int kk = kk0 + rr; \
            const int prow = kk < CTXL ? MT + b * CTXL + kk : b * SEQ + kk - CTXL; \
            kreg[i] = *(const v4u*)(P + (size_t)prow * INA + kcol + ch * 8); } \
        _Pragma("unroll") for (int i = 0; i < 2; ++i) { const int idx = tid + 512 * i, d = idx >> 3, ch = idx & 7; \
            vreg[i] = *(const v4u*)(VTh + (size_t)d * NKEY + kk0 + ch * 8); } } while (0)
#define ATT_COMMIT(st_) do { unsigned char* kb_ = lds + (st_) * STG; unsigned char* vb_ = kb_ + KT_BYTES; \
        _Pragma("unroll") for (int i = 0; i < KLD; ++i) { const int idx = tid + 512 * i, rr = idx / (DQK / 8), ch = idx % (DQK / 8); *(v4u*)(kb_ + rr * KROWB + ch * 16) = kreg[i]; } \
        _Pragma("unroll") for (int i = 0; i < 2; ++i) { const int idx = tid + 512 * i, d = idx >> 3, ch = idx & 7; *(v4u*)(vb_ + d * VROWB + ch * 16) = vreg[i]; } } while (0)
    __syncthreads();
    ATT_ISSUE(0); ATT_COMMIT(0); __syncthreads();
    const int qpos = q0 + wid * 32 + r32;
    for (int t = 0; t < NT; ++t) {
        if (t + 1 < NT) ATT_ISSUE(t + 1);
        const unsigned char* kb = lds + (t & 1) * STG; const unsigned char* vb = kb + KT_BYTES;
        f32x16 p0, p1;
#pragma unroll
        for (int i = 0; i < 16; ++i) { p0[i] = 0.f; p1[i] = 0.f; }
#pragma unroll
        for (int s = 0; s < KS; ++s) {
            const bf16x8 a0 = *(const bf16x8*)(kb + r32 * KROWB + (16 * s + 8 * hi) * 2);
            const bf16x8 a1 = *(const bf16x8*)(kb + (32 + r32) * KROWB + (16 * s + 8 * hi) * 2);
            p0 = MFMA32(a0, qf[s], p0); p1 = MFMA32(a1, qf[s], p1);
        }
        if (WIN && t >= 4) { const int kp0 = band0 + 64 * (t - 4);
#pragma unroll
            for (int i = 0; i < 16; ++i) { const int d0 = kp0 + crow(i, hi) - qpos, d1 = d0 + 32;
                p0[i] = (d0 >= -128 && d0 <= 128) ? __builtin_amdgcn_exp2f(p0[i]) : 0.f; p1[i] = (d1 >= -128 && d1 <= 128) ? __builtin_amdgcn_exp2f(p1[i]) : 0.f; }
        } else {
#pragma unroll
            for (int i = 0; i < 16; ++i) { p0[i] = __builtin_amdgcn_exp2f(p0[i]); p1[i] = __builtin_amdgcn_exp2f(p1[i]); }
        }
        float sa = 0.f, sb = 0.f;
#pragma unroll
        for (int i = 0; i < 16; ++i) { sa += p0[i]; sb += p1[i]; }
        l += sa + sb;
        bf16x8 pb[4];
#pragma unroll
        for (int s = 0; s < 2; ++s) {
            v4u w0, w1;
#pragma unroll
            for (int e = 0; e < 4; ++e) { w0[e] = cvtpk(p0[8 * s + 2 * e], p0[8 * s + 2 * e + 1]); w1[e] = cvtpk(p1[8 * s + 2 * e], p1[8 * s + 2 * e + 1]); }
            pb[s] = __builtin_bit_cast(bf16x8, w0); pb[2 + s] = __builtin_bit_cast(bf16x8, w1);
        }
#pragma unroll
        for (int db = 0; db < 4; ++db)
#pragma unroll
            for (int ks = 0; ks < 4; ++ks) {
                const bf16x8 a = *(const bf16x8*)(vb + (32 * db + r32) * VROWB + (16 * ks + 8 * hi) * 2);
                o[db] = MFMA32(a, pb[ks], o[db]);
            }
        if (t + 1 < NT) ATT_COMMIT((t + 1) & 1);
        __syncthreads();
    }
    lsum = l + __shfl_xor(l, 32);
#undef ATT_ISSUE
#undef ATT_COMMIT
}
DI void p4_attention(Frame& F) {
    const bf16* P = WSB(WS_P); const bf16* VT = WSB(WS_VT); bf16* O = WSB(WS_H);
    const int lane = F.lane, r32 = lane & 31, hi = lane >> 5, wid = F.wave;
    const float lam = WSF(WS_LAM)[0];
    for (int u = blockIdx.x; u < 2048; u += gridDim.x) {
        if (u < 1024) {
            const int b = u >> 9, head = (u >> 6) & 7, q0 = (u & 63) * 256;
            const bf16* VTh = VT + (size_t)(b * NVH + head) * 128 * NKEY;
            f32x16 o[4]; float l;
            attn_pass<64, false>(F, P, VTh, b, q0, head * 128, 2048 + head * 128, o, l);
            v4u* stash = (v4u*)(F.lds + 73728 + F.tid * 128);
            { const float rl = 1.f / l;
#pragma unroll
              for (int d = 0; d < 4; ++d)
#pragma unroll
                  for (int e4 = 0; e4 < 2; ++e4) { v4u w;
#pragma unroll
                      for (int e = 0; e < 4; ++e) w[e] = cvtpk(o[d][8 * e4 + 2 * e] * rl, o[d][8 * e4 + 2 * e + 1] * rl);
                      stash[d * 2 + e4] = w; } }
            attn_pass<64, false>(F, P, VTh, b, q0, head * 128 + 64, 2048 + head * 128 + 64, o, l);
            const float rl2 = lam / l; float ss = 0.f;
#pragma unroll
            for (int d = 0; d < 4; ++d)
#pragma unroll
                for (int e4 = 0; e4 < 2; ++e4) { const v4u w = stash[d * 2 + e4];
#pragma unroll
                    for (int e = 0; e < 4; ++e) { const float v0 = bflo(w[e]) - rl2 * o[d][8 * e4 + 2 * e], v1 = bfhi(w[e]) - rl2 * o[d][8 * e4 + 2 * e + 1]; o[d][8 * e4 + 2 * e] = v0; o[d][8 * e4 + 2 * e + 1] = v1; ss += v0 * v0 + v1 * v1; } }
            ss += __shfl_xor(ss, 32);
            const float rstd = rsqrtf(ss * (1.f / 128.f) + EPSN) * 0.8f;
            const float* sg = F.in[16];
            bf16* orow = O + (size_t)(b * SEQ + q0 + wid * 32 + r32) * DM + head * 128;
#pragma unroll
            for (int d = 0; d < 4; ++d)
#pragma unroll
                for (int g4 = 0; g4 < 4; ++g4) { const int dd = 32 * d + 8 * g4 + 4 * hi; const f32x4 gg = *(const f32x4*)(sg + dd);
                    v2u w; w.x = cvtpk(o[d][4 * g4] * rstd * gg.x, o[d][4 * g4 + 1] * rstd * gg.y); w.y = cvtpk(o[d][4 * g4 + 2] * rstd * gg.z, o[d][4 * g4 + 3] * rstd * gg.w);
                    *(v2u*)(orow + dd) = w; }
        } else {
            const int uu = u - 1024, b = uu >> 9, qh = (uu >> 6) & 7, q0 = (uu & 63) * 256, g = qh >> 2;
            const bf16* VTh = VT + (size_t)(b * NVH + 8 + g) * 128 * NKEY;
            f32x16 o[4]; float l;
            attn_pass<128, true>(F, P, VTh, b, q0, 1024 + qh * 128, 4096 + g * 128, o, l);
            const float rl = 1.f / (l + __expf(F.in[19][qh]));
            bf16* orow = O + (size_t)(b * SEQ + q0 + wid * 32 + r32) * DM + 1024 + qh * 128;
#pragma unroll
            for (int d = 0; d < 4; ++d)
#pragma unroll
                for (int g4 = 0; g4 < 4; ++g4) { const int dd = 32 * d + 8 * g4 + 4 * hi;
                    v2u w; w.x = cvtpk(o[d][4 * g4] * rl, o[d][4 * g4 + 1] * rl); w.y = cvtpk(o[d][4 * g4 + 2] * rl, o[d][4 * g4 + 3] * rl);
                    *(v2u*)(orow + dd) = w; }
        }
    }
}
DI void p12_shortconv(Frame& F) {
    const bf16* Z = WSB(WS_P); bf16* T = WSB(WS_T); const float* cw = F.in[22]; const float* cb = F.in[23]; const int lane = F.lane;
    unsigned char* scr = F.lds + F.wave * 18432;
    for (int it = F.gw; it < NBATCH * 256 * 48; it += F.NGW) {
        const int cc = it % 48, tc = (it / 48) & 255, b = it / (48 * 256); const int t0 = tc * 64, c0 = cc * 128;
        for (int i = 0; i < 17; ++i) { const int rr = 4 * i + (lane >> 4), ch = lane & 15; const int t = t0 - 1 + rr;
            if (rr < 66) { v4u v = {0, 0, 0, 0}; if (t >= 0 && t < SEQ) v = *(const v4u*)(Z + (size_t)(b * SEQ + t) * HY3 + c0 + ch * 8); *(v4u*)(scr + rr * 272 + ch * 16) = v; } }
        asm volatile("s_waitcnt vmcnt(0) lgkmcnt(0)" ::: "memory");
#pragma unroll 2
        for (int i = 0; i < 16; ++i) { const int pair = i * 64 + lane, c = pair >> 3, oct = pair & 7; const int col = c0 + c;
            const float w0 = cw[col], w1 = cw[HY3 + col], w2 = cw[2 * HY3 + col], bb = cb[col];
            float z[10];
#pragma unroll
            for (int j = 0; j < 10; ++j) z[j] = bf1(*(const unsigned short*)(scr + (8 * oct + j) * 272 + 2 * c));
            v4u o;
#pragma unroll
            for (int e = 0; e < 4; ++e) { const float y0 = w0 * z[2 * e] + w1 * z[2 * e + 1] + w2 * z[2 * e + 2] + bb, y1 = w0 * z[2 * e + 1] + w1 * z[2 * e + 2] + w2 * z[2 * e + 3] + bb; o[e] = cvtpk(y0, y1); }
            const int which = col >> 11, ch = col & 2047;
            *(v4u*)(T + (((size_t)which * NBATCH + b) * DM + ch) * SEQ + t0 + 8 * oct) = o; }
        asm volatile("s_waitcnt lgkmcnt(0)" ::: "memory");
    }
}
typedef float2 cf;
constexpr int FM = 16384;
#define FPAD(i) ((i) + (((i) >> 6) << 2))
DI cf cmul(cf a, cf b) { return make_float2(a.x * b.x - a.y * b.y, a.x * b.y + a.y * b.x); }
DI cf cmulc(cf a, cf b) { return make_float2(a.x * b.x + a.y * b.y, a.y * b.x - a.x * b.y); }
DI cf cadd(cf a, cf b) { return make_float2(a.x + b.x, a.y + b.y); }
DI cf csub(cf a, cf b) { return make_float2(a.x - b.x, a.y - b.y); }
template <bool INV> DI void r4(cf& a0, cf& a1, cf& a2, cf& a3) {
    const cf t0 = cadd(a0, a2), t1 = csub(a0, a2), t2 = cadd(a1, a3), t3 = csub(a1, a3);
    a0 = cadd(t0, t2); a2 = csub(t0, t2);
    if (!INV) { a1 = make_float2(t1.x + t3.y, t1.y - t3.x); a3 = make_float2(t1.x - t3.y, t1.y + t3.x); }
    else      { a1 = make_float2(t1.x - t3.y, t1.y + t3.x); a3 = make_float2(t1.x + t3.y, t1.y - t3.x); }
}
template <bool INV> DI void fft16(cf (&v)[16]) {
    constexpr float C1 = 0.9238795325112867f, S1 = 0.3826834323650898f, C2 = 0.7071067811865476f;
    const cf W[10] = {make_float2(1.f, 0.f), make_float2(C1, -S1), make_float2(C2, -C2), make_float2(S1, -C1), make_float2(0.f, -1.f), make_float2(-S1, -C1), make_float2(-C2, -C2), make_float2(-C1, -S1), make_float2(-1.f, 0.f), make_float2(-C1, S1)};
    if (!INV) {
#pragma unroll
        for (int i0 = 0; i0 < 4; ++i0) r4<false>(v[i0], v[4 + i0], v[8 + i0], v[12 + i0]);
#pragma unroll
        for (int m = 1; m < 4; ++m)
#pragma unroll
            for (int i0 = 1; i0 < 4; ++i0) v[4 * m + i0] = cmul(v[4 * m + i0], W[i0 * m]);
#pragma unroll
        for (int m = 0; m < 4; ++m) r4<false>(v[4 * m], v[4 * m + 1], v[4 * m + 2], v[4 * m + 3]);
    } else {
#pragma unroll
        for (int m = 0; m < 4; ++m) r4<true>(v[4 * m], v[4 * m + 1], v[4 * m + 2], v[4 * m + 3]);
#pragma unroll
        for (int m = 1; m < 4; ++m)
#pragma unroll
            for (int i0 = 1; i0 < 4; ++i0) v[4 * m + i0] = cmulc(v[4 * m + i0], W[i0 * m]);
#pragma unroll
        for (int i0 = 0; i0 < 4; ++i0) r4<true>(v[i0], v[4 + i0], v[8 + i0], v[12 + i0]);
    }
}
template <int S, bool INV> DI void fft_pass16(cf* cx, int tid) {
    constexpr int stride = S / 16;
    constexpr int estr = stride + (stride >= 64 ? 4 * (stride / 64) : 0);
    asm volatile("" : "+v"(tid));
#pragma unroll 1
    for (int u = tid; u < FM / 16; u += 512) {
        const int blk = u / stride, i = u % stride, base = blk * S + i;
        cf* p = cx + FPAD(base);
        const float rev = (float)i * (1.f / S);
        const cf w1 = make_float2(fcos_rev(rev), -fsin_rev(rev));
        cf v[16];
        if (!INV) {
#pragma unroll
            for (int j = 0; j < 16; ++j) v[j] = p[j * estr];
            fft16<false>(v);
            cf w = w1; p[0] = v[0];
#pragma unroll
            for (int f = 1; f < 16; ++f) { const int q = 4 * (f & 3) + (f >> 2); p[f * estr] = cmul(v[q], w); w = cmul(w, w1); }
        } else {
            cf w = w1; v[0] = p[0];
#pragma unroll
            for (int f = 1; f < 16; ++f) { const int q = 4 * (f & 3) + (f >> 2); v[q] = cmulc(p[f * estr], w); w = cmul(w, w1); }
            fft16<true>(v);
#pragma unroll
            for (int j = 0; j < 16; ++j) p[j * estr] = v[j];
        }
    }
}
template <bool INV> DI void fft_pass4(cf* cx, int tid) {
    asm volatile("" : "+v"(tid));
#pragma unroll 1
    for (int u = tid; u < FM / 4; u += 512) { cf* p = cx + FPAD(4 * u);
        cf a0 = p[0], a1 = p[1], a2 = p[2], a3 = p[3];
        r4<INV>(a0, a1, a2, a3);
        p[0] = a0; p[1] = a1; p[2] = a2; p[3] = a3; }
}
DI void fft_fwd(cf* cx, int tid) {
    fft_pass16<16384, false>(cx, tid); __syncthreads(); fft_pass16<1024, false>(cx, tid); __syncthreads(); fft_pass16<64, false>(cx, tid); __syncthreads(); fft_pass4<false>(cx, tid); __syncthreads();
}
DI void fft_inv(cf* cx, int tid) {
    fft_pass4<true>(cx, tid); __syncthreads(); fft_pass16<64, true>(cx, tid); __syncthreads(); fft_pass16<1024, true>(cx, tid); __syncthreads(); fft_pass16<16384, true>(cx, tid); __syncthreads();
}
DI int fposu(int k) { return ((k & 15) << 10) | (((k >> 4) & 15) << 6) | (((k >> 8) & 15) << 2) | (k >> 12); }
DI void rsplit(cf Zk, cf Zm, cf w, cf& Uk, cf& Um) {
    const cf E = make_float2(0.5f * (Zk.x + Zm.x), 0.5f * (Zk.y - Zm.y)), O = make_float2(0.5f * (Zk.y + Zm.y), -0.5f * (Zk.x - Zm.x));
    const cf T = cmul(w, O);
    Uk = cadd(E, T); Um = make_float2(E.x - T.x, -(E.y - T.y));
}
DI void p14_longconv(Frame& F, bool dry) {
    cf* cx = (cf*)F.lds; float* red = (float*)(F.lds + 139264); int tid = F.tid;
    const bf16* FILT = WSB(WS_FILT); bf16* T = WSB(WS_T); const float* dsk = F.in[32];
    cf* spec = (cf*)(F.ws + WS_SPEC + (size_t)blockIdx.x * SPEC_SLOT);
    for (int c = blockIdx.x; c < DM; c += gridDim.x) {
        const float delta = fabsf(-3.0701134573253944f + (float)c * ((-15.350567286626972f + 3.0701134573253944f) / 2047.f));
        const float dk = delta * (1.f / 16383.f) * LOG2E;
        for (int ord = 0; ord < 2; ++ord) {
            const bf16* hf = FILT + ((size_t)(ord * 2 + 0) * DM + c) * SEQ; const bf16* hb = FILT + ((size_t)(ord * 2 + 1) * DM + c) * SEQ;
            __syncthreads();
            asm volatile("" : "+v"(tid));
            float asum = 0.f;
#pragma unroll 1
            for (int n = tid; n < FM; n += 512) {
                float v0, v1;
                if (n < FM / 2) { const unsigned w = *(const unsigned*)(hf + 2 * n); v0 = bflo(w) * __builtin_amdgcn_exp2f(-(float)(2 * n) * dk); v1 = bfhi(w) * __builtin_amdgcn_exp2f(-(float)(2 * n + 1) * dk); }
                else { const int m0 = 2 * n, m1 = 2 * n + 1;
                    const int s0 = 2 * SEQ - m0, s1 = 2 * SEQ - m1;
                    v0 = (m0 == SEQ) ? 0.f : bf1(hb[s0]) * __builtin_amdgcn_exp2f(-(float)s0 * dk); v1 = bf1(hb[s1]) * __builtin_amdgcn_exp2f(-(float)s1 * dk); }
                asum += fabsf(v0) + fabsf(v1); cx[FPAD(n)] = make_float2(v0, v1);
            }
            asum = wave_sum(asum); if (F.lane == 0) red[F.wave] = asum;
            __syncthreads();
            float tot = 0.f;
#pragma unroll
            for (int w = 0; w < 8; ++w) tot += red[w];
            const float fscale = 1.f / (tot * (float)FM);
            fft_fwd(cx, tid);
#pragma unroll 1
            for (int e = tid; e < FM / 2; e += 512) {
                const int pu = 4 * (e >> 1) + (e & 1), k = 4096 * (e & 1) + 256 * ((e >> 1) & 15) + 16 * ((e >> 5) & 15) + (e >> 9);
                if (e == 0) { const cf z = cx[0]; spec[0] = make_float2((z.x + z.y) * fscale, 0.f); spec[FM] = make_float2((z.x - z.y) * fscale, 0.f);
                    const cf z2 = cx[2]; spec[2] = make_float2(z2.x * fscale, -z2.y * fscale); }
                else { const int km = FM - k, pmu = fposu(km); const float rev = (float)k * (1.f / (2 * FM)); const cf w = make_float2(fcos_rev(rev), -fsin_rev(rev)); cf Uk, Um;
                    rsplit(cx[FPAD(pu)], cx[FPAD(pmu)], w, Uk, Um); spec[pu] = make_float2(Uk.x * fscale, Uk.y * fscale); spec[pmu] = make_float2(Um.x * fscale, Um.y * fscale); }
            }
            __threadfence_block();
            const float dskip = dsk[ord * DM + c];
            for (int b = 0; b < NBATCH; ++b) {
                bf16* u = T + ((size_t)(0 * NBATCH + b) * DM + c) * SEQ;
                const bf16* gate = T + ((size_t)((1 + ord) * NBATCH + b) * DM + c) * SEQ;
                __syncthreads();
                asm volatile("" : "+v"(tid));
#pragma unroll 1
                for (int n = tid; n < FM; n += 512) { cf z = make_float2(0.f, 0.f); if (n < FM / 2) { const unsigned w = *(const unsigned*)(u + 2 * n); z = make_float2(bflo(w), bfhi(w)); } cx[FPAD(n)] = z; }
                __syncthreads();
                fft_fwd(cx, tid);
#pragma unroll 1
                for (int e = tid; e < FM / 2; e += 512) {
                    const int pu = 4 * (e >> 1) + (e & 1), k = 4096 * (e & 1) + 256 * ((e >> 1) & 15) + 16 * ((e >> 5) & 15) + (e >> 9);
                    if (e == 0) { const cf z = cx[0]; const float y0 = (z.x + z.y) * spec[0].x, ym = (z.x - z.y) * spec[FM].x; cx[0] = make_float2(0.5f * (y0 + ym), 0.5f * (y0 - ym));
                        const cf z2 = cx[2]; const cf y2 = cmul(make_float2(z2.x, -z2.y), spec[2]); cx[2] = make_float2(y2.x, -y2.y); }
                    else { const int km = FM - k, pmu = fposu(km); const float rev = (float)k * (1.f / (2 * FM)); const cf w = make_float2(fcos_rev(rev), -fsin_rev(rev)); cf Uk, Um;
                        const int pk = FPAD(pu), pm = FPAD(pmu);
                        rsplit(cx[pk], cx[pm], w, Uk, Um);
                        const cf Yk = cmul(Uk, spec[pu]), Ym = cmul(Um, spec[pmu]);
                        const cf E = make_float2(0.5f * (Yk.x + Ym.x), 0.5f * (Yk.y - Ym.y)), D = make_float2(0.5f * (Yk.x - Ym.x), 0.5f * (Yk.y + Ym.y));
                        const cf O = cmulc(D, w);
                        cx[pk] = make_float2(E.x - O.y, E.y + O.x); cx[pm] = make_float2(E.x + O.y, -E.y + O.x); }
                }
                __syncthreads();
                fft_inv(cx, tid);
#pragma unroll 1
                for (int n = tid; n < FM / 2; n += 512) { const cf y = cx[FPAD(n)]; const unsigned uw = *(const unsigned*)(u + 2 * n), gw = *(const unsigned*)(gate + 2 * n);
                    const float r0 = (y.x + dskip * bflo(uw)) * bflo(gw), r1 = (y.y + dskip * bfhi(uw)) * bfhi(gw);
                    if (!dry) *(unsigned*)(u + 2 * n) = cvtpk(r0, r1); }
                __threadfence_block();
            }
        }
    }
}
DI void p15_transpose_y(Frame& F) {
    const bf16* T = WSB(WS_T); bf16* Y = WSB(WS_H); const int lane = F.lane;
    unsigned char* scr = F.lds + F.wave * 9216;
    for (int it = F.gw; it < NBATCH * 256 * 32; it += F.NGW) {
        const int cc = it & 31, tc = (it >> 5) & 255, b = it >> 13; const int c0 = cc * 64, t0 = tc * 64;
#pragma unroll
        for (int i = 0; i < 8; ++i) { const int rr = 8 * i + (lane >> 3), ch = lane & 7;
            *(v4u*)(scr + rr * 144 + ch * 16) = *(const v4u*)(T + ((size_t)b * DM + c0 + rr) * SEQ + t0 + ch * 8); }
        asm volatile("s_waitcnt vmcnt(0) lgkmcnt(0)" ::: "memory");
#pragma unroll 2
        for (int i = 0; i < 8; ++i) { const int pair = i * 64 + lane, t = pair >> 3, oct = pair & 7;
            unsigned short e[8];
#pragma unroll
            for (int j = 0; j < 8; ++j) e[j] = *(const unsigned short*)(scr + (8 * oct + j) * 144 + 2 * t);
            v4u o; o.x = e[0] | ((unsigned)e[1] << 16); o.y = e[2] | ((unsigned)e[3] << 16); o.z = e[4] | ((unsigned)e[5] << 16); o.w = e[6] | ((unsigned)e[7] << 16);
            *(v4u*)(Y + (size_t)(b * SEQ + t0 + t) * DM + c0 + 8 * oct) = o; }
        asm volatile("s_waitcnt lgkmcnt(0)" ::: "memory");
    }
}
#define GAS __attribute__((address_space(1)))
#define RLX_AGENT __ATOMIC_RELAXED, __HIP_MEMORY_SCOPE_AGENT
#define XB_TMO      128
#define XB_XCNT(j)  (256  + 64 * (j))
#define XB_XSUB(j)  (1280 + 64 * (j))
#define XB_XGEN(j)  (2304 + 64 * (j))
#define XB_TOP      3328
#define XB_TOPGEN   3392
#define XCD_BAR_WORDS 3456
#define XB_SPIN_CAP (1u << 18)

__device__ __forceinline__ unsigned xb_ld(unsigned* p)              { return __hip_atomic_load(p, __ATOMIC_RELAXED, __HIP_MEMORY_SCOPE_AGENT); }
__device__ __forceinline__ unsigned xb_add(unsigned* p, unsigned v) { return __hip_atomic_fetch_add(p, v, __ATOMIC_RELAXED, __HIP_MEMORY_SCOPE_AGENT); }
__device__ __forceinline__ unsigned xb_xcc_id() { return (unsigned)__builtin_amdgcn_s_getreg((3 << 11) | 20) & 0xFu; }
#define XB_SPIN(cond, bar) do { unsigned _sp = 0; while (cond) { __builtin_amdgcn_s_sleep(1); \
    if ((++_sp & 255u) == 0u) { if (xb_ld(&(bar)[XB_TMO])) break; if (_sp > XB_SPIN_CAP) { atomicAdd(&(bar)[XB_TMO], 1u); break; } } } } while (0)

struct XcdBarrier {
    unsigned* bar; unsigned x;
    volatile LAS unsigned* st;
};

__device__ __forceinline__ XcdBarrier xcd_barrier_post(unsigned* bar, volatile LAS unsigned* st) {
    XcdBarrier b; b.bar = bar; b.x = xb_xcc_id(); b.st = st;
    if (threadIdx.x == 0) (void)xb_add(&bar[XB_XCNT(b.x)], 1u);
    return b;
}
__device__ __forceinline__ void xcd_barrier_complete(unsigned* bar, unsigned x, unsigned& nloc, unsigned& nx) {
    const unsigned G = gridDim.x * gridDim.y * gridDim.z;
    unsigned sum, cnt, mine, sp = 0u;
    for (;;) {
        sum = 0u; cnt = 0u; mine = 0u;
#pragma unroll
        for (unsigned j = 0; j < 16; ++j) { const unsigned c = xb_ld(&bar[XB_XCNT(j)]); sum += c; cnt += (c > 0u) ? 1u : 0u; mine = (j == x) ? c : mine; }
        if (sum == G) break;
        __builtin_amdgcn_s_sleep(1);
        if ((++sp & 255u) == 0u) { if (xb_ld(&bar[XB_TMO])) break; if (sp > XB_SPIN_CAP) { atomicAdd(&bar[XB_TMO], 1u); break; } }
    }
    nloc = mine > 0u ? mine : 1u; nx = cnt > 0u ? cnt : 1u;
}

__device__ __forceinline__ void xcd_barrier(const XcdBarrier& b) {
    asm volatile("s_waitcnt vmcnt(0)" ::: "memory");
    __syncthreads();
    if (threadIdx.x == 0) {
        unsigned* bar = b.bar;
        __builtin_amdgcn_s_waitcnt(0);
        unsigned nloc = b.st[0], nx = b.st[1];
        if (nloc == 0u) { xcd_barrier_complete(bar, b.x, nloc, nx); b.st[0] = nloc; b.st[1] = nx; }
        const unsigned old = xb_add(&bar[XB_XSUB(b.x)], 1u);
        const unsigned gen = old / nloc;
        if (old + 1u == (gen + 1u) * nloc) {
            __builtin_amdgcn_fence(__ATOMIC_RELEASE, "agent");
            asm volatile("s_waitcnt vmcnt(0)" ::: "memory");
            const unsigned og = xb_add(&bar[XB_TOP], 1u);
            const unsigned tg = og / nx;
            if (og + 1u == (tg + 1u) * nx) xb_add(&bar[XB_TOPGEN], 1u);
            else XB_SPIN(xb_ld(&bar[XB_TOPGEN]) == tg, bar);
            __builtin_amdgcn_fence(__ATOMIC_ACQUIRE, "agent");
            xb_add(&bar[XB_XGEN(b.x)], 1u);
            asm volatile("s_waitcnt vmcnt(0)" ::: "memory");
        } else {
            XB_SPIN(xb_ld(&bar[XB_XGEN(b.x)]) == gen, bar);
            __builtin_amdgcn_fence(__ATOMIC_ACQUIRE, "agent");
            asm volatile("s_waitcnt vmcnt(0)" ::: "memory");
        }
    }
    __syncthreads();
}

template <class Epi> DI void run_gemm(Frame& F, const bf16* A, const bf16* Bt, int M, int N, int K, const Epi& E) {
    __syncthreads();
    pg8::Gemm g{A, Bt, M, N, K}; pg8::StaticOrder S; S.init(M, N, (int)gridDim.x, (int)blockIdx.x);
    pg8::gemm_phase<Epi, pg8::StaticOrder, true, true>((PG8_LAS unsigned char*)F.lds, g, S, E);
    __syncthreads();
}
DI void ffn_phases(Frame& F, int l, int sub, size_t wg, size_t wv, size_t wd) {
    const bf16* W = WSB(WS_W);
    if (sub == 0) { pg8::EpiBf16<0> E{WSB(WS_P), DFF, nullptr, 0, 0, 1.f}; run_gemm(F, WSB(WS_H), W + wg, MT, DFF, DM, E); }
    else if (sub == 1) { pg8::EpiGlu E{WSB(WS_P), WSB(WS_U), DFF, F.in[36] + (size_t)l * 3 * DFF, F.in[37] + (size_t)l * DFF}; run_gemm(F, WSB(WS_H), W + wv, MT, DFF, DM, E); }
    else { pg8::EpiRes E{F.out, F.out, DM, WSF(WS_M) + (size_t)l * 3 * 12288 + 5 * DM, F.in[5] + (size_t)l * 12288 + 5 * DM}; run_gemm(F, WSB(WS_U), W + wd, MT, DM, DFF, E); }
}
struct Args { const float* in[39]; float* out; unsigned char* ws; int ph_lo, ph_hi; };
constexpr int NPHASE = 21;
__global__ void __launch_bounds__(512, 2) mega_fwd(Args args) {
    extern __shared__ __attribute__((aligned(16))) unsigned char lds_raw[];
    cg::grid_group grid = cg::this_grid();
    Frame F;
    F.lds = lds_raw; F.tid = threadIdx.x; F.lane = F.tid & 63; F.wave = __builtin_amdgcn_readfirstlane(F.tid >> 6);
    F.gw = blockIdx.x * 8 + F.wave; F.NGW = gridDim.x * 8;
#pragma unroll
    for (int i = 0; i < 39; ++i) F.in[i] = args.in[i];
    F.out = args.out; F.ws = args.ws;
    const int lo = args.ph_lo, hi = args.ph_hi;
    volatile LAS unsigned* MISC = (volatile LAS unsigned*)((LAS unsigned char*)lds_raw + MISC_OFF);
    if (F.tid < 64) MISC[F.tid] = 0u;
    __syncthreads();
    XcdBarrier bar = xcd_barrier_post((unsigned*)(F.ws + WS_BAR), MISC + 8);
#ifndef DUP_PHASE
#define DUP_PHASE -1
#endif
#ifndef ONLY_PHASE
#define ONLY_PHASE -1
#endif
#define IN(k) ((ONLY_PHASE < 0 || ONLY_PHASE == (k)) && lo <= (k) && (k) < hi)
#define SEAM(k) do { if (IN(k) && IN((k) + 1)) { if ((k) == 0) grid.sync(); else xcd_barrier(bar); } } while (0)
    bf16* W = WSB(WS_W);
    if (IN(0)) {
        const TJob jobs[5] = {{F.in[8], DM, INA, W + W0_IN}, {F.in[9], DM, DM, W + W0_OUT}, {F.in[34], DM, DFF, W + W0_G}, {F.in[35], DM, DFF, W + W0_V}, {F.in[38], DFF, DM, W + W0_D}};
        transpose_jobs<5>(F, jobs); p0_ada(F); p0_lam(F); p0_hyena_mlp(F);
#if DUP_PHASE == 99 || DUP_PHASE == 100
        transpose_jobs<5>(F, jobs); p0_hyena_mlp(F);
#endif
    }
    SEAM(0);
#if DUP_PHASE == 200
#pragma unroll 1
    for (int rep = 0; rep < 20; ++rep) grid.sync();
#endif
    if (IN(1)) norm_phase(F, F.in[0], 0, 0, true);
#if DUP_PHASE == 99 || DUP_PHASE == 101
    if (IN(1)) norm_phase(F, F.in[0], 0, 0, true);
#endif
    SEAM(1);
    if (IN(2)) { pg8::EpiBf16<0> E{WSB(WS_P), INA, nullptr, 0, 0, 1.f};
#pragma unroll 1
        for (int rep = 0; rep < (DUP_PHASE == 2 ? 2 : 1); ++rep) run_gemm(F, WSB(WS_H), W + W0_IN, MALL, INA, DM, E); }
    SEAM(2);
#if DUP_PHASE == 3
    if (IN(3)) p3_rope(F, true);
#endif
    if (IN(3)) p3_rope(F, false);
    SEAM(3);
    if (IN(4)) p4_attention(F);
#if DUP_PHASE == 4
    if (IN(4)) { __syncthreads(); p4_attention(F); }
#endif
    SEAM(4);
    if (IN(5)) { pg8::EpiRes E{F.in[0], F.out, DM, WSF(WS_M) + 2 * DM, F.in[5] + 2 * DM}; run_gemm(F, WSB(WS_H), W + W0_OUT, MT, DM, DM, E); }
    SEAM(5);
    if (IN(6)) norm_phase(F, F.out, 0, 1, false);
#if DUP_PHASE == 99 || DUP_PHASE == 101
    if (IN(6)) norm_phase(F, F.out, 0, 1, false);
#endif
    SEAM(6);
    if (IN(7)) ffn_phases(F, 0, 0, W0_G, W0_V, W0_D);
#if DUP_PHASE == 7
    if (IN(7)) ffn_phases(F, 0, 0, W0_G, W0_V, W0_D);
#endif
    SEAM(7);
    if (IN(8)) ffn_phases(F, 0, 1, W0_G, W0_V, W0_D);
#if DUP_PHASE == 8
    if (IN(8)) ffn_phases(F, 0, 1, W0_G, W0_V, W0_D);
#endif
    SEAM(8);
    if (IN(9)) ffn_phases(F, 0, 2, W0_G, W0_V, W0_D);
    SEAM(9);
    if (IN(10)) {
        const TJob jobs[5] = {{F.in[20], DM, HY3, W + W1_IN}, {F.in[33], DM, DM, W + W1_OUT}, {F.in[34] + (size_t)DM * DFF, DM, DFF, W + W1_G}, {F.in[35] + (size_t)DM * DFF, DM, DFF, W + W1_V}, {F.in[38] + (size_t)DFF * DM, DFF, DM, W + W1_D}};
        transpose_jobs<5>(F, jobs); norm_phase(F, F.out, 1, 0, false);
#if DUP_PHASE == 99 || DUP_PHASE == 100
        transpose_jobs<5>(F, jobs);
#endif
#if DUP_PHASE == 99 || DUP_PHASE == 101
        norm_phase(F, F.out, 1, 0, false);
#endif
    }
    SEAM(10);
    if (IN(11)) { pg8::EpiBf16<0> E{WSB(WS_P), HY3, F.in[21], 0, 0, 1.f}; run_gemm(F, WSB(WS_H), W + W1_IN, MT, HY3, DM, E); }
    SEAM(11);
    if (IN(12)) p12_shortconv(F);
#if DUP_PHASE == 12 || DUP_PHASE == 99
    if (IN(12)) p12_shortconv(F);
#endif
    SEAM(12);
    if (IN(13)) { pg8::EpiBf16<0> E{WSB(WS_FILT), SEQ, nullptr, 0, 0, 1.f}; run_gemm(F, WSB(WS_W3T), WSB(WS_A3), 8192, SEQ, 256, E); }
    SEAM(13);
#if DUP_PHASE == 14
    if (IN(14)) p14_longconv(F, true);
#endif
    if (IN(14)) p14_longconv(F, false);
    SEAM(14);
    if (IN(15)) p15_transpose_y(F);
#if DUP_PHASE == 99 || DUP_PHASE == 15
    if (IN(15)) p15_transpose_y(F);
#endif
    SEAM(15);
    if (IN(16)) { pg8::EpiRes E{F.out, F.out, DM, WSF(WS_M) + 3 * 12288 + 2 * DM, F.in[5] + 12288 + 2 * DM}; run_gemm(F, WSB(WS_H), W + W1_OUT, MT, DM, DM, E); }
    SEAM(16);
    if (IN(17)) norm_phase(F, F.out, 1, 1, false);
#if DUP_PHASE == 99 || DUP_PHASE == 101
    if (IN(17)) norm_phase(F, F.out, 1, 1, false);
#endif
    SEAM(17);
    if (IN(18)) ffn_phases(F, 1, 0, W1_G, W1_V, W1_D);
    SEAM(18);
    if (IN(19)) ffn_phases(F, 1, 1, W1_G, W1_V, W1_D);
    SEAM(19);
    if (IN(20)) ffn_phases(F, 1, 2, W1_G, W1_V, W1_D);
#undef IN
#undef SEAM
}
#ifndef MK_MULTI
#define MK_MULTI 0
#endif
extern "C" void kernel_launch(void* const* d_in, const int* in_sizes, int n_in, void* d_out, int out_size, void* d_ws, size_t ws_size, hipStream_t stream) {
    static int grid = 0;
    if (grid == 0) {
        if (n_in != 39 || in_sizes[0] != MT * DM || out_size != MT * DM || ws_size < WS_END) { fprintf(stderr, "kernel_launch: unexpected shapes (n_in %d in0 %d out %d ws %zu)\n", n_in, n_in > 0 ? in_sizes[0] : -1, out_size, ws_size); grid = -1; return; }
        int dev = 0, cus = 0, per_cu = 0;
        hipGetDevice(&dev); hipDeviceGetAttribute(&cus, hipDeviceAttributeMultiprocessorCount, dev);
        if (hipFuncSetAttribute((const void*)mega_fwd, hipFuncAttributeMaxDynamicSharedMemorySize, LDS_BYTES) != hipSuccess) { fprintf(stderr, "kernel_launch: hipFuncSetAttribute failed\n"); grid = -1; return; }
        if (hipOccupancyMaxActiveBlocksPerMultiprocessor(&per_cu, (const void*)mega_fwd, 512, LDS_BYTES) != hipSuccess || per_cu < 1) { fprintf(stderr, "kernel_launch: occupancy query says %d\n", per_cu); per_cu = 1; }
        (void)hipGetLastError();
        grid = cus * per_cu;
    }
    if (grid < 0) return;
    hipMemsetAsync((char*)d_ws + WS_M, 0, CTL_ZERO_BYTES, stream);
    Args a{};
    for (int i = 0; i < 39; ++i) a.in[i] = (const float*)d_in[i];
    a.out = (float*)d_out; a.ws = (unsigned char*)d_ws;
#if MK_MULTI
    for (int p = 0; p < NPHASE; ++p) { a.ph_lo = p; a.ph_hi = p + 1; hipLaunchKernelGGL(mega_fwd, dim3(grid), dim3(512), LDS_BYTES, stream, a); }
#else
    a.ph_lo = 0; a.ph_hi = NPHASE;
    void* kargs[] = {&a};
    hipError_t e = hipLaunchCooperativeKernel((const void*)mega_fwd, dim3(grid), dim3(512), kargs, LDS_BYTES, stream);
    if (e != hipSuccess) fprintf(stderr, "cooperative launch failed: %s (grid %d)\n", hipGetErrorString(e), grid);
#endif
}
```

```cpp
#include <hip/hip_runtime.h>
#include <cstdio>
#include <cstdint>
namespace pg8 {
#define PG8_LAS __attribute__((address_space(3)))
typedef unsigned short bf16_t;
typedef short bf16x8 __attribute__((ext_vector_type(8)));
typedef float f32x4 __attribute__((ext_vector_type(4)));
typedef unsigned u32x4 __attribute__((ext_vector_type(4)));
constexpr int BM = 256, BK = 64, HALF = 128, HTB = HALF * BK * 2  , STAGE_BYTES = 8 * HTB, NXCD = 8, WGM = 8;

__host__ __device__ __forceinline__ int lds_byte(int r, int c) { const int st = (r >> 4) * 2 + (c >> 5), rr = r & 15, cc = c & 31, ob = rr * 64 + cc * 2; return st * 1024 + (ob ^ (((ob >> 9) & 1) << 5)); }
__host__ __device__ __forceinline__ void stage_rc(int b, int& R, int& C) { const int st = b / 1024, sb = b % 1024, swz = sb ^ (((sb >> 9) & 1) << 5); R = (st >> 1) * 16 + swz / 64; C = (st & 1) * 32 + (swz % 64) / 2; }
__host__ __device__ __forceinline__ int perm32(int rho) { const int n = rho >> 4, i = rho & 15; return 8 * (i >> 2) + 4 * n + (i & 3); }

struct Unit { int pm, pn; };
struct Gemm { const bf16_t* A; const bf16_t* Bt; int M, N, K; };

struct StaticOrder {
    int nM, nN, nwg, G, c;
    __host__ __device__ void init(int M, int N, int G_, int c_) { nM = M / BM; nN = N / BM; nwg = nM * nN; G = G_; c = c_; }
    __host__ __device__ bool next(int i, Unit& u) const {
        const long L = (long)i * G + c; if (L >= nwg) return false;
        int wgid = (int)L; { const int q = nwg / NXCD, r = nwg % NXCD, xcd = wgid % NXCD, off = wgid / NXCD; wgid = (xcd < r ? xcd * (q + 1) : r * (q + 1) + (xcd - r) * q) + off; }
        const int nig = WGM * nN, gid = wgid / nig, fm = gid * WGM, gsz = (nM - fm) < WGM ? (nM - fm) : WGM;
        u.pm = fm + ((wgid % nig) % gsz); u.pn = (wgid % nig) / gsz; return true;
    }
    __device__ __forceinline__ void a_ready(const Unit&) const {}
    __device__ __forceinline__ void done(const Unit&) const {}
};

__device__ __forceinline__ unsigned cvt_pk_bf16(float lo, float hi) { unsigned r; asm volatile("v_cvt_pk_bf16_f32 %0, %1, %2" : "=v"(r) : "v"(lo), "v"(hi)); return r; }
typedef float f32x2 __attribute__((ext_vector_type(2)));
__device__ __forceinline__ f32x2 gelu_pk(f32x2 v) {
    const f32x2 av = __builtin_elementwise_abs(v), d = av * 0.2316418882f + 1.0f;
    f32x2 t; t.x = __builtin_amdgcn_rcpf(d.x); t.y = __builtin_amdgcn_rcpf(d.y);
    f32x2 q = t * 0.5307027145f + (-0.7265760135f); q = q * t + 0.7107068705f; q = q * t + (-0.142248368f); q = q * t + 0.127414796f; q = q * t;
    const f32x2 s = (v * v) * (-0.72134752044f);
    f32x2 e; e.x = __builtin_amdgcn_exp2f(s.x); e.y = __builtin_amdgcn_exp2f(s.y);
    const f32x2 m = v * (q * e), r = v - m;
    f32x2 o; o.x = v.x < 0.f ? m.x : r.x; o.y = v.y < 0.f ? m.y : r.y; return o;
}

template <int ACT  > struct EpiBf16 {
    static constexpr bool PERM = true, AFTER_DRAIN = false; static_assert(ACT == 0 || ACT == 1, "EpiBf16: ACT is 0 (none) or 1 (gelu_pk)");
    bf16_t* O; int ldc; const float* bias; int split_cols; size_t split_stride; float scale0;
    __device__ __forceinline__ void operator()(const f32x4 (&acc)[2][2][4][2], const Unit& u, int wr, int wc, int fr, int fq) const {
        const int row0 = u.pm * BM + wr * 64 + fr; int colt = u.pn * BM; bf16_t* base = O;
        float sc = 1.f; if (split_cols) { const int t = colt / split_cols; base += (size_t)t * split_stride; colt -= t * split_cols; if (t == 0) sc = scale0; }
        const int col0 = colt + wc * 32 + 8 * fq, bcol0 = u.pn * BM + wc * 32 + 8 * fq;
        f32x4 bv[2][2];
#pragma unroll
        for (int bj = 0; bj < 2; ++bj)
#pragma unroll
            for (int n = 0; n < 2; ++n) bv[bj][n] = bias ? *(const f32x4*)(bias + bcol0 + bj * HALF + 4 * n) : (f32x4){0.f, 0.f, 0.f, 0.f};
#pragma unroll
        for (int ai = 0; ai < 2; ++ai)
#pragma unroll
            for (int m = 0; m < 4; ++m) { bf16_t* rowp = base + (size_t)(row0 + ai * HALF + m * 16) * ldc + col0;
#pragma unroll
                for (int bj = 0; bj < 2; ++bj) { f32x4 v0 = acc[ai][bj][m][0] + bv[bj][0], v1 = acc[ai][bj][m][1] + bv[bj][1];
                    if (ACT == 1) { f32x2 a = gelu_pk((f32x2){v0[0], v0[1]}), b = gelu_pk((f32x2){v0[2], v0[3]}), c = gelu_pk((f32x2){v1[0], v1[1]}), d = gelu_pk((f32x2){v1[2], v1[3]});
                        v0 = (f32x4){a.x, a.y, b.x, b.y}; v1 = (f32x4){c.x, c.y, d.x, d.y}; }
                    v0 = v0 * sc; v1 = v1 * sc; u32x4 w; w.x = cvt_pk_bf16(v0[0], v0[1]); w.y = cvt_pk_bf16(v0[2], v0[3]); w.z = cvt_pk_bf16(v1[0], v1[1]); w.w = cvt_pk_bf16(v1[2], v1[3]);
                    *(u32x4*)(rowp + bj * HALF) = w; } }
    }
};
struct EpiRes {
    static constexpr bool PERM = false, AFTER_DRAIN = false;
    const float* base; float* out; int ldc; const float* gm; const float* gb;
    __device__ __forceinline__ void operator()(const f32x4 (&acc)[2][2][4][2], const Unit& u, int wr, int wc, int fr, int fq) const {
        const int col0 = u.pn * BM + wc * 32 + 4 * fq; const int b = u.pm >> 6;
        const float* gmb = gm + (size_t)b * 12288;
        const size_t rowoff = (size_t)(u.pm * BM + wr * 64 + fr) * ldc;
#pragma unroll
        for (int bj = 0; bj < 2; ++bj)
#pragma unroll
          for (int ai = 0; ai < 2; ++ai) {
            f32x4 gt[2], bs[4][2];
#pragma unroll
            for (int n = 0; n < 2; ++n) { const int c = col0 + bj * HALF + n * 16; gt[n] = *(const f32x4*)(gmb + c) + *(const f32x4*)(gb + c); }
#pragma unroll
                for (int m = 0; m < 4; ++m)
#pragma unroll
                    for (int n = 0; n < 2; ++n) bs[m][n] = *(const f32x4*)(base + rowoff + (size_t)(ai * HALF + m * 16) * ldc + col0 + bj * HALF + n * 16);
#pragma unroll
                for (int m = 0; m < 4; ++m)
#pragma unroll
                    for (int n = 0; n < 2; ++n) *(f32x4*)(out + rowoff + (size_t)(ai * HALF + m * 16) * ldc + col0 + bj * HALF + n * 16) = bs[m][n] + gt[n] * acc[ai][bj][m][n];
            asm volatile("" ::: "memory"); }
    }
};
struct EpiGlu {
    static constexpr bool PERM = true, AFTER_DRAIN = false;
    const bf16_t* G; bf16_t* U; int ldc; const float* cw; const float* cb;
    __device__ __forceinline__ void operator()(const f32x4 (&acc)[2][2][4][2], const Unit& u, int wr, int wc, int fr, int fq) const {
        typedef unsigned u32x2 __attribute__((ext_vector_type(2)));
        const int row0 = u.pm * BM + wr * 64 + fr;
#pragma unroll
        for (int bj = 0; bj < 2; ++bj)
#pragma unroll
            for (int n = 0; n < 2; ++n) { const int c0 = u.pn * BM + bj * HALF + wc * 32 + 8 * fq + 4 * n;
                const f32x4 w0 = *(const f32x4*)(cw + c0), w1 = *(const f32x4*)(cw + ldc + c0), w2 = *(const f32x4*)(cw + 2 * ldc + c0), bb = *(const f32x4*)(cb + c0);
                u32x2 g0[8], gm[8], gn[8];
#pragma unroll
                for (int it = 0; it < 8; ++it) { const int row = row0 + (it >> 2) * HALF + (it & 3) * 16; const int t = row & 16383;
                    const bf16_t* gp = G + (size_t)row * ldc + c0;
                    g0[it] = *(const u32x2*)gp; gm[it] = *(const u32x2*)(t > 0 ? gp - ldc : gp); gn[it] = *(const u32x2*)(t < 16383 ? gp + ldc : gp); }
#pragma unroll
                for (int it = 0; it < 8; ++it) { const int ai = it >> 2, m = it & 3; const int row = row0 + ai * HALF + m * 16; const int t = row & 16383;
                    const float fm = t > 0 ? 1.f : 0.f, fn = t < 16383 ? 1.f : 0.f;
                    u32x2 o;
#pragma unroll
                    for (int e = 0; e < 2; ++e) {
                        float r2[2];
#pragma unroll
                        for (int hh = 0; hh < 2; ++hh) {
                            const float a0 = hh ? __uint_as_float(g0[it][e] & 0xffff0000u) : __uint_as_float(g0[it][e] << 16);
                            const float am = (hh ? __uint_as_float(gm[it][e] & 0xffff0000u) : __uint_as_float(gm[it][e] << 16)) * fm;
                            const float an = (hh ? __uint_as_float(gn[it][e] & 0xffff0000u) : __uint_as_float(gn[it][e] << 16)) * fn;
                            const float g = w0[2 * e + hh] * am + w1[2 * e + hh] * a0 + w2[2 * e + hh] * an + bb[2 * e + hh];
                            const float ex = __builtin_amdgcn_exp2f(-2.3022082f * g * (1.f + 0.044715f * g * g));
                            r2[hh] = g * __builtin_amdgcn_rcpf(1.f + ex) * acc[ai][bj][m][n][2 * e + hh];
                        }
                        o[e] = cvt_pk_bf16(r2[0], r2[1]);
                    }
                    *(u32x2*)(U + (size_t)row * ldc + c0) = o; }
                asm volatile("" ::: "memory");
            }
    }
};
template <class Epi, class Sched, bool ALIGN_EPI = false, bool SP2 = false>
__device__ __forceinline__ void gemm_phase(PG8_LAS unsigned char* lds, const Gemm g, const Sched& S, const Epi& E) {
    const int tid = threadIdx.x, wid = __builtin_amdgcn_readfirstlane(tid >> 6), lane = tid & 63, wr = wid >> 2, wc = wid & 3, fr = lane & 15, fq = lane >> 4;
    const int K = g.K, nt = K / BK;
    unsigned voffA[2], voffB[2];
#pragma unroll
    for (int i = 0; i < 2; ++i) { int R, C; stage_rc(tid * 16 + i * 8192, R, C); const int Rb = Epi::PERM ? ((R & ~31) + perm32(R & 31)) : R;
        voffA[i] = (unsigned)(R * K + C) * 2u; voffB[i] = (unsigned)(Rb * K + C) * 2u; }
    const size_t kstep = (size_t)(BK * 2);
    const size_t hstep = (size_t)HALF * K * 2;
    const size_t tstep = 2 * hstep;
    const unsigned ldsw = (unsigned)wid * 1024u;
    const int aoff = lds_byte(wr * 64 + fr, fq * 8), boff = lds_byte(wc * 32 + fr, fq * 8);
#define PG8_SA(b, h) (((b) * 2 + (h)) * HTB)
#define PG8_SB(b, h) ((4 + (b) * 2 + (h)) * HTB)
#define PG8_STAGE(bufoff, gbase, voff) do { _Pragma("unroll") for (int _i = 0; _i < 2; ++_i) \
        __builtin_amdgcn_global_load_lds((const unsigned*)((const char*)(gbase) + (voff)[_i]), (PG8_LAS unsigned*)(lds + (bufoff) + ldsw + _i * 8192), 16, 0, 0); } while (0)
#define PG8_LDA(dst, b, h) do { _Pragma("unroll") for (int m = 0; m < 4; ++m) _Pragma("unroll") for (int k = 0; k < 2; ++k) dst[m][k] = *(const PG8_LAS bf16x8*)(lds + PG8_SA(b, h) + aoff + m * 2048 + k * 1024); } while (0)
#define PG8_LDB(dst, b, h) do { _Pragma("unroll") for (int n = 0; n < 2; ++n) _Pragma("unroll") for (int k = 0; k < 2; ++k) dst[n][k] = *(const PG8_LAS bf16x8*)(lds + PG8_SB(b, h) + boff + n * 2048 + k * 1024); } while (0)
#define PG8_MMA(ai, bj, At, Bt) do { __builtin_amdgcn_s_setprio(1); _Pragma("unroll") for (int m = 0; m < 4; ++m) _Pragma("unroll") for (int n = 0; n < 2; ++n) _Pragma("unroll") for (int k = 0; k < 2; ++k) \
        acc[ai][bj][m][n] = __builtin_amdgcn_mfma_f32_16x16x32_bf16(Bt[n][k], At[m][k], acc[ai][bj][m][n], 0, 0, 0); __builtin_amdgcn_s_setprio(0); } while (0)
#define PG8_WAIT_V(n) asm volatile("s_waitcnt vmcnt(" #n ")" ::: "memory")
#define PG8_WAIT_L(n) asm volatile("s_waitcnt lgkmcnt(" #n ")" ::: "memory")
#define PG8_BAR __builtin_amdgcn_s_barrier()
#define PG8_SCHED __builtin_amdgcn_sched_barrier(0)
    Unit cur, nxt; int ui = 0;
    if (!S.next(0, cur)) return;
    f32x4 acc[2][2][4][2];
#pragma unroll
    for (int a = 0; a < 2; ++a)
#pragma unroll
        for (int b = 0; b < 2; ++b)
#pragma unroll
            for (int m = 0; m < 4; ++m)
#pragma unroll
                for (int n = 0; n < 2; ++n) acc[a][b][m][n] = (f32x4){0.f, 0.f, 0.f, 0.f};
    bf16x8 At[4][2], B0[2][2], B1[2][2];
    const char* cA = (const char*)g.A + (size_t)cur.pm * tstep; const char* cB = (const char*)g.Bt + (size_t)cur.pn * tstep;
    S.a_ready(cur);
    if constexpr (SP2) {
        PG8_STAGE(PG8_SB(0, 0), cB, voffB); PG8_STAGE(PG8_SB(0, 1), cB + hstep, voffB); PG8_STAGE(PG8_SA(0, 0), cA, voffA); PG8_STAGE(PG8_SA(0, 1), cA + hstep, voffA);
        if (wr == 1) PG8_BAR;
        PG8_WAIT_V(2); PG8_BAR;
        PG8_STAGE(PG8_SB(1, 0), cB + kstep, voffB); PG8_STAGE(PG8_SA(1, 0), cA + kstep, voffA); PG8_STAGE(PG8_SB(1, 1), cB + hstep + kstep, voffB);
        PG8_WAIT_V(6); PG8_BAR;
    } else {
        PG8_STAGE(PG8_SB(0, 0), cB, voffB); PG8_STAGE(PG8_SA(0, 0), cA, voffA); PG8_STAGE(PG8_SB(0, 1), cB + hstep, voffB); PG8_STAGE(PG8_SA(0, 1), cA + hstep, voffA);
        if (wr == 1) PG8_BAR;
        PG8_WAIT_V(4); PG8_BAR;
        PG8_STAGE(PG8_SB(1, 0), cB + kstep, voffB); PG8_STAGE(PG8_SA(1, 0), cA + kstep, voffA); PG8_STAGE(PG8_SB(1, 1), cB + hstep + kstep, voffB);
        PG8_WAIT_V(6); PG8_BAR;
    }
    for (;;) {
        const bool has_next = S.next(ui + 1, nxt);
        const char* nA = has_next ? (const char*)g.A + (size_t)nxt.pm * tstep : cA; const char* nB = has_next ? (const char*)g.Bt + (size_t)nxt.pn * tstep : cB;
        for (int t = 0; t < nt; t += 2) {
            const bool last = (t == nt - 2);
            const char* a1 = cA + (size_t)(t + 1) * kstep;
            const char* a2 = last ? nA : cA + (size_t)(t + 2) * kstep; const char* b2 = last ? nB : cB + (size_t)(t + 2) * kstep;
            const char* a3 = a2 + kstep; const char* b3 = b2 + kstep;
            if (last && has_next) S.a_ready(nxt);
            if constexpr (SP2) {
            PG8_LDB(B0, 0, 0); PG8_LDB(B1, 0, 1); PG8_SCHED; PG8_LDA(At, 0, 0); PG8_STAGE(PG8_SA(1, 1), a1 + hstep, voffA);
            PG8_WAIT_V(8); PG8_WAIT_L(0); PG8_BAR; PG8_MMA(0, 0, At, B0); PG8_MMA(0, 1, At, B1); PG8_BAR; PG8_SCHED;
            PG8_LDA(At, 0, 1); PG8_STAGE(PG8_SB(0, 0), b2, voffB); PG8_STAGE(PG8_SB(0, 1), b2 + hstep, voffB); PG8_STAGE(PG8_SA(0, 0), a2, voffA);
            PG8_WAIT_V(8); PG8_WAIT_L(0); PG8_BAR; PG8_MMA(1, 0, At, B0); PG8_MMA(1, 1, At, B1); PG8_BAR; PG8_SCHED;
            PG8_LDB(B0, 1, 0); PG8_LDB(B1, 1, 1); PG8_SCHED; PG8_LDA(At, 1, 0); PG8_STAGE(PG8_SA(0, 1), a2 + hstep, voffA);
            PG8_WAIT_V(8); PG8_WAIT_L(0); PG8_BAR; PG8_MMA(0, 0, At, B0); PG8_MMA(0, 1, At, B1); PG8_BAR; PG8_SCHED;
            PG8_LDA(At, 1, 1); PG8_STAGE(PG8_SB(1, 0), b3, voffB); PG8_STAGE(PG8_SB(1, 1), b3 + hstep, voffB); PG8_STAGE(PG8_SA(1, 0), a3, voffA);
            PG8_WAIT_V(8); PG8_WAIT_L(0); PG8_BAR; PG8_MMA(1, 0, At, B0); PG8_MMA(1, 1, At, B1); PG8_BAR; PG8_SCHED;
            } else {
            PG8_LDB(B0, 0, 0); PG8_SCHED; PG8_LDA(At, 0, 0); PG8_STAGE(PG8_SA(1, 1), a1 + hstep, voffA);
            PG8_WAIT_L(8); PG8_BAR; PG8_WAIT_L(0); PG8_MMA(0, 0, At, B0); PG8_BAR; PG8_SCHED;
            PG8_LDB(B1, 0, 1); PG8_STAGE(PG8_SB(0, 0), b2, voffB);
            PG8_BAR; PG8_WAIT_L(0); PG8_MMA(0, 1, At, B1); PG8_BAR;
            PG8_LDA(At, 0, 1); PG8_STAGE(PG8_SA(0, 0), a2, voffA);
            PG8_BAR; PG8_WAIT_L(0); PG8_MMA(1, 0, At, B0); PG8_BAR; PG8_SCHED;
            PG8_STAGE(PG8_SB(0, 1), b2 + hstep, voffB);
            PG8_WAIT_V(6); PG8_BAR; PG8_MMA(1, 1, At, B1); PG8_BAR;
            PG8_LDB(B0, 1, 0); PG8_SCHED; PG8_LDA(At, 1, 0); PG8_STAGE(PG8_SA(0, 1), a2 + hstep, voffA);
            PG8_WAIT_L(8); PG8_BAR; PG8_WAIT_L(0); PG8_MMA(0, 0, At, B0); PG8_BAR; PG8_SCHED;
            PG8_LDB(B1, 1, 1); PG8_STAGE(PG8_SB(1, 0), b3, voffB);
            PG8_BAR; PG8_WAIT_L(0); PG8_MMA(0, 1, At, B1); PG8_BAR;
            PG8_LDA(At, 1, 1); PG8_STAGE(PG8_SA(1, 0), a3, voffA);
            PG8_BAR; PG8_WAIT_L(0); PG8_MMA(1, 0, At, B0); PG8_BAR; PG8_SCHED;
            PG8_STAGE(PG8_SB(1, 1), b3 + hstep, voffB);
            PG8_WAIT_V(6); PG8_BAR; PG8_MMA(1, 1, At, B1); PG8_BAR;
            }
        }
        if constexpr (ALIGN_EPI) { if (wr == 0) PG8_BAR; }
        if constexpr (!Epi::AFTER_DRAIN) { E(acc, cur, wr, wc, fr, fq); S.done(cur); }
        if (!has_next) break;
#pragma unroll
        for (int a = 0; a < 2; ++a)
#pragma unroll
            for (int b = 0; b < 2; ++b)
#pragma unroll
                for (int m = 0; m < 4; ++m)
#pragma unroll
                    for (int n = 0; n < 2; ++n) acc[a][b][m][n] = (f32x4){0.f, 0.f, 0.f, 0.f};
        cur = nxt; cA = nA; cB = nB; ++ui;
        if constexpr (ALIGN_EPI) { if (wr == 1) PG8_BAR; }
    }
    PG8_WAIT_V(0);
    if constexpr (!ALIGN_EPI) { if (wr == 0) PG8_BAR; }
    PG8_BAR;
    if constexpr (Epi::AFTER_DRAIN) { E.fused(acc, cur, wr, wc, fr, fq, lds, wid, lane); S.done(cur); }
#undef PG8_SA
#undef PG8_SB
#undef PG8_STAGE
#undef PG8_LDA
#undef PG8_LDB
#undef PG8_MMA
#undef PG8_WAIT_V
#undef PG8_WAIT_L
#undef PG8_BAR
#undef PG8_SCHED
}
}
#include <hip/hip_cooperative_groups.h>
namespace cg = cooperative_groups;

constexpr int DM = 2048, NBATCH = 2, SEQ = 16384, CTXL = 256, MT = NBATCH * SEQ, MC = NBATCH * CTXL, MALL = MT + MC;
constexpr int INA = 4608, DFF = 5632, HY3 = 6144, NKEY = CTXL + SEQ  , NVH = 10;
constexpr float EPSN = 1e-6f, LOG2E = 1.4426950408889634f;
constexpr size_t MiB = 1u << 20;
constexpr size_t WS_M = 0;
constexpr size_t CTL_ZERO_BYTES = 512 * 1024;
constexpr size_t WS_LAM = 1 * MiB;
constexpr size_t WS_A3 = 2 * MiB;
constexpr size_t WS_W3T = 1008 * MiB;
constexpr size_t WS_W = 12 * MiB;
constexpr size_t WS_H = 110 * MiB;
constexpr size_t WS_P = 240 * MiB;
constexpr size_t WS_VT = 533 * MiB;
constexpr size_t WS_U = 592 * MiB;
constexpr size_t WS_T = 624 * MiB;
constexpr size_t WS_FILT = 238 * MiB + 2 * MiB;
constexpr size_t WS_SPEC = 500 * MiB;
constexpr size_t SPEC_SLOT = 135168;
constexpr size_t WS_END = 1024 * MiB;
static_assert(WS_FILT == WS_P, "filters overlay Z");
static_assert(WS_W + 98 * MiB <= WS_H && WS_H + (size_t)MALL * DM * 2 <= WS_P && WS_P + (size_t)MALL * INA * 2 <= WS_VT, "ws map 1");
static_assert(WS_VT + (size_t)NBATCH * NVH * 128 * NKEY * 2 <= WS_U + 30 * MiB, "ws map 2");
static_assert(WS_P + (size_t)MT * DFF * 2 <= WS_U && WS_U + (size_t)MT * DFF * 2 <= WS_END, "ws map 3");
static_assert(WS_P + (size_t)MT * HY3 * 2 <= WS_T && WS_T + (size_t)3 * MT * DM * 2 <= WS_END, "ws map 4");
static_assert(WS_FILT + (size_t)4 * DM * SEQ * 2 <= WS_SPEC && WS_SPEC + 256 * SPEC_SLOT <= WS_T, "ws map 5");
constexpr size_t W0_IN = 0, W0_OUT = W0_IN + (size_t)INA * DM, W0_G = W0_OUT + (size_t)DM * DM, W0_V = W0_G + (size_t)DFF * DM, W0_D = W0_V + (size_t)DFF * DM;
constexpr size_t W1_IN = 0, W1_OUT = W1_IN + (size_t)HY3 * DM, W1_G = W1_OUT + (size_t)DM * DM, W1_V = W1_G + (size_t)DFF * DM, W1_D = W1_V + (size_t)DFF * DM;
static_assert((W1_D + (size_t)DFF * DM) * 2 <= 98 * MiB, "weights region");

constexpr int RING_BYTES = 131072, MISC_OFF = 147456, LDS_BYTES = 147456 + 256;
constexpr size_t WS_BAR = 384 * 1024;
#define LAS __attribute__((address_space(3)))
typedef unsigned short bf16;
typedef unsigned v4u __attribute__((ext_vector_type(4)));
typedef unsigned v2u __attribute__((ext_vector_type(2)));
typedef float f32x4 __attribute__((ext_vector_type(4)));
typedef float f32x16 __attribute__((ext_vector_type(16)));
typedef short bf16x8 __attribute__((ext_vector_type(8)));
typedef float f32x2_t __attribute__((ext_vector_type(2))); typedef __bf16 bf16x2_t __attribute__((ext_vector_type(2)));
#define DI __device__ __forceinline__
DI unsigned cvtpk(float lo, float hi) { f32x2_t v = {lo, hi}; bf16x2_t b = __builtin_convertvector(v, bf16x2_t); return __builtin_bit_cast(unsigned, b); }
DI float bflo(unsigned w) { return __uint_as_float(w << 16); }
DI float bfhi(unsigned w) { return __uint_as_float(w & 0xffff0000u); }
DI float bf1(unsigned short v) { return __uint_as_float((unsigned)v << 16); }
DI float wave_sum(float v) {
#pragma unroll
    for (int o = 1; o < 64; o <<= 1) v += __shfl_xor(v, o);
    return v;
}
DI float fsin_rev(float r) { return __builtin_amdgcn_sinf(r); }
DI float fcos_rev(float r) { return __builtin_amdgcn_cosf(r); }
DI float fsin_rad(float x) { return __builtin_amdgcn_sinf(x * 0.15915494309189535f); }

struct Args { const float* in[39]; float* out; unsigned char* ws; int ph_lo, ph_hi; };
struct Frame {
    unsigned char* lds; int tid, lane, wave, gw, NGW;
    const Args* a; float* out; unsigned char* ws;
};
#define WSF(off) ((float*)(F.ws + (off)))
#define WSB(off) ((bf16*)(F.ws + (off)))

DI void transpose_item(const float* W, int K, int N, bf16* WT, float* scr, int item, int lane) {
    const int nblk = N / 32, kb = item / nblk, nb = item % nblk, k0 = 64 * kb, n0 = 32 * nb;
#pragma unroll 8
    for (int i = 0; i < 32; ++i) { const int kk = 2 * i + (lane >> 5); scr[kk * 33 + (lane & 31)] = W[(size_t)(k0 + kk) * N + n0 + (lane & 31)]; }
    __builtin_amdgcn_fence(__ATOMIC_RELEASE, "wavefront"); asm volatile("s_waitcnt lgkmcnt(0)" ::: "memory");
    const int c = lane & 7;
#pragma unroll
    for (int j = 0; j < 4; ++j) { const int n = (lane >> 3) + 8 * j; const float* s = scr + (8 * c) * 33 + n;
        v4u o; o.x = cvtpk(s[0 * 33], s[1 * 33]); o.y = cvtpk(s[2 * 33], s[3 * 33]); o.z = cvtpk(s[4 * 33], s[5 * 33]); o.w = cvtpk(s[6 * 33], s[7 * 33]);
        *(v4u*)(WT + (size_t)(n0 + n) * K + k0 + 8 * c) = o; }
    asm volatile("s_waitcnt lgkmcnt(0)" ::: "memory");
}
struct TJob { const float* W; int K, N; bf16* WT; };
template <int NJ> DI void transpose_jobs(Frame& F, const TJob (&jobs)[NJ]) {
    float* scr = (float*)(F.lds + F.wave * 16384);
    int tot = 0;
#pragma unroll
    for (int j = 0; j < NJ; ++j) tot += (jobs[j].K / 64) * (jobs[j].N / 32);
    for (int it = F.gw; it < tot; it += F.NGW) {
        int r = it;
#pragma unroll
        for (int j = 0; j < NJ; ++j) { const int n = (jobs[j].K / 64) * (jobs[j].N / 32);
            if (r >= 0 && r < n) transpose_item(jobs[j].W, jobs[j].K, jobs[j].N, jobs[j].WT, scr, r, F.lane);
            r -= n; }
    }
}
DI float silu(float x) { return x / (1.f + __expf(-x)); }

DI void p0_ada(Frame& F) {
    const float* ada_w = F.a->in[4]; const float* c = F.a->in[1]; const float* cctx = F.a->in[3]; float* M = WSF(WS_M);
    for (int it = F.gw; it < 1536; it += F.NGW) {
        const int l = it / 768, rem = it % 768, kc = rem / 48, ng = rem % 48;
        const float* W = ada_w + (size_t)l * DM * 12288 + (size_t)(kc * 128) * 12288 + ng * 256 + F.lane * 4;
        f32x4 a0 = {0, 0, 0, 0}, a1 = a0, a2 = a0;
#pragma unroll 8
        for (int k = 0; k < 128; ++k) { const f32x4 w = *(const f32x4*)(W + (size_t)k * 12288); const int kk = kc * 128 + k;
            const float s0 = silu(c[kk]), s1 = silu(c[DM + kk]), s2 = silu(cctx[kk]);
            a0 += w * s0; a1 += w * s1; a2 += w * s2; }
        float* m0 = M + (size_t)(l * 3) * 12288 + ng * 256 + F.lane * 4;
#pragma unroll
        for (int e = 0; e < 4; ++e) { unsafeAtomicAdd(m0 + e, a0[e]); unsafeAtomicAdd(m0 + 12288 + e, a1[e]); unsafeAtomicAdd(m0 + 2 * 12288 + e, a2[e]); }
    }
}
DI void p0_hyena_mlp(Frame& F) {
    const float *w0 = F.a->in[24], *b0 = F.a->in[25], *w1 = F.a->in[26], *b1 = F.a->in[27], *w2 = F.a->in[28], *b2 = F.a->in[29], *fq = F.a->in[30];
    bf16* a3 = WSB(WS_A3); const int lane = F.lane; const float freq = fq[lane];
    for (int pg = F.gw; pg < 2048; pg += F.NGW) {
        float a[8], acc[8];
#pragma unroll
        for (int q = 0; q < 8; ++q) { const float pos = (float)(pg * 8 + q); float z = 0.f;
            if (lane == 0) z = pos / 16383.f;
            else if (lane <= 32) { const int i = (lane - 1) & 15; const float f = 1e-4f + (float)i * ((15.f - 1e-4f) / 15.f); const float rev = f * pos * (1.f / 16384.f);
                z = lane <= 16 ? fcos_rev(rev) : -fsin_rev(rev); }
            a[q] = z; acc[q] = b0[lane]; }
        for (int i = 0; i < 33; ++i) { const float w = w0[i * 64 + lane];
#pragma unroll
            for (int q = 0; q < 8; ++q) acc[q] += __shfl(a[q], i) * w; }
#pragma unroll
        for (int q = 0; q < 8; ++q) { a[q] = fsin_rad(freq * acc[q]); acc[q] = b1[lane]; }
        for (int i = 0; i < 64; ++i) { const float w = w1[i * 64 + lane];
#pragma unroll
            for (int q = 0; q < 8; ++q) acc[q] += __shfl(a[q], i) * w; }
#pragma unroll
        for (int q = 0; q < 8; ++q) { a[q] = fsin_rad(freq * acc[q]); acc[q] = b2[lane]; }
        for (int i = 0; i < 64; ++i) { const float w = w2[i * 64 + lane];
#pragma unroll
            for (int q = 0; q < 8; ++q) acc[q] += __shfl(a[q], i) * w; }
#pragma unroll
        for (int q = 0; q < 8; ++q) { const float v = fsin_rad(freq * acc[q]); const unsigned hi = cvtpk(v, 0.f) & 0xffffu; const unsigned lo = cvtpk(v - __uint_as_float(hi << 16), 0.f) & 0xffffu;
            bf16* o = a3 + (size_t)(pg * 8 + q) * 256 + lane; o[0] = (bf16)hi; o[64] = (bf16)lo; o[128] = (bf16)hi; o[192] = 0; }
    }
    { const float* w3 = F.a->in[31]; bf16* w3t = WSB(WS_W3T);
      for (int idx = blockIdx.x * 512 + F.tid; idx < 64 * 8192; idx += gridDim.x * 512) { const int j = idx >> 13, n = idx & 8191; const float v = w3[idx];
          const unsigned hi = cvtpk(v, 0.f) & 0xffffu; const unsigned lo = cvtpk(v - __uint_as_float(hi << 16), 0.f) & 0xffffu;
          bf16* o = w3t + (size_t)n * 256 + j; o[0] = (bf16)hi; o[64] = (bf16)hi; o[128] = (bf16)lo; o[192] = 0; } }
}
DI void p0_lam(Frame& F) {
    if (blockIdx.x == 0 && F.wave == 0) {
        const float s1 = wave_sum(F.a->in[12][F.lane] * F.a->in[13][F.lane]), s2 = wave_sum(F.a->in[14][F.lane] * F.a->in[15][F.lane]);
        if (F.lane == 0) WSF(WS_LAM)[0] = __expf(s1) - __expf(s2) + 0.2f;
    }
}
DI void norm_rows(Frame& F, const float* src, int srow0, int nrows, bf16* dst, int drow0, const float* g, const float* msc, const float* bsc, const float* msh, const float* bsh) {
    int lane = F.lane; asm volatile("" : "+v"(lane));
    f32x4 A[8], B[8];
#pragma unroll
    for (int j = 0; j < 8; ++j) { const int c = 4 * lane + 256 * j;
        const f32x4 sc = *(const f32x4*)(msc + c) + *(const f32x4*)(bsc + c); A[j] = *(const f32x4*)(g + c) * (sc + 1.0f); B[j] = *(const f32x4*)(msh + c) + *(const f32x4*)(bsh + c); }
#ifndef NORM_REP
#define NORM_REP 1
#endif
#pragma unroll 1
    for (int rep = 0; rep < NORM_REP; ++rep)
    for (int r = F.gw; r < nrows; r += F.NGW) {
        const f32x4* xr = (const f32x4*)(src + (size_t)(srow0 + r) * DM) + lane;
        f32x4 v[8]; float ss = 0.f;
#pragma unroll
        for (int j = 0; j < 8; ++j) { v[j] = xr[64 * j]; ss += (v[j].x * v[j].x + v[j].y * v[j].y) + (v[j].z * v[j].z + v[j].w * v[j].w); }
        const float rstd = rsqrtf(wave_sum(ss) * (1.f / DM) + EPSN);
        v2u* o = (v2u*)(dst + (size_t)(drow0 + r) * DM) + lane;
#pragma unroll
        for (int j = 0; j < 8; ++j) { const f32x4 y = v[j] * rstd * A[j] + B[j]; v2u w; w.x = cvtpk(y.x, y.y); w.y = cvtpk(y.z, y.w); o[64 * j] = w; }
    }
}
DI void norm_phase(Frame& F, const float* src, int l, int which, bool with_ctx) {
    const float* M = WSF(WS_M) + (size_t)l * 3 * 12288; const float* ab = F.a->in[5] + (size_t)l * 12288;
    const float* g = (which ? F.a->in[7] : F.a->in[6]) + (size_t)l * DM; const int csh = which ? 3 : 0, csc = which ? 4 : 1;
    for (int b = 0; b < NBATCH; ++b)
        norm_rows(F, src, b * SEQ, SEQ, WSB(WS_H), b * SEQ, g, M + b * 12288 + csc * DM, ab + csc * DM, M + b * 12288 + csh * DM, ab + csh * DM);
    if (with_ctx) norm_rows(F, F.a->in[2], 0, MC, WSB(WS_H), MT, g, M + 2 * 12288 + csc * DM, ab + csc * DM, M + 2 * 12288 + csh * DM, ab + csh * DM);
}
template <int SEGL> DI void qk_step(bf16* p, const float* gain, float scale, bool rope, int prow, int pcol, int lane, bool store) {
    const v4u raw = *(const v4u*)p;
    float x[8];
#pragma unroll
    for (int e = 0; e < 4; ++e) { x[2 * e] = bflo(raw[e]); x[2 * e + 1] = bfhi(raw[e]); }
    float ss = 0.f;
#pragma unroll
    for (int e = 0; e < 8; ++e) ss += x[e] * x[e];
#pragma unroll
    for (int o = 1; o < SEGL; o <<= 1) ss += __shfl_xor(ss, o);
    const float rstd = rsqrtf(ss * (1.f / (8 * SEGL)) + EPSN);
    const int k = lane & (SEGL - 1);
    const f32x4 g0 = *(const f32x4*)(gain + 8 * k), g1 = *(const f32x4*)(gain + 8 * k + 4);
#pragma unroll
    for (int e = 0; e < 8; ++e) x[e] *= rstd * (e < 4 ? g0[e & 3] : g1[e & 3]);
    if (rope) {
        constexpr int NF = 2 * SEGL;
        const int axis = k / (SEGL / 2), half = (k / (SEGL / 4)) & 1, f0 = 8 * (k & (SEGL / 4 - 1));
        const float pos = (float)(axis ? pcol : prow);
#pragma unroll
        for (int e = 0; e < 8; ++e) {
            const float xp = __shfl_xor(x[e], SEGL / 4);
            const float inv = __builtin_amdgcn_exp2f(-(float)(f0 + e) * (13.287712379549449f / NF));
            const float rev = pos * inv * 0.15915494309189535f;
            const float c = fcos_rev(rev), s = fsin_rev(rev);
            x[e] = half ? (x[e] * c + xp * s) : (x[e] * c - xp * s);
        }
    }
    if (store) { v4u o;
#pragma unroll
        for (int e = 0; e < 4; ++e) o[e] = cvtpk(x[2 * e] * scale, x[2 * e + 1] * scale);
        *(v4u*)p = o; }
}
DI int vt_perm_key(int pos) { const int gq = pos >> 4, h = (pos >> 3) & 1, j = pos & 7; return 16 * gq + 8 * (j >> 2) + 4 * h + (j & 3); }
DI void p3_rope(Frame& F, bool dry) {
    bf16* P = WSB(WS_P); const int lane = F.lane;
    const float *aq = F.a->in[10], *ak = F.a->in[11], *bq = F.a->in[17], *bk = F.a->in[18];
    for (int r = F.gw; r < MALL; r += F.NGW) {
        bf16* row = P + (size_t)r * INA + 8 * lane;
        if (r < MT) { const int t = r & (SEQ - 1), prow = t >> 6, pcol = t & 63;
            qk_step<8>(row, aq, 0.125f * LOG2E, true, prow, pcol, lane, !dry); qk_step<8>(row + 512, aq, 0.125f * LOG2E, true, prow, pcol, lane, !dry);
            qk_step<16>(row + 1024, bq, 0.08838834764831845f * LOG2E, true, prow, pcol, lane, !dry); qk_step<16>(row + 1536, bq, 0.08838834764831845f * LOG2E, true, prow, pcol, lane, !dry);
            qk_step<8>(row + 2048, ak, 1.f, true, prow, pcol, lane, !dry); qk_step<8>(row + 2560, ak, 1.f, true, prow, pcol, lane, !dry);
            qk_step<16>(row + 4096, bk, 1.f, true, prow, pcol, lane, !dry && lane < 32);
        } else {
            qk_step<8>(row + 2048, ak, 1.f, false, 0, 0, lane, !dry); qk_step<8>(row + 2560, ak, 1.f, false, 0, 0, lane, !dry);
            qk_step<16>(row + 4096, bk, 1.f, false, 0, 0, lane, !dry && lane < 32);
        }
    }
    unsigned char* scr = F.lds + F.wave * 17408;
    bf16* VT = WSB(WS_VT);
    for (int it = F.gw; it < NBATCH * 260 * NVH; it += F.NGW) {
        const int vh = it % NVH, kc = (it / NVH) % 260, b = it / (NVH * 260);
        const int srow0 = kc < 4 ? MT + b * CTXL + kc * 64 : b * SEQ + (kc - 4) * 64;
        const int scol = vh < 8 ? 3072 + vh * 128 : 4352 + (vh - 8) * 128;
#pragma unroll 4
        for (int i = 0; i < 16; ++i) { const int rr = 4 * i + (lane >> 4), ch = lane & 15;
            *(v4u*)(scr + rr * 272 + ch * 16) = *(const v4u*)(P + (size_t)(srow0 + rr) * INA + scol + ch * 8); }
        asm volatile("s_waitcnt vmcnt(0) lgkmcnt(0)" ::: "memory");
#pragma unroll 4
        for (int i = 0; i < 16; ++i) { const int pair = i * 64 + lane, d = pair >> 3, oct = pair & 7;
            unsigned short e[8];
#pragma unroll
            for (int j = 0; j < 8; ++j) e[j] = *(const unsigned short*)(scr + vt_perm_key(8 * oct + j) * 272 + 2 * d);
            v4u o; o.x = e[0] | ((unsigned)e[1] << 16); o.y = e[2] | ((unsigned)e[3] << 16); o.z = e[4] | ((unsigned)e[5] << 16); o.w = e[6] | ((unsigned)e[7] << 16);
            *(v4u*)(VT + ((size_t)(b * NVH + vh) * 128 + d) * NKEY + kc * 64 + 8 * oct) = o; }
        asm volatile("s_waitcnt lgkmcnt(0)" ::: "memory");
    }
}
#define MFMA32(a, b, c) __builtin_amdgcn_mfma_f32_32x32x16_bf16((a), (b), (c), 0, 0, 0)
DI int crow(int r, int hi) { return (r & 3) + 8 * (r >> 2) + 4 * hi; }
template <int DQK, bool WIN> DI void attn_pass(Frame& F, const bf16* P, const bf16* VTh, int b, int q0, int qcol, int kcol, f32x16 (&o)[4], float& lsum) {
    constexpr int KS = DQK / 16, KROWB = DQK * 2 + 16, KT_BYTES = 64 * KROWB, VROWB = 144, STG = KT_BYTES + 128 * VROWB, KLD = DQK / 64;
    const int tid = F.tid, lane = F.lane, r32 = lane & 31, hi = lane >> 5, wid = F.wave;
    unsigned char* lds = F.lds;
    bf16x8 qf[KS];
    { const bf16* qp = P + (size_t)(b * SEQ + q0 + wid * 32 + r32) * INA + qcol + 8 * hi;
#pragma unroll
      for (int s = 0; s < KS; ++s) qf[s] = *(const bf16x8*)(qp + 16 * s); }
#pragma unroll
    for (int d = 0; d < 4; ++d)
#pragma unroll
        for (int i = 0; i < 16; ++i) o[d][i] = 0.f;
    float l = 0.f;
    int band0 = 0, NT;
    if (WIN) { band0 = q0 - 128 < 0 ? 0 : q0 - 128; const int band1 = q0 + 384 > SEQ ? SEQ : q0 + 384; NT = 4 + (band1 - band0) / 64; } else NT = NKEY / 64;
    v4u kreg[KLD], vreg[2];
#define ATT_ISSUE(t_) do { const int t__ = (t_); \
        const int kk0 = WIN ? (t__ < 4 ? 64 * t__ : CTXL + band0 + 64 * (t__ - 4)) : 64 * t__; \
        _Pragma("unroll") for (int i = 0; i < KLD; ++i) { const int idx = tid + 512 * i, rr = idx / (DQK / 8), ch = idx % (DQK / 8); const int kk = kk0 + rr; \
            const int prow = kk < CTXL ? MT + b * CTXL + kk : b * SEQ + kk - CTXL; \
            kreg[i] = *(const v4u*)(P + (size_t)prow * INA + kcol + ch * 8); } \
        _Pragma("unroll") for (int i = 0; i < 2; ++i) { const int idx = tid + 512 * i, d = idx >> 3, ch = idx & 7; \
            vreg[i] = *(const v4u*)(VTh + (size_t)d * NKEY + kk0 + ch * 8); } } while (0)
#define ATT_COMMIT(st_) do { unsigned char* kb_ = lds + (st_) * STG; unsigned char* vb_ = kb_ + KT_BYTES; \
        _Pragma("unroll") for (int i = 0; i < KLD; ++i) { const int idx = tid + 512 * i, rr = idx / (DQK / 8), ch = idx % (DQK / 8); *(v4u*)(kb_ + rr * KROWB + ch * 16) = kreg[i]; } \
        _Pragma("unroll") for (int i = 0; i < 2; ++i) { const int idx = tid + 512 * i, d = idx >> 3, ch = idx & 7; *(v4u*)(vb_ + d * VROWB + ch * 16) = vreg[i]; } } while (0)
    __syncthreads();
    ATT_ISSUE(0); ATT_COMMIT(0); __syncthreads();
    const int qpos = q0 + wid * 32 + r32;
    for (int t = 0; t < NT; ++t) {
        if (t + 1 < NT) ATT_ISSUE(t + 1);
        const unsigned char* kb = lds + (t & 1) * STG; const unsigned char* vb = kb + KT_BYTES;
        f32x16 p0, p1;
#pragma unroll
        for (int i = 0; i < 16; ++i) { p0[i] = 0.f; p1[i] = 0.f; }
#pragma unroll
        for (int s = 0; s < KS; ++s) {
            const bf16x8 a0 = *(const bf16x8*)(kb + r32 * KROWB + (16 * s + 8 * hi) * 2);
            const bf16x8 a1 = *(const bf16x8*)(kb + (32 + r32) * KROWB + (16 * s + 8 * hi) * 2);
            p0 = MFMA32(a0, qf[s], p0); p1 = MFMA32(a1, qf[s], p1);
        }
        if (WIN && t >= 4) { const int kp0 = band0 + 64 * (t - 4);
#pragma unroll
            for (int i = 0; i < 16; ++i) { const int d0 = kp0 + crow(i, hi) - qpos, d1 = d0 + 32;
                p0[i] = (d0 >= -128 && d0 <= 128) ? __builtin_amdgcn_exp2f(p0[i]) : 0.f; p1[i] = (d1 >= -128 && d1 <= 128) ? __builtin_amdgcn_exp2f(p1[i]) : 0.f; }
        } else {
#pragma unroll
            for (int i = 0; i < 16; ++i) { p0[i] = __builtin_amdgcn_exp2f(p0[i]); p1[i] = __builtin_amdgcn_exp2f(p1[i]); }
        }
        float sa = 0.f, sb = 0.f;
#pragma unroll
        for (int i = 0; i < 16; ++i) { sa += p0[i]; sb += p1[i]; }
        l += sa + sb;
        bf16x8 pb[4];
#pragma unroll
        for (int s = 0; s < 2; ++s) {
            v4u w0, w1;
#pragma unroll
            for (int e = 0; e < 4; ++e) { w0[e] = cvtpk(p0[8 * s + 2 * e], p0[8 * s + 2 * e + 1]); w1[e] = cvtpk(p1[8 * s + 2 * e], p1[8 * s + 2 * e + 1]); }
            pb[s] = __builtin_bit_cast(bf16x8, w0); pb[2 + s] = __builtin_bit_cast(bf16x8, w1);
        }
#pragma unroll
        for (int db = 0; db < 4; ++db)
#pragma unroll
            for (int ks = 0; ks < 4; ++ks) {
                const bf16x8 a = *(const bf16x8*)(vb + (32 * db + r32) * VROWB + (16 * ks + 8 * hi) * 2);
                o[db] = MFMA32(a, pb[ks], o[db]);
            }
        if (t + 1 < NT) ATT_COMMIT((t + 1) & 1);
        __syncthreads();
    }
    lsum = l + __shfl_xor(l, 32);
#undef ATT_ISSUE
#undef ATT_COMMIT
}
DI void p4_attention(Frame& F) {
    const bf16* P = WSB(WS_P); const bf16* VT = WSB(WS_VT); bf16* O = WSB(WS_H);
    const int lane = F.lane, r32 = lane & 31, hi = lane >> 5, wid = F.wave;
    const float lam = WSF(WS_LAM)[0];
    for (int u = blockIdx.x; u < 2048; u += gridDim.x) {
        if (u < 1024) {
            const int b = u >> 9, head = (u >> 6) & 7, q0 = (u & 63) * 256;
            const bf16* VTh = VT + (size_t)(b * NVH + head) * 128 * NKEY;
            f32x16 o[4]; float l;
            attn_pass<64, false>(F, P, VTh, b, q0, head * 128, 2048 + head * 128, o, l);
            v4u* stash = (v4u*)(F.lds + 73728 + F.tid * 128);
            { const float rl = 1.f / l;
#pragma unroll
              for (int d = 0; d < 4; ++d)
#pragma unroll
                  for (int e4 = 0; e4 < 2; ++e4) { v4u w;
#pragma unroll
                      for (int e = 0; e < 4; ++e) w[e] = cvtpk(o[d][8 * e4 + 2 * e] * rl, o[d][8 * e4 + 2 * e + 1] * rl);
                      stash[d * 2 + e4] = w; } }
            attn_pass<64, false>(F, P, VTh, b, q0, head * 128 + 64, 2048 + head * 128 + 64, o, l);
            const float rl2 = lam / l; float ss = 0.f;
#pragma unroll
            for (int d = 0; d < 4; ++d)
#pragma unroll
                for (int e4 = 0; e4 < 2; ++e4) { const v4u w = stash[d * 2 + e4];
#pragma unroll
                    for (int e = 0; e < 4; ++e) { const float v0 = bflo(w[e]) - rl2 * o[d][8 * e4 + 2 * e], v1 = bfhi(w[e]) - rl2 * o[d][8 * e4 + 2 * e + 1]; o[d][8 * e4 + 2 * e] = v0; o[d][8 * e4 + 2 * e + 1] = v1; ss += v0 * v0 + v1 * v1; } }
            ss += __shfl_xor(ss, 32);
            const float rstd = rsqrtf(ss * (1.f / 128.f) + EPSN) * 0.8f;
            const float* sg = F.a->in[16];
            bf16* orow = O + (size_t)(b * SEQ + q0 + wid * 32 + r32) * DM + head * 128;
#pragma unroll
            for (int d = 0; d < 4; ++d)
#pragma unroll
                for (int g4 = 0; g4 < 4; ++g4) { const int dd = 32 * d + 8 * g4 + 4 * hi; const f32x4 gg = *(const f32x4*)(sg + dd);
                    v2u w; w.x = cvtpk(o[d][4 * g4] * rstd * gg.x, o[d][4 * g4 + 1] * rstd * gg.y); w.y = cvtpk(o[d][4 * g4 + 2] * rstd * gg.z, o[d][4 * g4 + 3] * rstd * gg.w);
                    *(v2u*)(orow + dd) = w; }
        } else {
            const int uu = u - 1024, b = uu >> 9, qh = (uu >> 6) & 7, q0 = (uu & 63) * 256, g = qh >> 2;
            const bf16* VTh = VT + (size_t)(b * NVH + 8 + g) * 128 * NKEY;
            f32x16 o[4]; float l;
            attn_pass<128, true>(F, P, VTh, b, q0, 1024 + qh * 128, 4096 + g * 128, o, l);
            const float rl = 1.f / (l + __expf(F.a->in[19][qh]));
            bf16* orow = O + (size_t)(b * SEQ + q0 + wid * 32 + r32) * DM + 1024 + qh * 128;
#pragma unroll
            for (int d = 0; d < 4; ++d)
#pragma unroll
                for (int g4 = 0; g4 < 4; ++g4) { const int dd = 32 * d + 8 * g4 + 4 * hi;
                    v2u w; w.x = cvtpk(o[d][4 * g4] * rl, o[d][4 * g4 + 1] * rl); w.y = cvtpk(o[d][4 * g4 + 2] * rl, o[d][4 * g4 + 3] * rl);
                    *(v2u*)(orow + dd) = w; }
        }
    }
}
DI void p12_shortconv(Frame& F) {
    const bf16* Z = WSB(WS_P); bf16* T = WSB(WS_T); const float* cw = F.a->in[22]; const float* cb = F.a->in[23]; const int lane = F.lane;
    unsigned char* scr = F.lds + F.wave * 18432;
    for (int it = F.gw; it < NBATCH * 256 * 48; it += F.NGW) {
        const int cc = it % 48, tc = (it / 48) & 255, b = it / (48 * 256); const int t0 = tc * 64, c0 = cc * 128;
        for (int i = 0; i < 17; ++i) { const int rr = 4 * i + (lane >> 4), ch = lane & 15; const int t = t0 - 1 + rr;
            if (rr < 66) { v4u v = {0, 0, 0, 0}; if (t >= 0 && t < SEQ) v = *(const v4u*)(Z + (size_t)(b * SEQ + t) * HY3 + c0 + ch * 8); *(v4u*)(scr + rr * 272 + ch * 16) = v; } }
        asm volatile("s_waitcnt vmcnt(0) lgkmcnt(0)" ::: "memory");
#pragma unroll 2
        for (int i = 0; i < 16; ++i) { const int pair = i * 64 + lane, c = pair >> 3, oct = pair & 7; const int col = c0 + c;
            const float w0 = cw[col], w1 = cw[HY3 + col], w2 = cw[2 * HY3 + col], bb = cb[col];
            float z[10];
#pragma unroll
            for (int j = 0; j < 10; ++j) z[j] = bf1(*(const unsigned short*)(scr + (8 * oct + j) * 272 + 2 * c));
            v4u o;
#pragma unroll
            for (int e = 0; e < 4; ++e) { const float y0 = w0 * z[2 * e] + w1 * z[2 * e + 1] + w2 * z[2 * e + 2] + bb, y1 = w0 * z[2 * e + 1] + w1 * z[2 * e + 2] + w2 * z[2 * e + 3] + bb; o[e] = cvtpk(y0, y1); }
            const int which = col >> 11, ch = col & 2047;
            *(v4u*)(T + (((size_t)which * NBATCH + b) * DM + ch) * SEQ + t0 + 8 * oct) = o; }
        asm volatile("s_waitcnt lgkmcnt(0)" ::: "memory");
    }
}
typedef float2 cf;
constexpr int FM = 16384;
#define FPAD(i) ((i) + (((i) >> 6) << 2))
#define NOSLP(v) asm("" : "+v"((v).y))
DI cf cmul(cf a, cf b) { cf r = make_float2(a.x * b.x - a.y * b.y, a.x * b.y + a.y * b.x); NOSLP(r); return r; }
DI cf cmulc(cf a, cf b) { cf r = make_float2(a.x * b.x + a.y * b.y, a.y * b.x - a.x * b.y); NOSLP(r); return r; }
DI cf cadd(cf a, cf b) { cf r = make_float2(a.x + b.x, a.y + b.y); NOSLP(r); return r; }
DI cf csub(cf a, cf b) { cf r = make_float2(a.x - b.x, a.y - b.y); NOSLP(r); return r; }
template <bool INV> DI void r4(cf& a0, cf& a1, cf& a2, cf& a3) {
    const cf t0 = cadd(a0, a2), t1 = csub(a0, a2), t2 = cadd(a1, a3), t3 = csub(a1, a3);
    a0 = cadd(t0, t2); a2 = csub(t0, t2);
    if (!INV) { a1 = make_float2(t1.x + t3.y, t1.y - t3.x); a3 = make_float2(t1.x - t3.y, t1.y + t3.x); }
    else      { a1 = make_float2(t1.x - t3.y, t1.y + t3.x); a3 = make_float2(t1.x + t3.y, t1.y - t3.x); }
    NOSLP(a1); NOSLP(a3);
}
template <bool INV> DI void fft16(cf (&v)[16]) {
    constexpr float C1 = 0.9238795325112867f, S1 = 0.3826834323650898f, C2 = 0.7071067811865476f;
    const cf W[10] = {make_float2(1.f, 0.f), make_float2(C1, -S1), make_float2(C2, -C2), make_float2(S1, -C1), make_float2(0.f, -1.f), make_float2(-S1, -C1), make_float2(-C2, -C2), make_float2(-C1, -S1), make_float2(-1.f, 0.f), make_float2(-C1, S1)};
    if (!INV) {
#pragma unroll
        for (int i0 = 0; i0 < 4; ++i0) r4<false>(v[i0], v[4 + i0], v[8 + i0], v[12 + i0]);
#pragma unroll
        for (int m = 1; m < 4; ++m)
#pragma unroll
            for (int i0 = 1; i0 < 4; ++i0) v[4 * m + i0] = cmul(v[4 * m + i0], W[i0 * m]);
#pragma unroll
        for (int m = 0; m < 4; ++m) r4<false>(v[4 * m], v[4 * m + 1], v[4 * m + 2], v[4 * m + 3]);
    } else {
#pragma unroll
        for (int m = 0; m < 4; ++m) r4<true>(v[4 * m], v[4 * m + 1], v[4 * m + 2], v[4 * m + 3]);
#pragma unroll
        for (int m = 1; m < 4; ++m)
#pragma unroll
            for (int i0 = 1; i0 < 4; ++i0) v[4 * m + i0] = cmulc(v[4 * m + i0], W[i0 * m]);
#pragma unroll
        for (int i0 = 0; i0 < 4; ++i0) r4<true>(v[i0], v[4 + i0], v[8 + i0], v[12 + i0]);
    }
}
template <int S, bool INV, bool HALF = false> DI void fft_pass16(cf* cx, int tid) {
    constexpr int stride = S / 16;
    constexpr int estr = stride + (stride >= 64 ? 4 * (stride / 64) : 0);
    asm volatile("" : "+v"(tid));
#pragma unroll 1
    for (int u = tid; u < FM / 16; u += 512) {
        const int blk = u / stride, i = u % stride, base = blk * S + i;
        cf* p = cx + FPAD(base);
        const float rev = (float)i * (1.f / S);
        const cf w1 = make_float2(fcos_rev(rev), -fsin_rev(rev));
        cf v[16];
        if (!INV) {
#pragma unroll
            for (int j = 0; j < 16; ++j) v[j] = (HALF && j >= 8) ? make_float2(0.f, 0.f) : p[j * estr];
            fft16<false>(v);
            cf w = w1; p[0] = v[0];
#pragma unroll
            for (int f = 1; f < 16; ++f) { const int q = 4 * (f & 3) + (f >> 2); p[f * estr] = cmul(v[q], w); w = cmul(w, w1); }
        } else {
            cf w = w1; v[0] = p[0];
#pragma unroll
            for (int f = 1; f < 16; ++f) { const int q = 4 * (f & 3) + (f >> 2); v[q] = cmulc(p[f * estr], w); w = cmul(w, w1); }
            fft16<true>(v);
#pragma unroll
            for (int j = 0; j < (HALF ? 8 : 16); ++j) p[j * estr] = v[j];
        }
    }
}
template <bool INV> DI void fft_pass4(cf* cx, int tid) {
    asm volatile("" : "+v"(tid));
#pragma unroll 1
    for (int u = tid; u < FM / 4; u += 512) { cf* p = cx + FPAD(4 * u);
        cf a0 = p[0], a1 = p[1], a2 = p[2], a3 = p[3];
        r4<INV>(a0, a1, a2, a3);
        p[0] = a0; p[1] = a1; p[2] = a2; p[3] = a3; }
}
template <bool HALF> DI void fft_fwd(cf* cx, int tid) {
    fft_pass16<16384, false, HALF>(cx, tid); __syncthreads(); fft_pass16<1024, false>(cx, tid); __syncthreads(); fft_pass16<64, false>(cx, tid); __syncthreads(); fft_pass4<false>(cx, tid); __syncthreads();
}
template <bool HALF> DI void fft_inv(cf* cx, int tid) {
    fft_pass4<true>(cx, tid); __syncthreads(); fft_pass16<64, true>(cx, tid); __syncthreads(); fft_pass16<1024, true>(cx, tid); __syncthreads(); fft_pass16<16384, true, HALF>(cx, tid); __syncthreads();
}
DI int fposu(int k) { return ((k & 15) << 10) | (((k >> 4) & 15) << 6) | (((k >> 8) & 15) << 2) | (k >> 12); }
DI void rsplit(cf Zk, cf Zm, cf w, cf& Uk, cf& Um) {
    const cf E = make_float2(0.5f * (Zk.x + Zm.x), 0.5f * (Zk.y - Zm.y)), O = make_float2(0.5f * (Zk.y + Zm.y), -0.5f * (Zk.x - Zm.x));
    const cf T = cmul(w, O);
    Uk = cadd(E, T); Um = make_float2(E.x - T.x, -(E.y - T.y));
}
DI void p14_longconv(Frame& F, bool dry) {
    cf* cx = (cf*)F.lds; float* red = (float*)(F.lds + 139264); int tid = F.tid;
    const bf16* FILT = WSB(WS_FILT); bf16* T = WSB(WS_T); const float* dsk = F.a->in[32];
    cf* spec = (cf*)(F.ws + WS_SPEC + (size_t)blockIdx.x * SPEC_SLOT);
    for (int c = blockIdx.x; c < DM; c += gridDim.x) {
        const float delta = fabsf(-3.0701134573253944f + (float)c * ((-15.350567286626972f + 3.0701134573253944f) / 2047.f));
        const float dk = delta * (1.f / 16383.f) * LOG2E;
        for (int ord = 0; ord < 2; ++ord) {
            const bf16* hf = FILT + ((size_t)(ord * 2 + 0) * DM + c) * SEQ; const bf16* hb = FILT + ((size_t)(ord * 2 + 1) * DM + c) * SEQ;
            __syncthreads();
            asm volatile("" : "+v"(tid));
            float asum = 0.f;
#pragma unroll 8
            for (int n = tid; n < FM; n += 512) {
                float v0, v1;
                if (n < FM / 2) { const unsigned w = *(const unsigned*)(hf + 2 * n); v0 = bflo(w) * __builtin_amdgcn_exp2f(-(float)(2 * n) * dk); v1 = bfhi(w) * __builtin_amdgcn_exp2f(-(float)(2 * n + 1) * dk); }
                else { const int m0 = 2 * n, m1 = 2 * n + 1;
                    const int s0 = 2 * SEQ - m0, s1 = 2 * SEQ - m1;
                    v0 = (m0 == SEQ) ? 0.f : bf1(hb[s0]) * __builtin_amdgcn_exp2f(-(float)s0 * dk); v1 = bf1(hb[s1]) * __builtin_amdgcn_exp2f(-(float)s1 * dk); }
                asum += fabsf(v0) + fabsf(v1); cx[FPAD(n)] = make_float2(v0, v1);
            }
            asum = wave_sum(asum); if (F.lane == 0) red[F.wave] = asum;
            __syncthreads();
            float tot = 0.f;
#pragma unroll
            for (int w = 0; w < 8; ++w) tot += red[w];
            const float fscale = 1.f / (tot * (float)FM);
            fft_fwd<false>(cx, tid);
#pragma unroll 8
            for (int e = tid; e < FM / 2; e += 512) {
                const int pu = 4 * (e >> 1) + (e & 1), k = 4096 * (e & 1) + 256 * ((e >> 1) & 15) + 16 * ((e >> 5) & 15) + (e >> 9);
                if (e == 0) { const cf z = cx[0]; spec[0] = make_float2((z.x + z.y) * fscale, 0.f); spec[FM] = make_float2((z.x - z.y) * fscale, 0.f);
                    const cf z2 = cx[2]; spec[2] = make_float2(z2.x * fscale, -z2.y * fscale); }
                else { const int km = FM - k, pmu = fposu(km); const float rev = (float)k * (1.f / (2 * FM)); const cf w = make_float2(fcos_rev(rev), -fsin_rev(rev)); cf Uk, Um;
                    rsplit(cx[FPAD(pu)], cx[FPAD(pmu)], w, Uk, Um); spec[pu] = make_float2(Uk.x * fscale, Uk.y * fscale); spec[pmu] = make_float2(Um.x * fscale, Um.y * fscale); }
            }
            __threadfence_block();
            const float dskip = dsk[ord * DM + c];
            for (int b = 0; b < NBATCH; ++b) {
                bf16* u = T + ((size_t)(0 * NBATCH + b) * DM + c) * SEQ;
                const bf16* gate = T + ((size_t)((1 + ord) * NBATCH + b) * DM + c) * SEQ;
                __syncthreads();
                asm volatile("" : "+v"(tid));
#pragma unroll 8
                for (int n = tid; n < FM / 2; n += 512) { const unsigned w = *(const unsigned*)(u + 2 * n); cx[FPAD(n)] = make_float2(bflo(w), bfhi(w)); }
                __syncthreads();
                fft_fwd<true>(cx, tid);
#pragma unroll 8
                for (int e = tid; e < FM / 2; e += 512) {
                    const int pu = 4 * (e >> 1) + (e & 1), k = 4096 * (e & 1) + 256 * ((e >> 1) & 15) + 16 * ((e >> 5) & 15) + (e >> 9);
                    if (e == 0) { const cf z = cx[0]; const float y0 = (z.x + z.y) * spec[0].x, ym = (z.x - z.y) * spec[FM].x; cx[0] = make_float2(0.5f * (y0 + ym), 0.5f * (y0 - ym));
                        const cf z2 = cx[2]; const cf y2 = cmul(make_float2(z2.x, -z2.y), spec[2]); cx[2] = make_float2(y2.x, -y2.y); }
                    else { const int km = FM - k, pmu = fposu(km); const float rev = (float)k * (1.f / (2 * FM)); const cf w = make_float2(fcos_rev(rev), -fsin_rev(rev)); cf Uk, Um;
                        const int pk = FPAD(pu), pm = FPAD(pmu);
                        rsplit(cx[pk], cx[pm], w, Uk, Um);
                        const cf Yk = cmul(Uk, spec[pu]), Ym = cmul(Um, spec[pmu]);
                        const cf E = make_float2(0.5f * (Yk.x + Ym.x), 0.5f * (Yk.y - Ym.y)), D = make_float2(0.5f * (Yk.x - Ym.x), 0.5f * (Yk.y + Ym.y));
                        const cf O = cmulc(D, w);
                        cx[pk] = make_float2(E.x - O.y, E.y + O.x); cx[pm] = make_float2(E.x + O.y, -E.y + O.x); }
                }
                __syncthreads();
                fft_inv<true>(cx, tid);
#pragma unroll 1
                for (int n0 = tid; n0 < FM / 2; n0 += 512 * 8) {
                    unsigned uw[8], gw[8];
#pragma unroll
                    for (int q = 0; q < 8; ++q) { const int n = n0 + 512 * q; uw[q] = *(const unsigned*)(u + 2 * n); gw[q] = *(const unsigned*)(gate + 2 * n); }
#pragma unroll
                    for (int q = 0; q < 8; ++q) { const int n = n0 + 512 * q; const cf y = cx[FPAD(n)];
                        const float r0 = (y.x + dskip * bflo(uw[q])) * bflo(gw[q]), r1 = (y.y + dskip * bfhi(uw[q])) * bfhi(gw[q]);
                        if (!dry) *(unsigned*)(u + 2 * n) = cvtpk(r0, r1); }
                }
                __threadfence_block();
            }
        }
    }
}
DI void p15_transpose_y(Frame& F) {
    const bf16* T = WSB(WS_T); bf16* Y = WSB(WS_H); const int lane = F.lane;
    unsigned char* scr = F.lds + F.wave * 9216;
    for (int it = F.gw; it < NBATCH * 256 * 32; it += F.NGW) {
        const int cc = it & 31, tc = (it >> 5) & 255, b = it >> 13; const int c0 = cc * 64, t0 = tc * 64;
#pragma unroll
        for (int i = 0; i < 8; ++i) { const int rr = 8 * i + (lane >> 3), ch = lane & 7;
            *(v4u*)(scr + rr * 144 + ch * 16) = *(const v4u*)(T + ((size_t)b * DM + c0 + rr) * SEQ + t0 + ch * 8); }
        asm volatile("s_waitcnt vmcnt(0) lgkmcnt(0)" ::: "memory");
#pragma unroll 2
        for (int i = 0; i < 8; ++i) { const int pair = i * 64 + lane, t = pair >> 3, oct = pair & 7;
            unsigned short e[8];
#pragma unroll
            for (int j = 0; j < 8; ++j) e[j] = *(const unsigned short*)(scr + (8 * oct + j) * 144 + 2 * t);
            v4u o; o.x = e[0] | ((unsigned)e[1] << 16); o.y = e[2] | ((unsigned)e[3] << 16); o.z = e[4] | ((unsigned)e[5] << 16); o.w = e[6] | ((unsigned)e[7] << 16);
            *(v4u*)(Y + (size_t)(b * SEQ + t0 + t) * DM + c0 + 8 * oct) = o; }
        asm volatile("s_waitcnt lgkmcnt(0)" ::: "memory");
    }
}
#define GAS __attribute__((address_space(1)))
#define RLX_AGENT __ATOMIC_RELAXED, __HIP_MEMORY_SCOPE_AGENT
#define XB_TMO      128
#define XB_XCNT(j)  (256  + 64 * (j))
#define XB_XSUB(j)  (1280 + 64 * (j))
#define XB_XGEN(j)  (2304 + 64 * (j))
#define XB_TOP      3328
#define XB_TOPGEN   3392
#define XCD_BAR_WORDS 3456
#define XB_SPIN_CAP (1u << 18)

__device__ __forceinline__ unsigned xb_ld(unsigned* p)              { return __hip_atomic_load(p, __ATOMIC_RELAXED, __HIP_MEMORY_SCOPE_AGENT); }
__device__ __forceinline__ unsigned xb_add(unsigned* p, unsigned v) { return __hip_atomic_fetch_add(p, v, __ATOMIC_RELAXED, __HIP_MEMORY_SCOPE_AGENT); }
__device__ __forceinline__ unsigned xb_xcc_id() { return (unsigned)__builtin_amdgcn_s_getreg((3 << 11) | 20) & 0xFu; }
#define XB_SPIN(cond, bar) do { unsigned _sp = 0; while (cond) { __builtin_amdgcn_s_sleep(1); \
    if ((++_sp & 255u) == 0u) { if (xb_ld(&(bar)[XB_TMO])) break; if (_sp > XB_SPIN_CAP) { atomicAdd(&(bar)[XB_TMO], 1u); break; } } } } while (0)

struct XcdBarrier {
    unsigned* bar; unsigned x;
    volatile LAS unsigned* st;
};

__device__ __forceinline__ XcdBarrier xcd_barrier_post(unsigned* bar, volatile LAS unsigned* st) {
    XcdBarrier b; b.bar = bar; b.x = xb_xcc_id(); b.st = st;
    if (threadIdx.x == 0) (void)xb_add(&bar[XB_XCNT(b.x)], 1u);
    return b;
}
__device__ __forceinline__ void xcd_barrier_complete(unsigned* bar, unsigned x, unsigned& nloc, unsigned& nx) {
    const unsigned G = gridDim.x * gridDim.y * gridDim.z;
    unsigned sum, cnt, mine, sp = 0u;
    for (;;) {
        sum = 0u; cnt = 0u; mine = 0u;
#pragma unroll
        for (unsigned j = 0; j < 16; ++j) { const unsigned c = xb_ld(&bar[XB_XCNT(j)]); sum += c; cnt += (c > 0u) ? 1u : 0u; mine = (j == x) ? c : mine; }
        if (sum == G) break;
        __builtin_amdgcn_s_sleep(1);
        if ((++sp & 255u) == 0u) { if (xb_ld(&bar[XB_TMO])) break; if (sp > XB_SPIN_CAP) { atomicAdd(&bar[XB_TMO], 1u); break; } }
    }
    nloc = mine > 0u ? mine : 1u; nx = cnt > 0u ? cnt : 1u;
}

__device__ __forceinline__ void xcd_barrier(const XcdBarrier& b) {
    asm volatile("s_waitcnt vmcnt(0)" ::: "memory");
    __syncthreads();
    if (threadIdx.x == 0) {
        unsigned* bar = b.bar;
        __builtin_amdgcn_s_waitcnt(0);
        unsigned nloc = b.st[0], nx = b.st[1];
        if (nloc == 0u) { xcd_barrier_complete(bar, b.x, nloc, nx); b.st[0] = nloc; b.st[1] = nx; }
        const unsigned old = xb_add(&bar[XB_XSUB(b.x)], 1u);
        const unsigned gen = old / nloc;
        if (old + 1u == (gen + 1u) * nloc) {
            __builtin_amdgcn_fence(__ATOMIC_RELEASE, "agent");
            asm volatile("s_waitcnt vmcnt(0)" ::: "memory");
            const unsigned og = xb_add(&bar[XB_TOP], 1u);
            const unsigned tg = og / nx;
            if (og + 1u == (tg + 1u) * nx) xb_add(&bar[XB_TOPGEN], 1u);
            else XB_SPIN(xb_ld(&bar[XB_TOPGEN]) == tg, bar);
            __builtin_amdgcn_fence(__ATOMIC_ACQUIRE, "agent");
            xb_add(&bar[XB_XGEN(b.x)], 1u);
            asm volatile("s_waitcnt vmcnt(0)" ::: "memory");
        } else {
            XB_SPIN(xb_ld(&bar[XB_XGEN(b.x)]) == gen, bar);
            __builtin_amdgcn_fence(__ATOMIC_ACQUIRE, "agent");
            asm volatile("s_waitcnt vmcnt(0)" ::: "memory");
        }
    }
    __syncthreads();
}

template <class Epi> DI void run_gemm(Frame& F, const bf16* A, const bf16* Bt, int M, int N, int K, const Epi& E) {
    __syncthreads();
    pg8::Gemm g{A, Bt, M, N, K}; pg8::StaticOrder S; S.init(M, N, (int)gridDim.x, (int)blockIdx.x);
    pg8::gemm_phase<Epi, pg8::StaticOrder, true, true>((PG8_LAS unsigned char*)F.lds, g, S, E);
    __syncthreads();
}
DI void ffn_phases(Frame& F, int l, int sub, size_t wg, size_t wv, size_t wd) {
    const bf16* W = WSB(WS_W);
    if (sub == 0) { pg8::EpiBf16<0> E{WSB(WS_P), DFF, nullptr, 0, 0, 1.f}; run_gemm(F, WSB(WS_H), W + wg, MT, DFF, DM, E); }
    else if (sub == 1) { pg8::EpiGlu E{WSB(WS_P), WSB(WS_U), DFF, F.a->in[36] + (size_t)l * 3 * DFF, F.a->in[37] + (size_t)l * DFF}; run_gemm(F, WSB(WS_H), W + wv, MT, DFF, DM, E); }
    else { pg8::EpiRes E{F.out, F.out, DM, WSF(WS_M) + (size_t)l * 3 * 12288 + 5 * DM, F.a->in[5] + (size_t)l * 12288 + 5 * DM}; run_gemm(F, WSB(WS_U), W + wd, MT, DM, DFF, E); }
}
constexpr int NPHASE = 21;
__global__ void __launch_bounds__(512, 2) mega_fwd(Args args) {
    extern __shared__ __attribute__((aligned(16))) unsigned char lds_raw[];
    cg::grid_group grid = cg::this_grid();
    Frame F;
    F.lds = lds_raw; F.tid = threadIdx.x; F.lane = F.tid & 63; F.wave = __builtin_amdgcn_readfirstlane(F.tid >> 6);
    F.gw = blockIdx.x * 8 + F.wave; F.NGW = gridDim.x * 8;
    F.a = &args;
    F.out = args.out; F.ws = args.ws;
    const int lo = args.ph_lo, hi = args.ph_hi;
    volatile LAS unsigned* MISC = (volatile LAS unsigned*)((LAS unsigned char*)lds_raw + MISC_OFF);
    if (F.tid < 64) MISC[F.tid] = 0u;
    __syncthreads();
    XcdBarrier bar = xcd_barrier_post((unsigned*)(F.ws + WS_BAR), MISC + 8);
#ifndef DUP_PHASE
#define DUP_PHASE -1
#endif
#ifndef ONLY_PHASE
#define ONLY_PHASE -1
#endif
#define IN(k) ((ONLY_PHASE < 0 || ONLY_PHASE == (k)) && lo <= (k) && (k) < hi)
#define SEAM(k) do { if (IN(k) && IN((k) + 1)) { if ((k) == 0) grid.sync(); else xcd_barrier(bar); } } while (0)
    bf16* W = WSB(WS_W);
    if (IN(0)) {
        const TJob jobs[5] = {{F.a->in[8], DM, INA, W + W0_IN}, {F.a->in[9], DM, DM, W + W0_OUT}, {F.a->in[34], DM, DFF, W + W0_G}, {F.a->in[35], DM, DFF, W + W0_V}, {F.a->in[38], DFF, DM, W + W0_D}};
        transpose_jobs<5>(F, jobs); p0_ada(F); p0_lam(F); p0_hyena_mlp(F);
#if DUP_PHASE == 99 || DUP_PHASE == 100
        transpose_jobs<5>(F, jobs); p0_hyena_mlp(F);
#endif
    }
    SEAM(0);
#if DUP_PHASE == 200
#pragma unroll 1
    for (int rep = 0; rep < 20; ++rep) grid.sync();
#endif
    if (IN(1)) norm_phase(F, F.a->in[0], 0, 0, true);
#if DUP_PHASE == 99 || DUP_PHASE == 101
    if (IN(1)) norm_phase(F, F.a->in[0], 0, 0, true);
#endif
    SEAM(1);
    if (IN(2)) { pg8::EpiBf16<0> E{WSB(WS_P), INA, nullptr, 0, 0, 1.f};
#pragma unroll 1
        for (int rep = 0; rep < (DUP_PHASE == 2 ? 2 : 1); ++rep) run_gemm(F, WSB(WS_H), W + W0_IN, MALL, INA, DM, E); }
    SEAM(2);
#if DUP_PHASE == 3
    if (IN(3)) p3_rope(F, true);
#endif
    if (IN(3)) p3_rope(F, false);
    SEAM(3);
    if (IN(4)) p4_attention(F);
#if DUP_PHASE == 4
    if (IN(4)) { __syncthreads(); p4_attention(F); }
#endif
    SEAM(4);
    if (IN(5)) { pg8::EpiRes E{F.a->in[0], F.out, DM, WSF(WS_M) + 2 * DM, F.a->in[5] + 2 * DM}; run_gemm(F, WSB(WS_H), W + W0_OUT, MT, DM, DM, E); }
    SEAM(5);
    if (IN(6)) norm_phase(F, F.out, 0, 1, false);
#if DUP_PHASE == 99 || DUP_PHASE == 101
    if (IN(6)) norm_phase(F, F.out, 0, 1, false);
#endif
    SEAM(6);
    if (IN(7)) ffn_phases(F, 0, 0, W0_G, W0_V, W0_D);
#if DUP_PHASE == 7
    if (IN(7)) ffn_phases(F, 0, 0, W0_G, W0_V, W0_D);
#endif
    SEAM(7);
    if (IN(8)) ffn_phases(F, 0, 1, W0_G, W0_V, W0_D);
#if DUP_PHASE == 8
    if (IN(8)) ffn_phases(F, 0, 1, W0_G, W0_V, W0_D);
#endif
    SEAM(8);
    if (IN(9)) ffn_phases(F, 0, 2, W0_G, W0_V, W0_D);
    SEAM(9);
    if (IN(10)) {
        const TJob jobs[5] = {{F.a->in[20], DM, HY3, W + W1_IN}, {F.a->in[33], DM, DM, W + W1_OUT}, {F.a->in[34] + (size_t)DM * DFF, DM, DFF, W + W1_G}, {F.a->in[35] + (size_t)DM * DFF, DM, DFF, W + W1_V}, {F.a->in[38] + (size_t)DFF * DM, DFF, DM, W + W1_D}};
        transpose_jobs<5>(F, jobs); norm_phase(F, F.out, 1, 0, false);
#if DUP_PHASE == 99 || DUP_PHASE == 100
        transpose_jobs<5>(F, jobs);
#endif
#if DUP_PHASE == 99 || DUP_PHASE == 101
        norm_phase(F, F.out, 1, 0, false);
#endif
    }
    SEAM(10);
    if (IN(11)) { pg8::EpiBf16<0> E{WSB(WS_P), HY3, F.a->in[21], 0, 0, 1.f}; run_gemm(F, WSB(WS_H), W + W1_IN, MT, HY3, DM, E); }
    SEAM(11);
    if (IN(12)) p12_shortconv(F);
#if DUP_PHASE == 12 || DUP_PHASE == 99
    if (IN(12)) p12_shortconv(F);
#endif
    SEAM(12);
    if (IN(13)) { pg8::EpiBf16<0> E{WSB(WS_FILT), SEQ, nullptr, 0, 0, 1.f}; run_gemm(F, WSB(WS_W3T), WSB(WS_A3), 8192, SEQ, 256, E); }
    SEAM(13);
#if DUP_PHASE == 14
    if (IN(14)) p14_longconv(F, true);
#endif
    if (IN(14)) p14_longconv(F, false);
    SEAM(14);
    if (IN(15)) p15_transpose_y(F);
#if DUP_PHASE == 99 || DUP_PHASE == 15
    if (IN(15)) p15_transpose_y(F);
#endif
    SEAM(15);
    if (IN(16)) { pg8::EpiRes E{F.out, F.out, DM, WSF(WS_M) + 3 * 12288 + 2 * DM, F.a->in[5] + 12288 + 2 * DM}; run_gemm(F, WSB(WS_H), W + W1_OUT, MT, DM, DM, E); }
    SEAM(16);
    if (IN(17)) norm_phase(F, F.out, 1, 1, false);
#if DUP_PHASE == 99 || DUP_PHASE == 101
    if (IN(17)) norm_phase(F, F.out, 1, 1, false);
#endif
    SEAM(17);
    if (IN(18)) ffn_phases(F, 1, 0, W1_G, W1_V, W1_D);
    SEAM(18);
    if (IN(19)) ffn_phases(F, 1, 1, W1_G, W1_V, W1_D);
    SEAM(19);
    if (IN(20)) ffn_phases(F, 1, 2, W1_G, W1_V, W1_D);
#undef IN
#undef SEAM
}
#ifndef MK_MULTI
#define MK_MULTI 0
#endif
extern "C" void kernel_launch(void* const* d_in, const int* in_sizes, int n_in, void* d_out, int out_size, void* d_ws, size_t ws_size, hipStream_t stream) {
    static int grid = 0;
    if (grid == 0) {
        if (n_in != 39 || in_sizes[0] != MT * DM || out_size != MT * DM || ws_size < WS_END) { fprintf(stderr, "kernel_launch: unexpected shapes (n_in %d in0 %d out %d ws %zu)\n", n_in, n_in > 0 ? in_sizes[0] : -1, out_size, ws_size); grid = -1; return; }
        int dev = 0, cus = 0, per_cu = 0;
        hipGetDevice(&dev); hipDeviceGetAttribute(&cus, hipDeviceAttributeMultiprocessorCount, dev);
        if (hipFuncSetAttribute((const void*)mega_fwd, hipFuncAttributeMaxDynamicSharedMemorySize, LDS_BYTES) != hipSuccess) { fprintf(stderr, "kernel_launch: hipFuncSetAttribute failed\n"); grid = -1; return; }
        if (hipOccupancyMaxActiveBlocksPerMultiprocessor(&per_cu, (const void*)mega_fwd, 512, LDS_BYTES) != hipSuccess || per_cu < 1) { fprintf(stderr, "kernel_launch: occupancy query says %d\n", per_cu); per_cu = 1; }
        (void)hipGetLastError();
        grid = cus * per_cu;
    }
    if (grid < 0) return;
    hipMemsetAsync((char*)d_ws + WS_M, 0, CTL_ZERO_BYTES, stream);
    Args a{};
    for (int i = 0; i < 39; ++i) a.in[i] = (const float*)d_in[i];
    a.out = (float*)d_out; a.ws = (unsigned char*)d_ws;
#if MK_MULTI
    for (int p = 0; p < NPHASE; ++p) { a.ph_lo = p; a.ph_hi = p + 1; hipLaunchKernelGGL(mega_fwd, dim3(grid), dim3(512), LDS_BYTES, stream, a); }
#else
    a.ph_lo = 0; a.ph_hi = NPHASE;
    void* kargs[] = {&a};
    hipError_t e = hipLaunchCooperativeKernel((const void*)mega_fwd, dim3(grid), dim3(512), kargs, LDS_BYTES, stream);
    if (e != hipSuccess) fprintf(stderr, "cooperative launch failed: %s (grid %d)\n", hipGetErrorString(e), grid);
#endif
}
```

```cpp
#include <hip/hip_runtime.h>
#include <cstdio>
#include <cstdint>
namespace pg8 {
#define PG8_LAS __attribute__((address_space(3)))
typedef unsigned short bf16_t;
typedef short bf16x8 __attribute__((ext_vector_type(8)));
typedef float f32x4 __attribute__((ext_vector_type(4)));
typedef unsigned u32x4 __attribute__((ext_vector_type(4)));
constexpr int BM = 256, BK = 64, HALF = 128, HTB = HALF * BK * 2  , STAGE_BYTES = 8 * HTB, NXCD = 8, WGM = 8;

__host__ __device__ __forceinline__ int lds_byte(int r, int c) { const int st = (r >> 4) * 2 + (c >> 5), rr = r & 15, cc = c & 31, ob = rr * 64 + cc * 2; return st * 1024 + (ob ^ (((ob >> 9) & 1) << 5)); }
__host__ __device__ __forceinline__ void stage_rc(int b, int& R, int& C) { const int st = b / 1024, sb = b % 1024, swz = sb ^ (((sb >> 9) & 1) << 5); R = (st >> 1) * 16 + swz / 64; C = (st & 1) * 32 + (swz % 64) / 2; }
__host__ __device__ __forceinline__ int perm32(int rho) { const int n = rho >> 4, i = rho & 15; return 8 * (i >> 2) + 4 * n + (i & 3); }

struct Unit { int pm, pn; };
struct Gemm { const bf16_t* A; const bf16_t* Bt; int M, N, K; };

struct StaticOrder {
    int nM, nN, nwg, G, c;
    __host__ __device__ void init(int M, int N, int G_, int c_) { nM = M / BM; nN = N / BM; nwg = nM * nN; G = G_; c = c_; }
    __host__ __device__ bool next(int i, Unit& u) const {
        const long L = (long)i * G + c; if (L >= nwg) return false;
        int wgid = (int)L; { const int q = nwg / NXCD, r = nwg % NXCD, xcd = wgid % NXCD, off = wgid / NXCD; wgid = (xcd < r ? xcd * (q + 1) : r * (q + 1) + (xcd - r) * q) + off; }
        const int nig = WGM * nN, gid = wgid / nig, fm = gid * WGM, gsz = (nM - fm) < WGM ? (nM - fm) : WGM;
        u.pm = fm + ((wgid % nig) % gsz); u.pn = (wgid % nig) / gsz; return true;
    }
    __device__ __forceinline__ void a_ready(const Unit&) const {}
    __device__ __forceinline__ void done(const Unit&) const {}
};

__device__ __forceinline__ unsigned cvt_pk_bf16(float lo, float hi) { unsigned r; asm volatile("v_cvt_pk_bf16_f32 %0, %1, %2" : "=v"(r) : "v"(lo), "v"(hi)); return r; }
typedef float f32x2 __attribute__((ext_vector_type(2)));
__device__ __forceinline__ f32x2 gelu_pk(f32x2 v) {
    const f32x2 av = __builtin_elementwise_abs(v), d = av * 0.2316418882f + 1.0f;
    f32x2 t; t.x = __builtin_amdgcn_rcpf(d.x); t.y = __builtin_amdgcn_rcpf(d.y);
    f32x2 q = t * 0.5307027145f + (-0.7265760135f); q = q * t + 0.7107068705f; q = q * t + (-0.142248368f); q = q * t + 0.127414796f; q = q * t;
    const f32x2 s = (v * v) * (-0.72134752044f);
    f32x2 e; e.x = __builtin_amdgcn_exp2f(s.x); e.y = __builtin_amdgcn_exp2f(s.y);
    const f32x2 m = v * (q * e), r = v - m;
    f32x2 o; o.x = v.x < 0.f ? m.x : r.x; o.y = v.y < 0.f ? m.y : r.y; return o;
}

template <int ACT  > struct EpiBf16 {
    static constexpr bool PERM = true, AFTER_DRAIN = false; static_assert(ACT == 0 || ACT == 1, "EpiBf16: ACT is 0 (none) or 1 (gelu_pk)");
    bf16_t* O; int ldc; const float* bias; int split_cols; size_t split_stride; float scale0;
    __device__ __forceinline__ void operator()(const f32x4 (&acc)[2][2][4][2], const Unit& u, int wr, int wc, int fr, int fq) const {
        const int row0 = u.pm * BM + wr * 64 + fr; int colt = u.pn * BM; bf16_t* base = O;
        float sc = 1.f; if (split_cols) { const int t = colt / split_cols; base += (size_t)t * split_stride; colt -= t * split_cols; if (t == 0) sc = scale0; }
        const int col0 = colt + wc * 32 + 8 * fq, bcol0 = u.pn * BM + wc * 32 + 8 * fq;
        f32x4 bv[2][2];
#pragma unroll
        for (int bj = 0; bj < 2; ++bj)
#pragma unroll
            for (int n = 0; n < 2; ++n) bv[bj][n] = bias ? *(const f32x4*)(bias + bcol0 + bj * HALF + 4 * n) : (f32x4){0.f, 0.f, 0.f, 0.f};
#pragma unroll
        for (int ai = 0; ai < 2; ++ai)
#pragma unroll
            for (int m = 0; m < 4; ++m) { bf16_t* rowp = base + (size_t)(row0 + ai * HALF + m * 16) * ldc + col0;
#pragma unroll
                for (int bj = 0; bj < 2; ++bj) { f32x4 v0 = acc[ai][bj][m][0] + bv[bj][0], v1 = acc[ai][bj][m][1] + bv[bj][1];
                    if (ACT == 1) { f32x2 a = gelu_pk((f32x2){v0[0], v0[1]}), b = gelu_pk((f32x2){v0[2], v0[3]}), c = gelu_pk((f32x2){v1[0], v1[1]}), d = gelu_pk((f32x2){v1[2], v1[3]});
                        v0 = (f32x4){a.x, a.y, b.x, b.y}; v1 = (f32x4){c.x, c.y, d.x, d.y}; }
                    v0 = v0 * sc; v1 = v1 * sc; u32x4 w; w.x = cvt_pk_bf16(v0[0], v0[1]); w.y = cvt_pk_bf16(v0[2], v0[3]); w.z = cvt_pk_bf16(v1[0], v1[1]); w.w = cvt_pk_bf16(v1[2], v1[3]);
                    *(u32x4*)(rowp + bj * HALF) = w; } }
    }
};
struct EpiRes {
    static constexpr bool PERM = false, AFTER_DRAIN = false;
    const float* base; float* out; int ldc; const float* gm; const float* gb;
    __device__ __forceinline__ void operator()(const f32x4 (&acc)[2][2][4][2], const Unit& u, int wr, int wc, int fr, int fq) const {
        const int col0 = u.pn * BM + wc * 32 + 4 * fq; const int b = u.pm >> 6;
        const float* gmb = gm + (size_t)b * 12288;
        const size_t rowoff = (size_t)(u.pm * BM + wr * 64 + fr) * ldc;
#pragma unroll
        for (int bj = 0; bj < 2; ++bj)
#pragma unroll
          for (int ai = 0; ai < 2; ++ai) {
            f32x4 gt[2], bs[4][2];
#pragma unroll
            for (int n = 0; n < 2; ++n) { const int c = col0 + bj * HALF + n * 16; gt[n] = *(const f32x4*)(gmb + c) + *(const f32x4*)(gb + c); }
#pragma unroll
                for (int m = 0; m < 4; ++m)
#pragma unroll
                    for (int n = 0; n < 2; ++n) bs[m][n] = __builtin_nontemporal_load((const f32x4*)(base + rowoff + (size_t)(ai * HALF + m * 16) * ldc + col0 + bj * HALF + n * 16));
#pragma unroll
                for (int m = 0; m < 4; ++m)
#pragma unroll
                    for (int n = 0; n < 2; ++n) __builtin_nontemporal_store(bs[m][n] + gt[n] * acc[ai][bj][m][n], (f32x4*)(out + rowoff + (size_t)(ai * HALF + m * 16) * ldc + col0 + bj * HALF + n * 16));
            asm volatile("" ::: "memory"); }
    }
};
struct EpiGlu {
    static constexpr bool PERM = true, AFTER_DRAIN = false;
    const bf16_t* G; bf16_t* U; int ldc; const float* cw; const float* cb;
    __device__ __forceinline__ void operator()(const f32x4 (&acc)[2][2][4][2], const Unit& u, int wr, int wc, int fr, int fq) const {
        typedef unsigned u32x2 __attribute__((ext_vector_type(2)));
        const int row0 = u.pm * BM + wr * 64 + fr;
#pragma unroll
        for (int bj = 0; bj < 2; ++bj)
#pragma unroll
            for (int n = 0; n < 2; ++n) { const int c0 = u.pn * BM + bj * HALF + wc * 32 + 8 * fq + 4 * n;
                const f32x4 w0 = *(const f32x4*)(cw + c0), w1 = *(const f32x4*)(cw + ldc + c0), w2 = *(const f32x4*)(cw + 2 * ldc + c0), bb = *(const f32x4*)(cb + c0);
                u32x2 g0[8], gm[8], gn[8];
#pragma unroll
                for (int it = 0; it < 8; ++it) { const int row = row0 + (it >> 2) * HALF + (it & 3) * 16; const int t = row & 16383;
                    const bf16_t* gp = G + (size_t)row * ldc + c0;
                    g0[it] = *(const u32x2*)gp; gm[it] = *(const u32x2*)(t > 0 ? gp - ldc : gp); gn[it] = *(const u32x2*)(t < 16383 ? gp + ldc : gp); }
#pragma unroll
                for (int it = 0; it < 8; ++it) { const int ai = it >> 2, m = it & 3; const int row = row0 + ai * HALF + m * 16; const int t = row & 16383;
                    const float fm = t > 0 ? 1.f : 0.f, fn = t < 16383 ? 1.f : 0.f;
                    u32x2 o;
#pragma unroll
                    for (int e = 0; e < 2; ++e) {
                        float r2[2];
#pragma unroll
                        for (int hh = 0; hh < 2; ++hh) {
                            const float a0 = hh ? __uint_as_float(g0[it][e] & 0xffff0000u) : __uint_as_float(g0[it][e] << 16);
                            const float am = (hh ? __uint_as_float(gm[it][e] & 0xffff0000u) : __uint_as_float(gm[it][e] << 16)) * fm;
                            const float an = (hh ? __uint_as_float(gn[it][e] & 0xffff0000u) : __uint_as_float(gn[it][e] << 16)) * fn;
                            const float g = w0[2 * e + hh] * am + w1[2 * e + hh] * a0 + w2[2 * e + hh] * an + bb[2 * e + hh];
                            const float ex = __builtin_amdgcn_exp2f(-2.3022082f * g * (1.f + 0.044715f * g * g));
                            r2[hh] = g * __builtin_amdgcn_rcpf(1.f + ex) * acc[ai][bj][m][n][2 * e + hh];
                        }
                        o[e] = cvt_pk_bf16(r2[0], r2[1]);
                    }
                    *(u32x2*)(U + (size_t)row * ldc + c0) = o; }
                asm volatile("" ::: "memory");
            }
    }
};
struct EpiGV {
    static constexpr bool PERM = true, AFTER_DRAIN = false;
    bf16_t* U; int ldu; const float* cw; const float* cb; float* EG; float* EV; PG8_LAS float* XL;
    __device__ __forceinline__ static f32x4 shfl4(const f32x4 v, int src) { f32x4 r; r[0] = __shfl(v[0], src); r[1] = __shfl(v[1], src); r[2] = __shfl(v[2], src); r[3] = __shfl(v[3], src); return r; }
    __device__ __forceinline__ void operator()(const f32x4 (&acc)[2][2][4][2], const Unit& u, int wr, int wc, int fr, int fq) const {
        const int lane = (int)(threadIdx.x & 63u);
        const int cl = wc * 32 + 8 * fq;
#pragma unroll
        for (int ai = 0; ai < 2; ++ai) { const int blk = 2 * ai + wr;
            if (fr == 0) {
#pragma unroll
                for (int n = 0; n < 2; ++n) *(PG8_LAS f32x4*)(XL + (blk * 2 + 0) * 128 + cl + 4 * n) = acc[ai][0][0][n]; }
            if (fr == 15) {
#pragma unroll
                for (int n = 0; n < 2; ++n) *(PG8_LAS f32x4*)(XL + (blk * 2 + 1) * 128 + cl + 4 * n) = acc[ai][0][3][n]; } }
        asm volatile("s_waitcnt lgkmcnt(0)" ::: "memory"); __builtin_amdgcn_s_barrier(); asm volatile("" ::: "memory");
        const int c0 = u.pn * HALF + cl;
        f32x4 w0[2], w1[2], w2[2], bb[2];
#pragma unroll
        for (int n = 0; n < 2; ++n) { w0[n] = *(const f32x4*)(cw + c0 + 4 * n); w1[n] = *(const f32x4*)(cw + ldu + c0 + 4 * n); w2[n] = *(const f32x4*)(cw + 2 * ldu + c0 + 4 * n); bb[n] = *(const f32x4*)(cb + c0 + 4 * n); }
#pragma unroll
        for (int ai = 0; ai < 2; ++ai) { const int blk = 2 * ai + wr;
#pragma unroll
            for (int m = 0; m < 4; ++m) { const int rt = ai * HALF + wr * 64 + m * 16 + fr;
                u32x4 o;
#pragma unroll
                for (int n = 0; n < 2; ++n) {
                    const f32x4 g = acc[ai][0][m][n], v = acc[ai][1][m][n];
                    f32x4 a = shfl4(g, lane - 1), b;
                    if (m > 0) b = shfl4(acc[ai][0][m - 1][n], lane + 15);
                    else b = blk > 0 ? *(const PG8_LAS f32x4*)(XL + ((blk - 1) * 2 + 1) * 128 + cl + 4 * n) : (f32x4){0.f, 0.f, 0.f, 0.f};
                    const f32x4 up = fr == 0 ? b : a;
                    f32x4 a2 = shfl4(g, lane + 1), b2;
                    if (m < 3) b2 = shfl4(acc[ai][0][m + 1][n], lane - 15);
                    else b2 = blk < 3 ? *(const PG8_LAS f32x4*)(XL + ((blk + 1) * 2 + 0) * 128 + cl + 4 * n) : (f32x4){0.f, 0.f, 0.f, 0.f};
                    const f32x4 dn = fr == 15 ? b2 : a2;
                    const f32x4 gc = w0[n] * up + w1[n] * g + w2[n] * dn + bb[n];
                    float r[4];
#pragma unroll
                    for (int e = 0; e < 4; ++e) { const float x = gc[e]; const float ex = __builtin_amdgcn_exp2f(-2.3022082f * x * (1.f + 0.044715f * x * x)); r[e] = x * __builtin_amdgcn_rcpf(1.f + ex) * v[e]; }
                    o[2 * n] = cvt_pk_bf16(r[0], r[1]); o[2 * n + 1] = cvt_pk_bf16(r[2], r[3]);
                    if (rt <= 1 || rt >= 254) {
                        const int slot = rt <= 1 ? rt : rt - 252;
                        *(f32x4*)(EG + ((size_t)u.pm * 4 + slot) * ldu + c0 + 4 * n) = g;
                        if (rt == 0 || rt == 255) *(f32x4*)(EV + ((size_t)u.pm * 2 + (rt == 255)) * ldu + c0 + 4 * n) = v;
                    }
                }
                *(u32x4*)(U + (size_t)(u.pm * BM + rt) * ldu + c0) = o;
                if (m & 1) asm volatile("" ::: "memory"); }
        }
    }
};
template <class Epi, class Sched, bool ALIGN_EPI = false, bool SP2 = false>
__device__ __forceinline__ void gemm_phase(PG8_LAS unsigned char* lds, const Gemm g, const Sched& S, const Epi& E) {
    const int tid = threadIdx.x, wid = __builtin_amdgcn_readfirstlane(tid >> 6), lane = tid & 63, wr = wid >> 2, wc = wid & 3, fr = lane & 15, fq = lane >> 4;
    const int K = g.K, nt = K / BK;
    unsigned voffA[2], voffB[2];
#pragma unroll
    for (int i = 0; i < 2; ++i) { int R, C; stage_rc(tid * 16 + i * 8192, R, C); const int Rb = Epi::PERM ? ((R & ~31) + perm32(R & 31)) : R;
        voffA[i] = (unsigned)(R * K + C) * 2u; voffB[i] = (unsigned)(Rb * K + C) * 2u; }
    const size_t kstep = (size_t)(BK * 2);
    const size_t hstep = (size_t)HALF * K * 2;
    const size_t tstep = 2 * hstep;
    const unsigned ldsw = (unsigned)wid * 1024u;
    const int aoff = lds_byte(wr * 64 + fr, fq * 8), boff = lds_byte(wc * 32 + fr, fq * 8);
#define PG8_SA(b, h) (((b) * 2 + (h)) * HTB)
#define PG8_SB(b, h) ((4 + (b) * 2 + (h)) * HTB)
#define PG8_STAGE(bufoff, gbase, voff) do { _Pragma("unroll") for (int _i = 0; _i < 2; ++_i) \
        __builtin_amdgcn_global_load_lds((const unsigned*)((const char*)(gbase) + (voff)[_i]), (PG8_LAS unsigned*)(lds + (bufoff) + ldsw + _i * 8192), 16, 0, 0); } while (0)
#define PG8_LDA(dst, b, h) do { _Pragma("unroll") for (int m = 0; m < 4; ++m) _Pragma("unroll") for (int k = 0; k < 2; ++k) dst[m][k] = *(const PG8_LAS bf16x8*)(lds + PG8_SA(b, h) + aoff + m * 2048 + k * 1024); } while (0)
#define PG8_LDB(dst, b, h) do { _Pragma("unroll") for (int n = 0; n < 2; ++n) _Pragma("unroll") for (int k = 0; k < 2; ++k) dst[n][k] = *(const PG8_LAS bf16x8*)(lds + PG8_SB(b, h) + boff + n * 2048 + k * 1024); } while (0)
#define PG8_MMA(ai, bj, At, Bt) do { __builtin_amdgcn_s_setprio(1); _Pragma("unroll") for (int m = 0; m < 4; ++m) _Pragma("unroll") for (int n = 0; n < 2; ++n) _Pragma("unroll") for (int k = 0; k < 2; ++k) \
        acc[ai][bj][m][n] = __builtin_amdgcn_mfma_f32_16x16x32_bf16(Bt[n][k], At[m][k], acc[ai][bj][m][n], 0, 0, 0); __builtin_amdgcn_s_setprio(0); } while (0)
#define PG8_WAIT_V(n) asm volatile("s_waitcnt vmcnt(" #n ")" ::: "memory")
#define PG8_WAIT_L(n) asm volatile("s_waitcnt lgkmcnt(" #n ")" ::: "memory")
#define PG8_BAR __builtin_amdgcn_s_barrier()
#define PG8_SCHED __builtin_amdgcn_sched_barrier(0)
    Unit cur, nxt; int ui = 0;
    if (!S.next(0, cur)) return;
    f32x4 acc[2][2][4][2];
#pragma unroll
    for (int a = 0; a < 2; ++a)
#pragma unroll
        for (int b = 0; b < 2; ++b)
#pragma unroll
            for (int m = 0; m < 4; ++m)
#pragma unroll
                for (int n = 0; n < 2; ++n) acc[a][b][m][n] = (f32x4){0.f, 0.f, 0.f, 0.f};
    bf16x8 At[4][2], B0[2][2], B1[2][2];
    const char* cA = (const char*)g.A + (size_t)cur.pm * tstep; const char* cB = (const char*)g.Bt + (size_t)cur.pn * tstep;
    S.a_ready(cur);
    if constexpr (SP2) {
        PG8_STAGE(PG8_SB(0, 0), cB, voffB); PG8_STAGE(PG8_SB(0, 1), cB + hstep, voffB); PG8_STAGE(PG8_SA(0, 0), cA, voffA); PG8_STAGE(PG8_SA(0, 1), cA + hstep, voffA);
        if (wr == 1) PG8_BAR;
        PG8_WAIT_V(2); PG8_BAR;
        PG8_STAGE(PG8_SB(1, 0), cB + kstep, voffB); PG8_STAGE(PG8_SA(1, 0), cA + kstep, voffA); PG8_STAGE(PG8_SB(1, 1), cB + hstep + kstep, voffB);
        PG8_WAIT_V(6); PG8_BAR;
    } else {
        PG8_STAGE(PG8_SB(0, 0), cB, voffB); PG8_STAGE(PG8_SA(0, 0), cA, voffA); PG8_STAGE(PG8_SB(0, 1), cB + hstep, voffB); PG8_STAGE(PG8_SA(0, 1), cA + hstep, voffA);
        if (wr == 1) PG8_BAR;
        PG8_WAIT_V(4); PG8_BAR;
        PG8_STAGE(PG8_SB(1, 0), cB + kstep, voffB); PG8_STAGE(PG8_SA(1, 0), cA + kstep, voffA); PG8_STAGE(PG8_SB(1, 1), cB + hstep + kstep, voffB);
        PG8_WAIT_V(6); PG8_BAR;
    }
    for (;;) {
        const bool has_next = S.next(ui + 1, nxt);
        const char* nA = has_next ? (const char*)g.A + (size_t)nxt.pm * tstep : cA; const char* nB = has_next ? (const char*)g.Bt + (size_t)nxt.pn * tstep : cB;
        for (int t = 0; t < nt; t += 2) {
            const bool last = (t == nt - 2);
            const char* a1 = cA + (size_t)(t + 1) * kstep;
            const char* a2 = last ? nA : cA + (size_t)(t + 2) * kstep; const char* b2 = last ? nB : cB + (size_t)(t + 2) * kstep;
            const char* a3 = a2 + kstep; const char* b3 = b2 + kstep;
            if (last && has_next) S.a_ready(nxt);
            if constexpr (SP2) {
            PG8_LDB(B0, 0, 0); PG8_LDB(B1, 0, 1); PG8_SCHED; PG8_LDA(At, 0, 0); PG8_STAGE(PG8_SA(1, 1), a1 + hstep, voffA);
            PG8_WAIT_V(8); PG8_WAIT_L(0); PG8_BAR; PG8_MMA(0, 0, At, B0); PG8_MMA(0, 1, At, B1); PG8_BAR; PG8_SCHED;
            PG8_LDA(At, 0, 1); PG8_STAGE(PG8_SB(0, 0), b2, voffB); PG8_STAGE(PG8_SB(0, 1), b2 + hstep, voffB); PG8_STAGE(PG8_SA(0, 0), a2, voffA);
            PG8_WAIT_V(8); PG8_WAIT_L(0); PG8_BAR; PG8_MMA(1, 0, At, B0); PG8_MMA(1, 1, At, B1); PG8_BAR; PG8_SCHED;
            PG8_LDB(B0, 1, 0); PG8_LDB(B1, 1, 1); PG8_SCHED; PG8_LDA(At, 1, 0); PG8_STAGE(PG8_SA(0, 1), a2 + hstep, voffA);
            PG8_WAIT_V(8); PG8_WAIT_L(0); PG8_BAR; PG8_MMA(0, 0, At, B0); PG8_MMA(0, 1, At, B1); PG8_BAR; PG8_SCHED;
            PG8_LDA(At, 1, 1); PG8_STAGE(PG8_SB(1, 0), b3, voffB); PG8_STAGE(PG8_SB(1, 1), b3 + hstep, voffB); PG8_STAGE(PG8_SA(1, 0), a3, voffA);
            PG8_WAIT_V(8); PG8_WAIT_L(0); PG8_BAR; PG8_MMA(1, 0, At, B0); PG8_MMA(1, 1, At, B1); PG8_BAR; PG8_SCHED;
            } else {
            PG8_LDB(B0, 0, 0); PG8_SCHED; PG8_LDA(At, 0, 0); PG8_STAGE(PG8_SA(1, 1), a1 + hstep, voffA);
            PG8_WAIT_L(8); PG8_BAR; PG8_WAIT_L(0); PG8_MMA(0, 0, At, B0); PG8_BAR; PG8_SCHED;
            PG8_LDB(B1, 0, 1); PG8_STAGE(PG8_SB(0, 0), b2, voffB);
            PG8_BAR; PG8_WAIT_L(0); PG8_MMA(0, 1, At, B1); PG8_BAR;
            PG8_LDA(At, 0, 1); PG8_STAGE(PG8_SA(0, 0), a2, voffA);
            PG8_BAR; PG8_WAIT_L(0); PG8_MMA(1, 0, At, B0); PG8_BAR; PG8_SCHED;
            PG8_STAGE(PG8_SB(0, 1), b2 + hstep, voffB);
            PG8_WAIT_V(6); PG8_BAR; PG8_MMA(1, 1, At, B1); PG8_BAR;
            PG8_LDB(B0, 1, 0); PG8_SCHED; PG8_LDA(At, 1, 0); PG8_STAGE(PG8_SA(0, 1), a2 + hstep, voffA);
            PG8_WAIT_L(8); PG8_BAR; PG8_WAIT_L(0); PG8_MMA(0, 0, At, B0); PG8_BAR; PG8_SCHED;
            PG8_LDB(B1, 1, 1); PG8_STAGE(PG8_SB(1, 0), b3, voffB);
            PG8_BAR; PG8_WAIT_L(0); PG8_MMA(0, 1, At, B1); PG8_BAR;
            PG8_LDA(At, 1, 1); PG8_STAGE(PG8_SA(1, 0), a3, voffA);
            PG8_BAR; PG8_WAIT_L(0); PG8_MMA(1, 0, At, B0); PG8_BAR; PG8_SCHED;
            PG8_STAGE(PG8_SB(1, 1), b3 + hstep, voffB);
            PG8_WAIT_V(6); PG8_BAR; PG8_MMA(1, 1, At, B1); PG8_BAR;
            }
        }
        if constexpr (ALIGN_EPI) { if (wr == 0) PG8_BAR; }
        if constexpr (!Epi::AFTER_DRAIN) { E(acc, cur, wr, wc, fr, fq); S.done(cur); }
        if (!has_next) break;
#pragma unroll
        for (int a = 0; a < 2; ++a)
#pragma unroll
            for (int b = 0; b < 2; ++b)
#pragma unroll
                for (int m = 0; m < 4; ++m)
#pragma unroll
                    for (int n = 0; n < 2; ++n) acc[a][b][m][n] = (f32x4){0.f, 0.f, 0.f, 0.f};
        cur = nxt; cA = nA; cB = nB; ++ui;
        if constexpr (ALIGN_EPI) { if (wr == 1) PG8_BAR; }
    }
    PG8_WAIT_V(0);
    if constexpr (!ALIGN_EPI) { if (wr == 0) PG8_BAR; }
    PG8_BAR;
    if constexpr (Epi::AFTER_DRAIN) { E.fused(acc, cur, wr, wc, fr, fq, lds, wid, lane); S.done(cur); }
#undef PG8_SA
#undef PG8_SB
#undef PG8_STAGE
#undef PG8_LDA
#undef PG8_LDB
#undef PG8_MMA
#undef PG8_WAIT_V
#undef PG8_WAIT_L
#undef PG8_BAR
#undef PG8_SCHED
}
}
#include <hip/hip_cooperative_groups.h>
namespace cg = cooperative_groups;

constexpr int DM = 2048, NBATCH = 2, SEQ = 16384, CTXL = 256, MT = NBATCH * SEQ, MC = NBATCH * CTXL, MALL = MT + MC;
constexpr int INA = 4608, DFF = 5632, HY3 = 6144, NKEY = CTXL + SEQ  , NVH = 10;
constexpr float EPSN = 1e-6f, LOG2E = 1.4426950408889634f;
constexpr size_t MiB = 1u << 20;
constexpr size_t WS_M = 0;
constexpr size_t CTL_ZERO_BYTES = 512 * 1024;
constexpr size_t WS_LAM = 1 * MiB;
constexpr size_t WS_A3 = 2 * MiB;
constexpr size_t WS_W3T = 1008 * MiB;
constexpr size_t WS_W = 12 * MiB;
constexpr size_t WS_H = 110 * MiB;
constexpr size_t WS_P = 240 * MiB;
constexpr size_t WS_VT = 533 * MiB;
constexpr size_t WS_U = 592 * MiB;
constexpr size_t WS_T = 624 * MiB;
constexpr size_t WS_FILT = 238 * MiB + 2 * MiB;
constexpr size_t WS_SPEC = 500 * MiB;
constexpr size_t SPEC_SLOT = 135168;
constexpr size_t WS_END = 1024 * MiB;
static_assert(WS_FILT == WS_P, "filters overlay Z");
static_assert(WS_W + 98 * MiB <= WS_H && WS_H + (size_t)MALL * DM * 2 <= WS_P && WS_P + (size_t)MALL * INA * 2 <= WS_VT, "ws map 1");
static_assert(WS_VT + (size_t)NBATCH * NVH * 128 * NKEY * 2 <= WS_U + 30 * MiB, "ws map 2");
static_assert(WS_P + (size_t)MT * DFF * 2 <= WS_U && WS_U + (size_t)MT * DFF * 2 <= WS_END, "ws map 3");
static_assert(WS_P + (size_t)MT * HY3 * 2 <= WS_T && WS_T + (size_t)3 * MT * DM * 2 <= WS_END, "ws map 4");
static_assert(WS_FILT + (size_t)4 * DM * SEQ * 2 <= WS_SPEC && WS_SPEC + 256 * SPEC_SLOT <= WS_T, "ws map 5");
constexpr size_t W0_IN = 0, W0_OUT = W0_IN + (size_t)INA * DM, W0_G = W0_OUT + (size_t)DM * DM, W0_V = W0_G + (size_t)DFF * DM, W0_D = W0_V + (size_t)DFF * DM;
constexpr size_t W1_IN = 0, W1_OUT = W1_IN + (size_t)HY3 * DM, W1_G = W1_OUT + (size_t)DM * DM, W1_V = W1_G + (size_t)DFF * DM, W1_D = W1_V + (size_t)DFF * DM;
static_assert((W1_D + (size_t)DFF * DM) * 2 <= 98 * MiB, "weights region");

constexpr int RING_BYTES = 131072, MISC_OFF = 147456, LDS_BYTES = 147456 + 256;
constexpr size_t WS_BAR = 384 * 1024;
#define LAS __attribute__((address_space(3)))
typedef unsigned short bf16;
typedef unsigned v4u __attribute__((ext_vector_type(4)));
typedef unsigned v2u __attribute__((ext_vector_type(2)));
typedef float f32x4 __attribute__((ext_vector_type(4)));
typedef float f32x16 __attribute__((ext_vector_type(16)));
typedef short bf16x8 __attribute__((ext_vector_type(8)));
typedef float f32x2_t __attribute__((ext_vector_type(2))); typedef __bf16 bf16x2_t __attribute__((ext_vector_type(2)));
#define DI __device__ __forceinline__
DI unsigned cvtpk(float lo, float hi) { f32x2_t v = {lo, hi}; bf16x2_t b = __builtin_convertvector(v, bf16x2_t); return __builtin_bit_cast(unsigned, b); }
DI float bflo(unsigned w) { return __uint_as_float(w << 16); }
DI float bfhi(unsigned w) { return __uint_as_float(w & 0xffff0000u); }
DI float bf1(unsigned short v) { return __uint_as_float((unsigned)v << 16); }
DI float wave_sum(float v) {
#pragma unroll
    for (int o = 1; o < 64; o <<= 1) v += __shfl_xor(v, o);
    return v;
}
DI float fsin_rev(float r) { return __builtin_amdgcn_sinf(r); }
DI float fcos_rev(float r) { return __builtin_amdgcn_cosf(r); }
DI float fsin_rad(float x) { return __builtin_amdgcn_sinf(x * 0.15915494309189535f); }

struct Args { const float* in[39]; float* out; unsigned char* ws; int ph_lo, ph_hi; };
struct Frame {
    unsigned char* lds; int tid, lane, wave, gw, NGW;
    const Args* a; float* out; unsigned char* ws;
};
#define WSF(off) ((float*)(F.ws + (off)))
#define WSB(off) ((bf16*)(F.ws + (off)))

DI void transpose_item(const float* W, int K, int N, bf16* WT, float* scr, int item, int lane, int mode) {
    const int nblk = N / 32, kb = item / nblk, nb = item % nblk, k0 = 64 * kb, n0 = 32 * nb;
    const int d0 = mode == 0 ? n0 : (n0 >> 7) * 256 + (mode == 2 ? 128 : 0) + (n0 & 127);
#pragma unroll 8
    for (int i = 0; i < 32; ++i) { const int kk = 2 * i + (lane >> 5); scr[kk * 33 + (lane & 31)] = W[(size_t)(k0 + kk) * N + n0 + (lane & 31)]; }
    __builtin_amdgcn_fence(__ATOMIC_RELEASE, "wavefront"); asm volatile("s_waitcnt lgkmcnt(0)" ::: "memory");
    const int c = lane & 7;
#pragma unroll
    for (int j = 0; j < 4; ++j) { const int n = (lane >> 3) + 8 * j; const float* s = scr + (8 * c) * 33 + n;
        v4u o; o.x = cvtpk(s[0 * 33], s[1 * 33]); o.y = cvtpk(s[2 * 33], s[3 * 33]); o.z = cvtpk(s[4 * 33], s[5 * 33]); o.w = cvtpk(s[6 * 33], s[7 * 33]);
        *(v4u*)(WT + (size_t)(d0 + n) * K + k0 + 8 * c) = o; }
    asm volatile("s_waitcnt lgkmcnt(0)" ::: "memory");
}
struct TJob { const float* W; int K, N; bf16* WT; int mode; };
template <int NJ> DI void transpose_jobs(Frame& F, const TJob (&jobs)[NJ]) {
    float* scr = (float*)(F.lds + F.wave * 16384);
    int tot = 0;
#pragma unroll
    for (int j = 0; j < NJ; ++j) tot += (jobs[j].K / 64) * (jobs[j].N / 32);
    for (int it = F.gw; it < tot; it += F.NGW) {
        int r = it;
#pragma unroll
        for (int j = 0; j < NJ; ++j) { const int n = (jobs[j].K / 64) * (jobs[j].N / 32);
            if (r >= 0 && r < n) transpose_item(jobs[j].W, jobs[j].K, jobs[j].N, jobs[j].WT, scr, r, F.lane, jobs[j].mode);
            r -= n; }
    }
}
DI float silu(float x) { return x / (1.f + __expf(-x)); }

DI void p0_ada(Frame& F) {
    const float* ada_w = F.a->in[4]; const float* c = F.a->in[1]; const float* cctx = F.a->in[3]; float* M = WSF(WS_M);
    for (int it = F.gw; it < 1536; it += F.NGW) {
        const int l = it / 768, rem = it % 768, kc = rem / 48, ng = rem % 48;
        const float* W = ada_w + (size_t)l * DM * 12288 + (size_t)(kc * 128) * 12288 + ng * 256 + F.lane * 4;
        f32x4 a0 = {0, 0, 0, 0}, a1 = a0, a2 = a0;
#pragma unroll 8
        for (int k = 0; k < 128; ++k) { const f32x4 w = *(const f32x4*)(W + (size_t)k * 12288); const int kk = kc * 128 + k;
            const float s0 = silu(c[kk]), s1 = silu(c[DM + kk]), s2 = silu(cctx[kk]);
            a0 += w * s0; a1 += w * s1; a2 += w * s2; }
        float* m0 = M + (size_t)(l * 3) * 12288 + ng * 256 + F.lane * 4;
#pragma unroll
        for (int e = 0; e < 4; ++e) { unsafeAtomicAdd(m0 + e, a0[e]); unsafeAtomicAdd(m0 + 12288 + e, a1[e]); unsafeAtomicAdd(m0 + 2 * 12288 + e, a2[e]); }
    }
}
DI void p0_hyena_mlp(Frame& F) {
    const float *w0 = F.a->in[24], *b0 = F.a->in[25], *w1 = F.a->in[26], *b1 = F.a->in[27], *w2 = F.a->in[28], *b2 = F.a->in[29], *fq = F.a->in[30];
    bf16* a3 = WSB(WS_A3); const int lane = F.lane; const float freq = fq[lane];
    for (int pg = F.gw; pg < 2048; pg += F.NGW) {
        float a[8], acc[8];
#pragma unroll
        for (int q = 0; q < 8; ++q) { const float pos = (float)(pg * 8 + q); float z = 0.f;
            if (lane == 0) z = pos / 16383.f;
            else if (lane <= 32) { const int i = (lane - 1) & 15; const float f = 1e-4f + (float)i * ((15.f - 1e-4f) / 15.f); const float rev = f * pos * (1.f / 16384.f);
                z = lane <= 16 ? fcos_rev(rev) : -fsin_rev(rev); }
            a[q] = z; acc[q] = b0[lane]; }
        for (int i = 0; i < 33; ++i) { const float w = w0[i * 64 + lane];
#pragma unroll
            for (int q = 0; q < 8; ++q) acc[q] += __shfl(a[q], i) * w; }
#pragma unroll
        for (int q = 0; q < 8; ++q) { a[q] = fsin_rad(freq * acc[q]); acc[q] = b1[lane]; }
        for (int i = 0; i < 64; ++i) { const float w = w1[i * 64 + lane];
#pragma unroll
            for (int q = 0; q < 8; ++q) acc[q] += __shfl(a[q], i) * w; }
#pragma unroll
        for (int q = 0; q < 8; ++q) { a[q] = fsin_rad(freq * acc[q]); acc[q] = b2[lane]; }
        for (int i = 0; i < 64; ++i) { const float w = w2[i * 64 + lane];
#pragma unroll
            for (int q = 0; q < 8; ++q) acc[q] += __shfl(a[q], i) * w; }
#pragma unroll
        for (int q = 0; q < 8; ++q) { const float v = fsin_rad(freq * acc[q]); const unsigned hi = cvtpk(v, 0.f) & 0xffffu; const unsigned lo = cvtpk(v - __uint_as_float(hi << 16), 0.f) & 0xffffu;
            bf16* o = a3 + (size_t)(pg * 8 + q) * 256 + lane; o[0] = (bf16)hi; o[64] = (bf16)lo; o[128] = (bf16)hi; o[192] = 0; }
    }
    { const float* w3 = F.a->in[31]; bf16* w3t = WSB(WS_W3T);
      for (int idx = blockIdx.x * 512 + F.tid; idx < 64 * 8192; idx += gridDim.x * 512) { const int j = idx >> 13, n = idx & 8191; const float v = w3[idx];
          const unsigned hi = cvtpk(v, 0.f) & 0xffffu; const unsigned lo = cvtpk(v - __uint_as_float(hi << 16), 0.f) & 0xffffu;
          bf16* o = w3t + (size_t)n * 256 + j; o[0] = (bf16)hi; o[64] = (bf16)hi; o[128] = (bf16)lo; o[192] = 0; } }
}
DI void p0_lam(Frame& F) {
    if (blockIdx.x == 0 && F.wave == 0) {
        const float s1 = wave_sum(F.a->in[12][F.lane] * F.a->in[13][F.lane]), s2 = wave_sum(F.a->in[14][F.lane] * F.a->in[15][F.lane]);
        if (F.lane == 0) WSF(WS_LAM)[0] = __expf(s1) - __expf(s2) + 0.2f;
    }
}
DI void norm_rows(Frame& F, const float* src, int srow0, int nrows, bf16* dst, int drow0, const float* g, const float* msc, const float* bsc, const float* msh, const float* bsh) {
    int lane = F.lane; asm volatile("" : "+v"(lane));
    f32x4 A[8], B[8];
#pragma unroll
    for (int j = 0; j < 8; ++j) { const int c = 4 * lane + 256 * j;
        const f32x4 sc = *(const f32x4*)(msc + c) + *(const f32x4*)(bsc + c); A[j] = *(const f32x4*)(g + c) * (sc + 1.0f); B[j] = *(const f32x4*)(msh + c) + *(const f32x4*)(bsh + c); }
#ifndef NORM_REP
#define NORM_REP 1
#endif
#pragma unroll 1
    for (int rep = 0; rep < NORM_REP; ++rep)
    for (int r = F.gw; r < nrows; r += F.NGW) {
        const f32x4* xr = (const f32x4*)(src + (size_t)(srow0 + r) * DM) + lane;
        f32x4 v[8]; float ss = 0.f;
#pragma unroll
        for (int j = 0; j < 8; ++j) { v[j] = __builtin_nontemporal_load(xr + 64 * j); ss += (v[j].x * v[j].x + v[j].y * v[j].y) + (v[j].z * v[j].z + v[j].w * v[j].w); }
        const float rstd = rsqrtf(wave_sum(ss) * (1.f / DM) + EPSN);
        v2u* o = (v2u*)(dst + (size_t)(drow0 + r) * DM) + lane;
#pragma unroll
        for (int j = 0; j < 8; ++j) { const f32x4 y = v[j] * rstd * A[j] + B[j]; v2u w; w.x = cvtpk(y.x, y.y); w.y = cvtpk(y.z, y.w); o[64 * j] = w; }
    }
}
DI void norm_phase(Frame& F, const float* src, int l, int which, bool with_ctx) {
    const float* M = WSF(WS_M) + (size_t)l * 3 * 12288; const float* ab = F.a->in[5] + (size_t)l * 12288;
    const float* g = (which ? F.a->in[7] : F.a->in[6]) + (size_t)l * DM; const int csh = which ? 3 : 0, csc = which ? 4 : 1;
    for (int b = 0; b < NBATCH; ++b)
        norm_rows(F, src, b * SEQ, SEQ, WSB(WS_H), b * SEQ, g, M + b * 12288 + csc * DM, ab + csc * DM, M + b * 12288 + csh * DM, ab + csh * DM);
    if (with_ctx) norm_rows(F, F.a->in[2], 0, MC, WSB(WS_H), MT, g, M + 2 * 12288 + csc * DM, ab + csc * DM, M + 2 * 12288 + csh * DM, ab + csh * DM);
}
template <int SEGL> DI void qk_step(bf16* p, const float* gain, float scale, bool rope, int prow, int pcol, int lane, bool store) {
    const v4u raw = *(const v4u*)p;
    float x[8];
#pragma unroll
    for (int e = 0; e < 4; ++e) { x[2 * e] = bflo(raw[e]); x[2 * e + 1] = bfhi(raw[e]); }
    float ss = 0.f;
#pragma unroll
    for (int e = 0; e < 8; ++e) ss += x[e] * x[e];
#pragma unroll
    for (int o = 1; o < SEGL; o <<= 1) ss += __shfl_xor(ss, o);
    const float rstd = rsqrtf(ss * (1.f / (8 * SEGL)) + EPSN);
    const int k = lane & (SEGL - 1);
    const f32x4 g0 = *(const f32x4*)(gain + 8 * k), g1 = *(const f32x4*)(gain + 8 * k + 4);
#pragma unroll
    for (int e = 0; e < 8; ++e) x[e] *= rstd * (e < 4 ? g0[e & 3] : g1[e & 3]);
    if (rope) {
        constexpr int NF = 2 * SEGL;
        const int axis = k / (SEGL / 2), half = (k / (SEGL / 4)) & 1, f0 = 8 * (k & (SEGL / 4 - 1));
        const float pos = (float)(axis ? pcol : prow);
#pragma unroll
        for (int e = 0; e < 8; ++e) {
            const float xp = __shfl_xor(x[e], SEGL / 4);
            const float inv = __builtin_amdgcn_exp2f(-(float)(f0 + e) * (13.287712379549449f / NF));
            const float rev = pos * inv * 0.15915494309189535f;
            const float c = fcos_rev(rev), s = fsin_rev(rev);
            x[e] = half ? (x[e] * c + xp * s) : (x[e] * c - xp * s);
        }
    }
    if (store) { v4u o;
#pragma unroll
        for (int e = 0; e < 4; ++e) o[e] = cvtpk(x[2 * e] * scale, x[2 * e + 1] * scale);
        *(v4u*)p = o; }
}
DI int vt_perm_key(int pos) { const int gq = pos >> 4, h = (pos >> 3) & 1, j = pos & 7; return 16 * gq + 8 * (j >> 2) + 4 * h + (j & 3); }
DI void p3_rope(Frame& F, bool dry) {
    bf16* P = WSB(WS_P); const int lane = F.lane;
    const float *aq = F.a->in[10], *ak = F.a->in[11], *bq = F.a->in[17], *bk = F.a->in[18];
    for (int r = F.gw; r < MALL; r += F.NGW) {
        bf16* row = P + (size_t)r * INA + 8 * lane;
        if (r < MT) { const int t = r & (SEQ - 1), prow = t >> 6, pcol = t & 63;
            qk_step<8>(row, aq, 0.125f * LOG2E, true, prow, pcol, lane, !dry); qk_step<8>(row + 512, aq, 0.125f * LOG2E, true, prow, pcol, lane, !dry);
            qk_step<16>(row + 1024, bq, 0.08838834764831845f * LOG2E, true, prow, pcol, lane, !dry); qk_step<16>(row + 1536, bq, 0.08838834764831845f * LOG2E, true, prow, pcol, lane, !dry);
            qk_step<8>(row + 2048, ak, 1.f, true, prow, pcol, lane, !dry); qk_step<8>(row + 2560, ak, 1.f, true, prow, pcol, lane, !dry);
            qk_step<16>(row + 4096, bk, 1.f, true, prow, pcol, lane, !dry && lane < 32);
        } else {
            qk_step<8>(row + 2048, ak, 1.f, false, 0, 0, lane, !dry); qk_step<8>(row + 2560, ak, 1.f, false, 0, 0, lane, !dry);
            qk_step<16>(row + 4096, bk, 1.f, false, 0, 0, lane, !dry && lane < 32);
        }
    }
    unsigned char* scr = F.lds + F.wave * 17408;
    bf16* VT = WSB(WS_VT);
    for (int it = F.gw; it < NBATCH * 260 * NVH; it += F.NGW) {
        const int vh = it % NVH, kc = (it / NVH) % 260, b = it / (NVH * 260);
        const int srow0 = kc < 4 ? MT + b * CTXL + kc * 64 : b * SEQ + (kc - 4) * 64;
        const int scol = vh < 8 ? 3072 + vh * 128 : 4352 + (vh - 8) * 128;
#pragma unroll 4
        for (int i = 0; i < 16; ++i) { const int rr = 4 * i + (lane >> 4), ch = lane & 15;
            *(v4u*)(scr + rr * 272 + ch * 16) = *(const v4u*)(P + (size_t)(srow0 + rr) * INA + scol + ch * 8); }
        asm volatile("s_waitcnt vmcnt(0) lgkmcnt(0)" ::: "memory");
#pragma unroll 4
        for (int i = 0; i < 16; ++i) { const int pair = i * 64 + lane, d = pair >> 3, oct = pair & 7;
            unsigned short e[8];
#pragma unroll
            for (int j = 0; j < 8; ++j) e[j] = *(const unsigned short*)(scr + vt_perm_key(8 * oct + j) * 272 + 2 * d);
            v4u o; o.x = e[0] | ((unsigned)e[1] << 16); o.y = e[2] | ((unsigned)e[3] << 16); o.z = e[4] | ((unsigned)e[5] << 16); o.w = e[6] | ((unsigned)e[7] << 16);
            *(v4u*)(VT + ((size_t)(b * NVH + vh) * 128 + d) * NKEY + kc * 64 + 8 * oct) = o; }
        asm volatile("s_waitcnt lgkmcnt(0)" ::: "memory");
    }
}
#define MFMA32(a, b, c) __builtin_amdgcn_mfma_f32_32x32x16_bf16((a), (b), (c), 0, 0, 0)
DI int crow(int r, int hi) { return (r & 3) + 8 * (r >> 2) + 4 * hi; }
template <int DQK, bool WIN> DI void attn_pass(Frame& F, const bf16* P, const bf16* VTh, int b, int q0, int qcol, int kcol, f32x16 (&o)[4], float& lsum) {
    constexpr int KS = DQK / 16, KROWB = DQK * 2 + 16, KT_BYTES = 64 * KROWB, VROWB = 144, STG = KT_BYTES + 128 * VROWB, KLD = DQK / 64;
    const int tid = F.tid, lane = F.lane, r32 = lane & 31, hi = lane >> 5, wid = F.wave;
    unsigned char* lds = F.lds;
    bf16x8 qf[KS];
    { const bf16* qp = P + (size_t)(b * SEQ + q0 + wid * 32 + r32) * INA + qcol + 8 * hi;
#pragma unroll
      for (int s = 0; s < KS; ++s) qf[s] = *(const bf16x8*)(qp + 16 * s); }
#pragma unroll
    for (int d = 0; d < 4; ++d)
#pragma unroll
        for (int i = 0; i < 16; ++i) o[d][i] = 0.f;
    float l = 0.f;
    int band0 = 0, NT;
    if (WIN) { band0 = q0 - 128 < 0 ? 0 : q0 - 128; const int band1 = q0 + 384 > SEQ ? SEQ : q0 + 384; NT = 4 + (band1 - band0) / 64; } else NT = NKEY / 64;
    v4u kreg[KLD], vreg[2];
    int koff[KLD], voff[2];
#pragma unroll
    for (int i = 0; i < KLD; ++i) { const int idx = tid + 512 * i, rr = idx / (DQK / 8), ch = idx % (DQK / 8); koff[i] = rr * INA + ch * 8; }
#pragma unroll
    for (int i = 0; i < 2; ++i) { const int idx = tid + 512 * i, d = idx >> 3, ch = idx & 7; voff[i] = d * NKEY + ch * 8; }
#define ATT_ISSUE(t_) do { const int t__ = (t_); \
        const int kk0 = WIN ? (t__ < 4 ? 64 * t__ : CTXL + band0 + 64 * (t__ - 4)) : 64 * t__; \
        const int rowbase = kk0 < CTXL ? MT + b * CTXL + kk0 : b * SEQ + kk0 - CTXL; \
        const bf16* tk_ = P + (size_t)rowbase * INA + kcol; const bf16* tv_ = VTh + kk0; \
        _Pragma("unroll") for (int i = 0; i < KLD; ++i) kreg[i] = *(const v4u*)(tk_ + koff[i]); \
        _Pragma("unroll") for (int i = 0; i < 2; ++i) vreg[i] = *(const v4u*)(tv_ + voff[i]); } while (0)
#define ATT_COMMIT(st_) do { unsigned char* kb_ = lds + (st_) * STG; unsigned char* vb_ = kb_ + KT_BYTES; \
        _Pragma("unroll") for (int i = 0; i < KLD; ++i) { const int idx = tid + 512 * i, rr = idx / (DQK / 8), ch = idx % (DQK / 8); *(v4u*)(kb_ + rr * KROWB + ch * 16) = kreg[i]; } \
        _Pragma("unroll") for (int i = 0; i < 2; ++i) { const int idx = tid + 512 * i, d = idx >> 3, ch = idx & 7; *(v4u*)(vb_ + d * VROWB + ch * 16) = vreg[i]; } } while (0)
    __syncthreads();
    ATT_ISSUE(0); ATT_COMMIT(0); __syncthreads();
    const int qpos = q0 + wid * 32 + r32;
    for (int t = 0; t < NT; ++t) {
        if (t + 1 < NT) ATT_ISSUE(t + 1);
        const unsigned char* kb = lds + (t & 1) * STG; const unsigned char* vb = kb + KT_BYTES;
        f32x16 p0, p1;
#pragma unroll
        for (int i = 0; i < 16; ++i) { p0[i] = 0.f; p1[i] = 0.f; }
#pragma unroll
        for (int s = 0; s < KS; ++s) {
            const bf16x8 a0 = *(const bf16x8*)(kb + r32 * KROWB + (16 * s + 8 * hi) * 2);
            const bf16x8 a1 = *(const bf16x8*)(kb + (32 + r32) * KROWB + (16 * s + 8 * hi) * 2);
            p0 = MFMA32(a0, qf[s], p0); p1 = MFMA32(a1, qf[s], p1);
        }
        if (WIN && t >= 4) { const int kp0 = band0 + 64 * (t - 4);
#pragma unroll
            for (int i = 0; i < 16; ++i) { const int d0 = kp0 + crow(i, hi) - qpos, d1 = d0 + 32;
                p0[i] = (d0 >= -128 && d0 <= 128) ? __builtin_amdgcn_exp2f(p0[i]) : 0.f; p1[i] = (d1 >= -128 && d1 <= 128) ? __builtin_amdgcn_exp2f(p1[i]) : 0.f; }
        } else {
#pragma unroll
            for (int i = 0; i < 16; ++i) { p0[i] = __builtin_amdgcn_exp2f(p0[i]); p1[i] = __builtin_amdgcn_exp2f(p1[i]); }
        }
        float sa = 0.f, sb = 0.f;
#pragma unroll
        for (int i = 0; i < 16; ++i) { sa += p0[i]; sb += p1[i]; asm("" : "+v"(sb)); }
        l += sa + sb;
        bf16x8 pb[4];
#pragma unroll
        for (int s = 0; s < 2; ++s) {
            v4u w0, w1;
#pragma unroll
            for (int e = 0; e < 4; ++e) { w0[e] = cvtpk(p0[8 * s + 2 * e], p0[8 * s + 2 * e + 1]); w1[e] = cvtpk(p1[8 * s + 2 * e], p1[8 * s + 2 * e + 1]); }
            pb[s] = __builtin_bit_cast(bf16x8, w0); pb[2 + s] = __builtin_bit_cast(bf16x8, w1);
        }
#pragma unroll
        for (int db = 0; db < 4; ++db)
#pragma unroll
            for (int ks = 0; ks < 4; ++ks) {
                const bf16x8 a = *(const bf16x8*)(vb + (32 * db + r32) * VROWB + (16 * ks + 8 * hi) * 2);
                o[db] = MFMA32(a, pb[ks], o[db]);
            }
        if (t + 1 < NT) ATT_COMMIT((t + 1) & 1);
        __syncthreads();
    }
    lsum = l + __shfl_xor(l, 32);
#undef ATT_ISSUE
#undef ATT_COMMIT
}
DI void p4_attention(Frame& F) {
    const bf16* P = WSB(WS_P); const bf16* VT = WSB(WS_VT); bf16* O = WSB(WS_H);
    const int lane = F.lane, r32 = lane & 31, hi = lane >> 5, wid = F.wave;
    const float lam = WSF(WS_LAM)[0];
    if (wid >= 4) __builtin_amdgcn_s_setprio(1);
    for (int u = blockIdx.x; u < 2048; u += gridDim.x) {
        if (u < 1024) {
            const int b = u >> 9, head = (u >> 6) & 7, q0 = (u & 63) * 256;
            const bf16* VTh = VT + (size_t)(b * NVH + head) * 128 * NKEY;
            f32x16 o[4]; float l;
            attn_pass<64, false>(F, P, VTh, b, q0, head * 128, 2048 + head * 128, o, l);
            v4u* stash = (v4u*)(F.lds + 73728 + F.tid * 128);
            { const float rl = 1.f / l;
#pragma unroll
              for (int d = 0; d < 4; ++d)
#pragma unroll
                  for (int e4 = 0; e4 < 2; ++e4) { v4u w;
#pragma unroll
                      for (int e = 0; e < 4; ++e) w[e] = cvtpk(o[d][8 * e4 + 2 * e] * rl, o[d][8 * e4 + 2 * e + 1] * rl);
                      stash[d * 2 + e4] = w; } }
            attn_pass<64, false>(F, P, VTh, b, q0, head * 128 + 64, 2048 + head * 128 + 64, o, l);
            const float rl2 = lam / l; float ss = 0.f;
#pragma unroll
            for (int d = 0; d < 4; ++d)
#pragma unroll
                for (int e4 = 0; e4 < 2; ++e4) { const v4u w = stash[d * 2 + e4];
#pragma unroll
                    for (int e = 0; e < 4; ++e) { const float v0 = bflo(w[e]) - rl2 * o[d][8 * e4 + 2 * e], v1 = bfhi(w[e]) - rl2 * o[d][8 * e4 + 2 * e + 1]; o[d][8 * e4 + 2 * e] = v0; o[d][8 * e4 + 2 * e + 1] = v1; ss += v0 * v0 + v1 * v1; } }
            ss += __shfl_xor(ss, 32);
            const float rstd = rsqrtf(ss * (1.f / 128.f) + EPSN) * 0.8f;
            const float* sg = F.a->in[16];
            bf16* orow = O + (size_t)(b * SEQ + q0 + wid * 32 + r32) * DM + head * 128;
#pragma unroll
            for (int d = 0; d < 4; ++d)
#pragma unroll
                for (int g4 = 0; g4 < 4; ++g4) { const int dd = 32 * d + 8 * g4 + 4 * hi; const f32x4 gg = *(const f32x4*)(sg + dd);
                    v2u w; w.x = cvtpk(o[d][4 * g4] * rstd * gg.x, o[d][4 * g4 + 1] * rstd * gg.y); w.y = cvtpk(o[d][4 * g4 + 2] * rstd * gg.z, o[d][4 * g4 + 3] * rstd * gg.w);
                    *(v2u*)(orow + dd) = w; }
        } else {
            const int uu = u - 1024, b = uu >> 9, qh = (uu >> 6) & 7, q0 = (uu & 63) * 256, g = qh >> 2;
            const bf16* VTh = VT + (size_t)(b * NVH + 8 + g) * 128 * NKEY;
            f32x16 o[4]; float l;
            attn_pass<128, true>(F, P, VTh, b, q0, 1024 + qh * 128, 4096 + g * 128, o, l);
            const float rl = 1.f / (l + __expf(F.a->in[19][qh]));
            bf16* orow = O + (size_t)(b * SEQ + q0 + wid * 32 + r32) * DM + 1024 + qh * 128;
#pragma unroll
            for (int d = 0; d < 4; ++d)
#pragma unroll
                for (int g4 = 0; g4 < 4; ++g4) { const int dd = 32 * d + 8 * g4 + 4 * hi;
                    v2u w; w.x = cvtpk(o[d][4 * g4] * rl, o[d][4 * g4 + 1] * rl); w.y = cvtpk(o[d][4 * g4 + 2] * rl, o[d][4 * g4 + 3] * rl);
                    *(v2u*)(orow + dd) = w; }
        }
    }
    __builtin_amdgcn_s_setprio(0);
}
DI void p12_shortconv(Frame& F) {
    const bf16* Z = WSB(WS_P); bf16* T = WSB(WS_T); const float* cw = F.a->in[22]; const float* cb = F.a->in[23]; const int lane = F.lane;
    unsigned char* scr = F.lds + F.wave * 18432;
    for (int it = F.gw; it < NBATCH * 256 * 48; it += F.NGW) {
        const int cc = it % 48, tc = (it / 48) & 255, b = it / (48 * 256); const int t0 = tc * 64, c0 = cc * 128;
        for (int i = 0; i < 17; ++i) { const int rr = 4 * i + (lane >> 4), ch = lane & 15; const int t = t0 - 1 + rr;
            if (rr < 66) { v4u v = {0, 0, 0, 0}; if (t >= 0 && t < SEQ) v = *(const v4u*)(Z + (size_t)(b * SEQ + t) * HY3 + c0 + ch * 8); *(v4u*)(scr + rr * 272 + ch * 16) = v; } }
        asm volatile("s_waitcnt vmcnt(0) lgkmcnt(0)" ::: "memory");
#pragma unroll 2
        for (int i = 0; i < 16; ++i) { const int pair = i * 64 + lane, c = pair >> 3, oct = pair & 7; const int col = c0 + c;
            const float w0 = cw[col], w1 = cw[HY3 + col], w2 = cw[2 * HY3 + col], bb = cb[col];
            float z[10];
#pragma unroll
            for (int j = 0; j < 10; ++j) z[j] = bf1(*(const unsigned short*)(scr + (8 * oct + j) * 272 + 2 * c));
            v4u o;
#pragma unroll
            for (int e = 0; e < 4; ++e) { const float y0 = w0 * z[2 * e] + w1 * z[2 * e + 1] + w2 * z[2 * e + 2] + bb, y1 = w0 * z[2 * e + 1] + w1 * z[2 * e + 2] + w2 * z[2 * e + 3] + bb; o[e] = cvtpk(y0, y1); }
            const int which = col >> 11, ch = col & 2047;
            *(v4u*)(T + (((size_t)which * NBATCH + b) * DM + ch) * SEQ + t0 + 8 * oct) = o; }
        asm volatile("s_waitcnt lgkmcnt(0)" ::: "memory");
    }
}
typedef float2 cf;
constexpr int FM = 16384;
#define FPAD(i) ((i) + (((i) >> 6) << 2))
#define NOSLP(v) asm("" : "+v"((v).y))
DI cf cmul(cf a, cf b) { cf r = make_float2(a.x * b.x - a.y * b.y, a.x * b.y + a.y * b.x); NOSLP(r); return r; }
DI cf cmulc(cf a, cf b) { cf r = make_float2(a.x * b.x + a.y * b.y, a.y * b.x - a.x * b.y); NOSLP(r); return r; }
DI cf cadd(cf a, cf b) { cf r = make_float2(a.x + b.x, a.y + b.y); NOSLP(r); return r; }
DI cf csub(cf a, cf b) { cf r = make_float2(a.x - b.x, a.y - b.y); NOSLP(r); return r; }
template <bool INV> DI void r4(cf& a0, cf& a1, cf& a2, cf& a3) {
    const cf t0 = cadd(a0, a2), t1 = csub(a0, a2), t2 = cadd(a1, a3), t3 = csub(a1, a3);
    a0 = cadd(t0, t2); a2 = csub(t0, t2);
    if (!INV) { a1 = make_float2(t1.x + t3.y, t1.y - t3.x); a3 = make_float2(t1.x - t3.y, t1.y + t3.x); }
    else      { a1 = make_float2(t1.x - t3.y, t1.y + t3.x); a3 = make_float2(t1.x + t3.y, t1.y - t3.x); }
    NOSLP(a1); NOSLP(a3);
}
template <bool INV> DI void fft16(cf (&v)[16]) {
    constexpr float C1 = 0.9238795325112867f, S1 = 0.3826834323650898f, C2 = 0.7071067811865476f;
    const cf W[10] = {make_float2(1.f, 0.f), make_float2(C1, -S1), make_float2(C2, -C2), make_float2(S1, -C1), make_float2(0.f, -1.f), make_float2(-S1, -C1), make_float2(-C2, -C2), make_float2(-C1, -S1), make_float2(-1.f, 0.f), make_float2(-C1, S1)};
    if (!INV) {
#pragma unroll
        for (int i0 = 0; i0 < 4; ++i0) r4<false>(v[i0], v[4 + i0], v[8 + i0], v[12 + i0]);
#pragma unroll
        for (int m = 1; m < 4; ++m)
#pragma unroll
            for (int i0 = 1; i0 < 4; ++i0) v[4 * m + i0] = cmul(v[4 * m + i0], W[i0 * m]);
#pragma unroll
        for (int m = 0; m < 4; ++m) r4<false>(v[4 * m], v[4 * m + 1], v[4 * m + 2], v[4 * m + 3]);
    } else {
#pragma unroll
        for (int m = 0; m < 4; ++m) r4<true>(v[4 * m], v[4 * m + 1], v[4 * m + 2], v[4 * m + 3]);
#pragma unroll
        for (int m = 1; m < 4; ++m)
#pragma unroll
            for (int i0 = 1; i0 < 4; ++i0) v[4 * m + i0] = cmulc(v[4 * m + i0], W[i0 * m]);
#pragma unroll
        for (int i0 = 0; i0 < 4; ++i0) r4<true>(v[i0], v[4 + i0], v[8 + i0], v[12 + i0]);
    }
}
template <int S, bool INV, bool HALF = false> DI void fft_pass16(cf* cx, int tid) {
    constexpr int stride = S / 16;
    constexpr int estr = stride + (stride >= 64 ? 4 * (stride / 64) : 0);
    asm volatile("" : "+v"(tid));
#pragma unroll 2
    for (int u = tid; u < FM / 16; u += 512) {
        const int blk = u / stride, i = u % stride, base = blk * S + i;
        cf* p = cx + FPAD(base);
        const float rev = (float)i * (1.f / S);
        const cf w1 = make_float2(fcos_rev(rev), -fsin_rev(rev));
        cf v[16];
        if (!INV) {
#pragma unroll
            for (int j = 0; j < 16; ++j) v[j] = (HALF && j >= 8) ? make_float2(0.f, 0.f) : p[j * estr];
            fft16<false>(v);
            cf w = w1; p[0] = v[0];
#pragma unroll
            for (int f = 1; f < 16; ++f) { const int q = 4 * (f & 3) + (f >> 2); p[f * estr] = cmul(v[q], w); w = cmul(w, w1); }
        } else {
            cf w = w1; v[0] = p[0];
#pragma unroll
            for (int f = 1; f < 16; ++f) { const int q = 4 * (f & 3) + (f >> 2); v[q] = cmulc(p[f * estr], w); w = cmul(w, w1); }
            fft16<true>(v);
#pragma unroll
            for (int j = 0; j < (HALF ? 8 : 16); ++j) p[j * estr] = v[j];
        }
    }
}
template <bool INV> DI void fft_pass4(cf* cx, int tid) {
    asm volatile("" : "+v"(tid));
#pragma unroll 1
    for (int u = tid; u < FM / 4; u += 512) { cf* p = cx + FPAD(4 * u);
        cf a0 = p[0], a1 = p[1], a2 = p[2], a3 = p[3];
        r4<INV>(a0, a1, a2, a3);
        p[0] = a0; p[1] = a1; p[2] = a2; p[3] = a3; }
}
template <bool HALF> DI void fft_fwd(cf* cx, int tid) {
    fft_pass16<16384, false, HALF>(cx, tid); __syncthreads(); fft_pass16<1024, false>(cx, tid); __syncthreads(); fft_pass16<64, false>(cx, tid); __syncthreads(); fft_pass4<false>(cx, tid); __syncthreads();
}
template <bool HALF> DI void fft_inv(cf* cx, int tid) {
    fft_pass4<true>(cx, tid); __syncthreads(); fft_pass16<64, true>(cx, tid); __syncthreads(); fft_pass16<1024, true>(cx, tid); __syncthreads(); fft_pass16<16384, true, HALF>(cx, tid); __syncthreads();
}
DI int fposu(int k) { return ((k & 15) << 10) | (((k >> 4) & 15) << 6) | (((k >> 8) & 15) << 2) | (k >> 12); }
DI void rsplit(cf Zk, cf Zm, cf w, cf& Uk, cf& Um) {
    cf E = make_float2(0.5f * (Zk.x + Zm.x), 0.5f * (Zk.y - Zm.y)), O = make_float2(0.5f * (Zk.y + Zm.y), -0.5f * (Zk.x - Zm.x));
    NOSLP(E); NOSLP(O);
    const cf T = cmul(w, O);
    Uk = cadd(E, T); Um = make_float2(E.x - T.x, -(E.y - T.y)); NOSLP(Um);
}
DI void p14_longconv(Frame& F, bool dry) {
    cf* cx = (cf*)F.lds; float* red = (float*)(F.lds + 139264); int tid = F.tid;
    const bf16* FILT = WSB(WS_FILT); bf16* T = WSB(WS_T); const float* dsk = F.a->in[32];
    cf* spec = (cf*)(F.ws + WS_SPEC + (size_t)blockIdx.x * SPEC_SLOT);
    for (int c = blockIdx.x; c < DM; c += gridDim.x) {
        const float delta = fabsf(-3.0701134573253944f + (float)c * ((-15.350567286626972f + 3.0701134573253944f) / 2047.f));
        const float dk = delta * (1.f / 16383.f) * LOG2E;
        for (int ord = 0; ord < 2; ++ord) {
            const bf16* hf = FILT + ((size_t)(ord * 2 + 0) * DM + c) * SEQ; const bf16* hb = FILT + ((size_t)(ord * 2 + 1) * DM + c) * SEQ;
            __syncthreads();
            asm volatile("" : "+v"(tid));
            float asum = 0.f;
#pragma unroll 8
            for (int n = tid; n < FM; n += 512) {
                float v0, v1;
                if (n < FM / 2) { const unsigned w = *(const unsigned*)(hf + 2 * n); v0 = bflo(w) * __builtin_amdgcn_exp2f(-(float)(2 * n) * dk); v1 = bfhi(w) * __builtin_amdgcn_exp2f(-(float)(2 * n + 1) * dk); }
                else { const int m0 = 2 * n, m1 = 2 * n + 1;
                    const int s0 = 2 * SEQ - m0, s1 = 2 * SEQ - m1;
                    v0 = (m0 == SEQ) ? 0.f : bf1(hb[s0]) * __builtin_amdgcn_exp2f(-(float)s0 * dk); v1 = bf1(hb[s1]) * __builtin_amdgcn_exp2f(-(float)s1 * dk); }
                asum += fabsf(v0) + fabsf(v1); cx[FPAD(n)] = make_float2(v0, v1);
            }
            asum = wave_sum(asum); if (F.lane == 0) red[F.wave] = asum;
            __syncthreads();
            float tot = 0.f;
#pragma unroll
            for (int w = 0; w < 8; ++w) tot += red[w];
            const float fscale = 1.f / (tot * (float)FM);
            fft_fwd<false>(cx, tid);
#pragma unroll 8
            for (int e = tid; e < FM / 2; e += 512) {
                const int pu = 4 * (e >> 1) + (e & 1), k = 4096 * (e & 1) + 256 * ((e >> 1) & 15) + 16 * ((e >> 5) & 15) + (e >> 9);
                if (e == 0) { const cf z = cx[0]; spec[0] = make_float2((z.x + z.y) * fscale, 0.f); spec[FM] = make_float2((z.x - z.y) * fscale, 0.f);
                    const cf z2 = cx[2]; spec[2] = make_float2(z2.x * fscale, -z2.y * fscale); }
                else { const int km = FM - k, pmu = fposu(km); const float rev = (float)k * (1.f / (2 * FM)); const cf w = make_float2(fcos_rev(rev), -fsin_rev(rev)); cf Uk, Um;
                    rsplit(cx[FPAD(pu)], cx[FPAD(pmu)], w, Uk, Um); spec[pu] = make_float2(Uk.x * fscale, Uk.y * fscale); spec[pmu] = make_float2(Um.x * fscale, Um.y * fscale); }
            }
            __threadfence_block();
            const float dskip = dsk[ord * DM + c];
            for (int b = 0; b < NBATCH; ++b) {
                bf16* u = T + ((size_t)(0 * NBATCH + b) * DM + c) * SEQ;
                const bf16* gate = T + ((size_t)((1 + ord) * NBATCH + b) * DM + c) * SEQ;
                __syncthreads();
                asm volatile("" : "+v"(tid));
                unsigned uw[16], gw[16]; cf s1[16], s2[16];
#pragma unroll
                for (int q = 0; q < 16; ++q) uw[q] = *(const unsigned*)(u + 2 * (tid + 512 * q));
#pragma unroll
                for (int q = 0; q < 16; ++q) cx[FPAD(tid + 512 * q)] = make_float2(bflo(uw[q]), bfhi(uw[q]));
#pragma unroll
                for (int q = 0; q < 16; ++q) {
                    const int e = tid + 512 * q; gw[q] = *(const unsigned*)(gate + 2 * e);
                    const int pu = 4 * (e >> 1) + (e & 1), k = 4096 * (e & 1) + 256 * ((e >> 1) & 15) + 16 * ((e >> 5) & 15) + (e >> 9);
                    s1[q] = spec[pu]; }
                const cf sx = spec[2];
                __syncthreads();
                fft_fwd<true>(cx, tid);
#pragma unroll
                for (int q = 0; q < 16; ++q) { const int e = tid + 512 * q; const int k = 4096 * (e & 1) + 256 * ((e >> 1) & 15) + 16 * ((e >> 5) & 15) + (e >> 9); s2[q] = spec[e == 0 ? FM : fposu(FM - k)]; }
#pragma unroll
                for (int q = 0; q < 16; ++q) {
                    const int e = tid + 512 * q;
                    const int pu = 4 * (e >> 1) + (e & 1), k = 4096 * (e & 1) + 256 * ((e >> 1) & 15) + 16 * ((e >> 5) & 15) + (e >> 9);
                    if (q == 0 && e == 0) { const cf z = cx[0]; const float y0 = (z.x + z.y) * s1[0].x, ym = (z.x - z.y) * s2[0].x; cx[0] = make_float2(0.5f * (y0 + ym), 0.5f * (y0 - ym));
                        const cf z2 = cx[2]; const cf y2 = cmul(make_float2(z2.x, -z2.y), sx); cx[2] = make_float2(y2.x, -y2.y); }
                    else { const int km = FM - k, pmu = fposu(km); const float rev = (float)k * (1.f / (2 * FM)); const cf w = make_float2(fcos_rev(rev), -fsin_rev(rev)); cf Uk, Um;
                        const int pk = FPAD(pu), pm = FPAD(pmu);
                        rsplit(cx[pk], cx[pm], w, Uk, Um);
                        const cf Yk = cmul(Uk, s1[q]), Ym = cmul(Um, s2[q]);
                        cf E = make_float2(0.5f * (Yk.x + Ym.x), 0.5f * (Yk.y - Ym.y)), D = make_float2(0.5f * (Yk.x - Ym.x), 0.5f * (Yk.y + Ym.y)); NOSLP(E); NOSLP(D);
                        const cf O = cmulc(D, w);
                        cx[pk] = make_float2(E.x - O.y, E.y + O.x); cx[pm] = make_float2(E.x + O.y, -E.y + O.x); }
                    if (q & 1) asm volatile("" ::: "memory");
                }
                __syncthreads();
                fft_inv<true>(cx, tid);
#pragma unroll
                for (int q = 0; q < 16; ++q) { const int n = tid + 512 * q; const cf y = cx[FPAD(n)];
                    const float r0 = (y.x + dskip * bflo(uw[q])) * bflo(gw[q]), r1 = (y.y + dskip * bfhi(uw[q])) * bfhi(gw[q]);
                    if (!dry) *(unsigned*)(u + 2 * n) = cvtpk(r0, r1); }
                __threadfence_block();
            }
        }
    }
}
DI void p15_transpose_y(Frame& F) {
    const bf16* T = WSB(WS_T); bf16* Y = WSB(WS_H); const int lane = F.lane;
    unsigned char* scr = F.lds + F.wave * 9216;
    for (int it = F.gw; it < NBATCH * 256 * 32; it += F.NGW) {
        const int cc = it & 31, tc = (it >> 5) & 255, b = it >> 13; const int c0 = cc * 64, t0 = tc * 64;
#pragma unroll
        for (int i = 0; i < 8; ++i) { const int rr = 8 * i + (lane >> 3), ch = lane & 7;
            *(v4u*)(scr + rr * 144 + ch * 16) = *(const v4u*)(T + ((size_t)b * DM + c0 + rr) * SEQ + t0 + ch * 8); }
        asm volatile("s_waitcnt vmcnt(0) lgkmcnt(0)" ::: "memory");
#pragma unroll 2
        for (int i = 0; i < 8; ++i) { const int pair = i * 64 + lane, t = pair >> 3, oct = pair & 7;
            unsigned short e[8];
#pragma unroll
            for (int j = 0; j < 8; ++j) e[j] = *(const unsigned short*)(scr + (8 * oct + j) * 144 + 2 * t);
            v4u o; o.x = e[0] | ((unsigned)e[1] << 16); o.y = e[2] | ((unsigned)e[3] << 16); o.z = e[4] | ((unsigned)e[5] << 16); o.w = e[6] | ((unsigned)e[7] << 16);
            *(v4u*)(Y + (size_t)(b * SEQ + t0 + t) * DM + c0 + 8 * oct) = o; }
        asm volatile("s_waitcnt lgkmcnt(0)" ::: "memory");
    }
}
#define GAS __attribute__((address_space(1)))
#define RLX_AGENT __ATOMIC_RELAXED, __HIP_MEMORY_SCOPE_AGENT
#define XB_TMO      128
#define XB_XCNT(j)  (256  + 64 * (j))
#define XB_XSUB(j)  (1280 + 64 * (j))
#define XB_XGEN(j)  (2304 + 64 * (j))
#define XB_TOP      3328
#define XB_TOPGEN   3392
#define XCD_BAR_WORDS 3456
#define XB_SPIN_CAP (1u << 18)

__device__ __forceinline__ unsigned xb_ld(unsigned* p)              { return __hip_atomic_load(p, __ATOMIC_RELAXED, __HIP_MEMORY_SCOPE_AGENT); }
__device__ __forceinline__ unsigned xb_add(unsigned* p, unsigned v) { return __hip_atomic_fetch_add(p, v, __ATOMIC_RELAXED, __HIP_MEMORY_SCOPE_AGENT); }
__device__ __forceinline__ unsigned xb_xcc_id() { return (unsigned)__builtin_amdgcn_s_getreg((3 << 11) | 20) & 0xFu; }
#define XB_SPIN(cond, bar) do { unsigned _sp = 0; while (cond) { __builtin_amdgcn_s_sleep(1); \
    if ((++_sp & 255u) == 0u) { if (xb_ld(&(bar)[XB_TMO])) break; if (_sp > XB_SPIN_CAP) { atomicAdd(&(bar)[XB_TMO], 1u); break; } } } } while (0)

struct XcdBarrier {
    unsigned* bar; unsigned x;
    volatile LAS unsigned* st;
};

__device__ __forceinline__ XcdBarrier xcd_barrier_post(unsigned* bar, volatile LAS unsigned* st) {
    XcdBarrier b; b.bar = bar; b.x = xb_xcc_id(); b.st = st;
    if (threadIdx.x == 0) (void)xb_add(&bar[XB_XCNT(b.x)], 1u);
    return b;
}
__device__ __forceinline__ void xcd_barrier_complete(unsigned* bar, unsigned x, unsigned& nloc, unsigned& nx) {
    const unsigned G = gridDim.x * gridDim.y * gridDim.z;
    unsigned sum, cnt, mine, sp = 0u;
    for (;;) {
        sum = 0u; cnt = 0u; mine = 0u;
#pragma unroll
        for (unsigned j = 0; j < 16; ++j) { const unsigned c = xb_ld(&bar[XB_XCNT(j)]); sum += c; cnt += (c > 0u) ? 1u : 0u; mine = (j == x) ? c : mine; }
        if (sum == G) break;
        __builtin_amdgcn_s_sleep(1);
        if ((++sp & 255u) == 0u) { if (xb_ld(&bar[XB_TMO])) break; if (sp > XB_SPIN_CAP) { atomicAdd(&bar[XB_TMO], 1u); break; } }
    }
    nloc = mine > 0u ? mine : 1u; nx = cnt > 0u ? cnt : 1u;
}

__device__ __forceinline__ void xcd_barrier(const XcdBarrier& b) {
    asm volatile("s_waitcnt vmcnt(0)" ::: "memory");
    __syncthreads();
    if (threadIdx.x == 0) {
        unsigned* bar = b.bar;
        __builtin_amdgcn_s_waitcnt(0);
        unsigned nloc = b.st[0], nx = b.st[1];
        if (nloc == 0u) { xcd_barrier_complete(bar, b.x, nloc, nx); b.st[0] = nloc; b.st[1] = nx; }
        const unsigned old = xb_add(&bar[XB_XSUB(b.x)], 1u);
        const unsigned gen = old / nloc;
        if (old + 1u == (gen + 1u) * nloc) {
            __builtin_amdgcn_fence(__ATOMIC_RELEASE, "agent");
            asm volatile("s_waitcnt vmcnt(0)" ::: "memory");
            const unsigned og = xb_add(&bar[XB_TOP], 1u);
            const unsigned tg = og / nx;
            if (og + 1u == (tg + 1u) * nx) xb_add(&bar[XB_TOPGEN], 1u);
            else XB_SPIN(xb_ld(&bar[XB_TOPGEN]) == tg, bar);
            __builtin_amdgcn_fence(__ATOMIC_ACQUIRE, "agent");
            xb_add(&bar[XB_XGEN(b.x)], 1u);
            asm volatile("s_waitcnt vmcnt(0)" ::: "memory");
        } else {
            XB_SPIN(xb_ld(&bar[XB_XGEN(b.x)]) == gen, bar);
            __builtin_amdgcn_fence(__ATOMIC_ACQUIRE, "agent");
            asm volatile("s_waitcnt vmcnt(0)" ::: "memory");
        }
    }
    __syncthreads();
}

#ifndef STAGGER_TICKS
#define STAGGER_TICKS 0
#endif
template <class Epi> DI void run_gemm(Frame& F, const bf16* A, const bf16* Bt, int M, int N, int K, const Epi& E, bool stagger = false) {
    if (STAGGER_TICKS > 0 && stagger && (blockIdx.x & 8)) {
        const unsigned long long t0 = __builtin_amdgcn_s_memrealtime();
        while (__builtin_amdgcn_s_memrealtime() - t0 < (unsigned long long)STAGGER_TICKS) __builtin_amdgcn_s_sleep(32);
    }
    __syncthreads();
    pg8::Gemm g{A, Bt, M, N, K}; pg8::StaticOrder S; S.init(M, N, (int)gridDim.x, (int)blockIdx.x);
    pg8::gemm_phase<Epi, pg8::StaticOrder, true, true>((PG8_LAS unsigned char*)F.lds, g, S, E);
    __syncthreads();
}
constexpr size_t WS_EG = WS_P, WS_EV = WS_P + 16 * MiB;
DI void glu_fixup(Frame& F, int l) {
    const float* EG = WSF(WS_EG); const float* EV = WSF(WS_EV); bf16* U = WSB(WS_U);
    const float* cw = F.a->in[36] + (size_t)l * 3 * DFF; const float* cb = F.a->in[37] + (size_t)l * DFF;
    for (int idx = blockIdx.x * 512 + F.tid; idx < 128 * 2 * (DFF / 4); idx += gridDim.x * 512) {
        const int c = (idx % (DFF / 4)) * 4, which = (idx / (DFF / 4)) & 1, pm = idx / (2 * (DFF / 4));
        const int row = pm * 256 + (which ? 255 : 0), t = row & (SEQ - 1);
        const f32x4 z = {0.f, 0.f, 0.f, 0.f};
        const f32x4 g = *(const f32x4*)(EG + ((size_t)pm * 4 + (which ? 3 : 0)) * DFF + c);
        const f32x4 up = which ? *(const f32x4*)(EG + ((size_t)pm * 4 + 2) * DFF + c) : (t == 0 ? z : *(const f32x4*)(EG + ((size_t)(pm - 1) * 4 + 3) * DFF + c));
        const f32x4 dn = which ? (t == SEQ - 1 ? z : *(const f32x4*)(EG + ((size_t)(pm + 1) * 4 + 0) * DFF + c)) : *(const f32x4*)(EG + ((size_t)pm * 4 + 1) * DFF + c);
        const f32x4 v = *(const f32x4*)(EV + ((size_t)pm * 2 + which) * DFF + c);
        const f32x4 gc = *(const f32x4*)(cw + c) * up + *(const f32x4*)(cw + DFF + c) * g + *(const f32x4*)(cw + 2 * DFF + c) * dn + *(const f32x4*)(cb + c);
        float r[4];
#pragma unroll
        for (int e = 0; e < 4; ++e) { const float x = gc[e]; const float ex = __builtin_amdgcn_exp2f(-2.3022082f * x * (1.f + 0.044715f * x * x)); r[e] = x * __builtin_amdgcn_rcpf(1.f + ex) * v[e]; }
        v2u o; o.x = cvtpk(r[0], r[1]); o.y = cvtpk(r[2], r[3]);
        *(v2u*)(U + (size_t)row * DFF + c) = o;
    }
}
DI void ffn_phases(Frame& F, int l, int sub, size_t wg, size_t wv, size_t wd) {
    const bf16* W = WSB(WS_W);
    if (sub == 0) { pg8::EpiGV E{WSB(WS_U), DFF, F.a->in[36] + (size_t)l * 3 * DFF, F.a->in[37] + (size_t)l * DFF, WSF(WS_EG), WSF(WS_EV), (PG8_LAS float*)((PG8_LAS unsigned char*)F.lds + RING_BYTES)};
        run_gemm(F, WSB(WS_H), W + wg, MT, 2 * DFF, DM, E); }
    else if (sub == 1) glu_fixup(F, l);
    else { pg8::EpiRes E{F.out, F.out, DM, WSF(WS_M) + (size_t)l * 3 * 12288 + 5 * DM, F.a->in[5] + (size_t)l * 12288 + 5 * DM}; run_gemm(F, WSB(WS_U), W + wd, MT, DM, DFF, E); }
}
constexpr int NPHASE = 21;
__global__ void __launch_bounds__(512, 2) mega_fwd(Args args) {
    extern __shared__ __attribute__((aligned(16))) unsigned char lds_raw[];
    cg::grid_group grid = cg::this_grid();
    Frame F;
    F.lds = lds_raw; F.tid = threadIdx.x; F.lane = F.tid & 63; F.wave = __builtin_amdgcn_readfirstlane(F.tid >> 6);
    F.gw = blockIdx.x * 8 + F.wave; F.NGW = gridDim.x * 8;
    F.a = &args;
    F.out = args.out; F.ws = args.ws;
    const int lo = args.ph_lo, hi = args.ph_hi;
    volatile LAS unsigned* MISC = (volatile LAS unsigned*)((LAS unsigned char*)lds_raw + MISC_OFF);
    if (F.tid < 64) MISC[F.tid] = 0u;
    __syncthreads();
    XcdBarrier bar = xcd_barrier_post((unsigned*)(F.ws + WS_BAR), MISC + 8);
#ifndef DUP_PHASE
#define DUP_PHASE -1
#endif
#ifndef ONLY_PHASE
#define ONLY_PHASE -1
#endif
#define IN(k) ((ONLY_PHASE < 0 || ONLY_PHASE == (k)) && lo <= (k) && (k) < hi)
#define SEAM(k) do { if (IN(k) && IN((k) + 1)) { if ((k) == 0) grid.sync(); else xcd_barrier(bar); } } while (0)
    bf16* W = WSB(WS_W);
    if (IN(0)) {
        const TJob jobs[5] = {{F.a->in[8], DM, INA, W + W0_IN, 0}, {F.a->in[9], DM, DM, W + W0_OUT, 0}, {F.a->in[34], DM, DFF, W + W0_G, 1}, {F.a->in[35], DM, DFF, W + W0_G, 2}, {F.a->in[38], DFF, DM, W + W0_D, 0}};
        transpose_jobs<5>(F, jobs); p0_ada(F); p0_lam(F); p0_hyena_mlp(F);
#if DUP_PHASE == 99 || DUP_PHASE == 100
        transpose_jobs<5>(F, jobs); p0_hyena_mlp(F);
#endif
    }
    SEAM(0);
#if DUP_PHASE == 200
#pragma unroll 1
    for (int rep = 0; rep < 20; ++rep) grid.sync();
#endif
    if (IN(1)) norm_phase(F, F.a->in[0], 0, 0, true);
#if DUP_PHASE == 99 || DUP_PHASE == 101
    if (IN(1)) norm_phase(F, F.a->in[0], 0, 0, true);
#endif
    SEAM(1);
    if (IN(2)) { pg8::EpiBf16<0> E{WSB(WS_P), INA, nullptr, 0, 0, 1.f}; run_gemm(F, WSB(WS_H), W + W0_IN, MALL, INA, DM, E); }
#if DUP_PHASE == 2
    if (IN(2)) { pg8::EpiBf16<0> E{WSB(WS_P), INA, nullptr, 0, 0, 1.f}; run_gemm(F, WSB(WS_H), W + W0_IN, MALL, INA, DM, E); }
#endif
    SEAM(2);
#if DUP_PHASE == 3
    if (IN(3)) p3_rope(F, true);
#endif
    if (IN(3)) p3_rope(F, false);
    SEAM(3);
    if (IN(4)) p4_attention(F);
#if DUP_PHASE == 4
    if (IN(4)) { __syncthreads(); p4_attention(F); }
#endif
    SEAM(4);
    if (IN(5)) { pg8::EpiRes E{F.a->in[0], F.out, DM, WSF(WS_M) + 2 * DM, F.a->in[5] + 2 * DM}; run_gemm(F, WSB(WS_H), W + W0_OUT, MT, DM, DM, E); }
#if DUP_PHASE == 5
    if (IN(5)) { pg8::EpiRes E{F.a->in[0], F.out, DM, WSF(WS_M) + 2 * DM, F.a->in[5] + 2 * DM}; run_gemm(F, WSB(WS_H), W + W0_OUT, MT, DM, DM, E); }
#endif
    SEAM(5);
    if (IN(6)) norm_phase(F, F.out, 0, 1, false);
#if DUP_PHASE == 99 || DUP_PHASE == 101
    if (IN(6)) norm_phase(F, F.out, 0, 1, false);
#endif
    SEAM(6);
    if (IN(7)) ffn_phases(F, 0, 0, W0_G, W0_V, W0_D);
    SEAM(7);
    if (IN(8)) ffn_phases(F, 0, 1, W0_G, W0_V, W0_D);
    SEAM(8);
    if (IN(9)) ffn_phases(F, 0, 2, W0_G, W0_V, W0_D);
    SEAM(9);
    if (IN(10)) {
        const TJob jobs[5] = {{F.a->in[20], DM, HY3, W + W1_IN, 0}, {F.a->in[33], DM, DM, W + W1_OUT, 0}, {F.a->in[34] + (size_t)DM * DFF, DM, DFF, W + W1_G, 1}, {F.a->in[35] + (size_t)DM * DFF, DM, DFF, W + W1_G, 2}, {F.a->in[38] + (size_t)DFF * DM, DFF, DM, W + W1_D, 0}};
        transpose_jobs<5>(F, jobs); norm_phase(F, F.out, 1, 0, false);
#if DUP_PHASE == 99 || DUP_PHASE == 100
        transpose_jobs<5>(F, jobs);
#endif
#if DUP_PHASE == 99 || DUP_PHASE == 101
        norm_phase(F, F.out, 1, 0, false);
#endif
    }
    SEAM(10);
    if (IN(11)) { pg8::EpiBf16<0> E{WSB(WS_P), HY3, F.a->in[21], 0, 0, 1.f}; run_gemm(F, WSB(WS_H), W + W1_IN, MT, HY3, DM, E); }
#if DUP_PHASE == 11
    if (IN(11)) { pg8::EpiBf16<0> E{WSB(WS_P), HY3, F.a->in[21], 0, 0, 1.f}; run_gemm(F, WSB(WS_H), W + W1_IN, MT, HY3, DM, E); }
#endif
    SEAM(11);
    if (IN(12)) p12_shortconv(F);
#if DUP_PHASE == 12 || DUP_PHASE == 99
    if (IN(12)) p12_shortconv(F);
#endif
    SEAM(12);
    if (IN(13)) { pg8::EpiBf16<0> E{WSB(WS_FILT), SEQ, nullptr, 0, 0, 1.f}; run_gemm(F, WSB(WS_W3T), WSB(WS_A3), 8192, SEQ, 256, E); }
    SEAM(13);
#if DUP_PHASE == 14
    if (IN(14)) p14_longconv(F, true);
#endif
    if (IN(14)) p14_longconv(F, false);
    SEAM(14);
    if (IN(15)) p15_transpose_y(F);
#if DUP_PHASE == 99 || DUP_PHASE == 15
    if (IN(15)) p15_transpose_y(F);
#endif
    SEAM(15);
    if (IN(16)) { pg8::EpiRes E{F.out, F.out, DM, WSF(WS_M) + 3 * 12288 + 2 * DM, F.a->in[5] + 12288 + 2 * DM}; run_gemm(F, WSB(WS_H), W + W1_OUT, MT, DM, DM, E); }
    SEAM(16);
    if (IN(17)) norm_phase(F, F.out, 1, 1, false);
#if DUP_PHASE == 99 || DUP_PHASE == 101
    if (IN(17)) norm_phase(F, F.out, 1, 1, false);
#endif
    SEAM(17);
    if (IN(18)) ffn_phases(F, 1, 0, W1_G, W1_V, W1_D);
    SEAM(18);
    if (IN(19)) ffn_phases(F, 1, 1, W1_G, W1_V, W1_D);
    SEAM(19);
    if (IN(20)) ffn_phases(F, 1, 2, W1_G, W1_V, W1_D);
#undef IN
#undef SEAM
}
#ifndef MK_MULTI
#define MK_MULTI 0
#endif
extern "C" void kernel_launch(void* const* d_in, const int* in_sizes, int n_in, void* d_out, int out_size, void* d_ws, size_t ws_size, hipStream_t stream) {
    static int grid = 0;
    if (grid == 0) {
        if (n_in != 39 || in_sizes[0] != MT * DM || out_size != MT * DM || ws_size < WS_END) { fprintf(stderr, "kernel_launch: unexpected shapes (n_in %d in0 %d out %d ws %zu)\n", n_in, n_in > 0 ? in_sizes[0] : -1, out_size, ws_size); grid = -1; return; }
        int dev = 0, cus = 0, per_cu = 0;
        hipGetDevice(&dev); hipDeviceGetAttribute(&cus, hipDeviceAttributeMultiprocessorCount, dev);
        if (hipFuncSetAttribute((const void*)mega_fwd, hipFuncAttributeMaxDynamicSharedMemorySize, LDS_BYTES) != hipSuccess) { fprintf(stderr, "kernel_launch: hipFuncSetAttribute failed\n"); grid = -1; return; }
        if (hipOccupancyMaxActiveBlocksPerMultiprocessor(&per_cu, (const void*)mega_fwd, 512, LDS_BYTES) != hipSuccess || per_cu < 1) { fprintf(stderr, "kernel_launch: occupancy query says %d\n", per_cu); per_cu = 1; }
        (void)hipGetLastError();
        grid = cus * per_cu;
    }
    if (grid < 0) return;
    hipMemsetAsync((char*)d_ws + WS_M, 0, CTL_ZERO_BYTES, stream);
    Args a{};
    for (int i = 0; i < 39; ++i) a.in[i] = (const float*)d_in[i];
    a.out = (float*)d_out; a.ws = (unsigned char*)d_ws;
#if MK_MULTI
    for (int p = 0; p < NPHASE; ++p) { a.ph_lo = p; a.ph_hi = p + 1; hipLaunchKernelGGL(mega_fwd, dim3(grid), dim3(512), LDS_BYTES, stream, a); }
#else
    a.ph_lo = 0; a.ph_hi = NPHASE;
    void* kargs[] = {&a};
    hipError_t e = hipLaunchCooperativeKernel((const void*)mega_fwd, dim3(grid), dim3(512), kargs, LDS_BYTES, stream);
    if (e != hipSuccess) fprintf(stderr, "cooperative launch failed: %s (grid %d)\n", hipGetErrorString(e), grid);
#endif
}
```

```cpp
#include <hip/hip_runtime.h>
#include <cstdio>
#include <cstdint>
namespace pg8 {
#define PG8_LAS __attribute__((address_space(3)))
typedef unsigned short bf16_t;
typedef short bf16x8 __attribute__((ext_vector_type(8)));
typedef float f32x4 __attribute__((ext_vector_type(4)));
typedef unsigned u32x4 __attribute__((ext_vector_type(4)));
constexpr int BM = 256, BK = 64, HALF = 128, HTB = HALF * BK * 2  , STAGE_BYTES = 8 * HTB, NXCD = 8, WGM = 8;

__host__ __device__ __forceinline__ int lds_byte(int r, int c) { const int st = (r >> 4) * 2 + (c >> 5), rr = r & 15, cc = c & 31, ob = rr * 64 + cc * 2; return st * 1024 + (ob ^ (((ob >> 9) & 1) << 5)); }
__host__ __device__ __forceinline__ void stage_rc(int b, int& R, int& C) { const int st = b / 1024, sb = b % 1024, swz = sb ^ (((sb >> 9) & 1) << 5); R = (st >> 1) * 16 + swz / 64; C = (st & 1) * 32 + (swz % 64) / 2; }
__host__ __device__ __forceinline__ int perm32(int rho) { const int n = rho >> 4, i = rho & 15; return 8 * (i >> 2) + 4 * n + (i & 3); }

struct Unit { int pm, pn; };
struct Gemm { const bf16_t* A; const bf16_t* Bt; int M, N, K; };

struct StaticOrder {
    int nM, nN, nwg, G, c;
    __host__ __device__ void init(int M, int N, int G_, int c_) { nM = M / BM; nN = N / BM; nwg = nM * nN; G = G_; c = c_; }
    __host__ __device__ bool next(int i, Unit& u) const {
        const long L = (long)i * G + c; if (L >= nwg) return false;
        int wgid = (int)L; { const int q = nwg / NXCD, r = nwg % NXCD, xcd = wgid % NXCD, off = wgid / NXCD; wgid = (xcd < r ? xcd * (q + 1) : r * (q + 1) + (xcd - r) * q) + off; }
        const int nig = WGM * nN, gid = wgid / nig, fm = gid * WGM, gsz = (nM - fm) < WGM ? (nM - fm) : WGM;
        u.pm = fm + ((wgid % nig) % gsz); u.pn = (wgid % nig) / gsz; return true;
    }
    __device__ __forceinline__ void a_ready(const Unit&) const {}
    __device__ __forceinline__ void done(const Unit&) const {}
};

__device__ __forceinline__ unsigned cvt_pk_bf16(float lo, float hi) { unsigned r; asm volatile("v_cvt_pk_bf16_f32 %0, %1, %2" : "=v"(r) : "v"(lo), "v"(hi)); return r; }
typedef float f32x2 __attribute__((ext_vector_type(2)));
__device__ __forceinline__ f32x2 gelu_pk(f32x2 v) {
    const f32x2 av = __builtin_elementwise_abs(v), d = av * 0.2316418882f + 1.0f;
    f32x2 t; t.x = __builtin_amdgcn_rcpf(d.x); t.y = __builtin_amdgcn_rcpf(d.y);
    f32x2 q = t * 0.5307027145f + (-0.7265760135f); q = q * t + 0.7107068705f; q = q * t + (-0.142248368f); q = q * t + 0.127414796f; q = q * t;
    const f32x2 s = (v * v) * (-0.72134752044f);
    f32x2 e; e.x = __builtin_amdgcn_exp2f(s.x); e.y = __builtin_amdgcn_exp2f(s.y);
    const f32x2 m = v * (q * e), r = v - m;
    f32x2 o; o.x = v.x < 0.f ? m.x : r.x; o.y = v.y < 0.f ? m.y : r.y; return o;
}

template <int ACT  > struct EpiBf16 {
    static constexpr bool PERM = true, AFTER_DRAIN = false; static_assert(ACT == 0 || ACT == 1, "EpiBf16: ACT is 0 (none) or 1 (gelu_pk)");
    bf16_t* O; int ldc; const float* bias; int split_cols; size_t split_stride; float scale0;
    __device__ __forceinline__ void operator()(const f32x4 (&acc)[2][2][4][2], const Unit& u, int wr, int wc, int fr, int fq) const {
        const int row0 = u.pm * BM + wr * 64 + fr; int colt = u.pn * BM; bf16_t* base = O;
        float sc = 1.f; if (split_cols) { const int t = colt / split_cols; base += (size_t)t * split_stride; colt -= t * split_cols; if (t == 0) sc = scale0; }
        const int col0 = colt + wc * 32 + 8 * fq, bcol0 = u.pn * BM + wc * 32 + 8 * fq;
        f32x4 bv[2][2];
#pragma unroll
        for (int bj = 0; bj < 2; ++bj)
#pragma unroll
            for (int n = 0; n < 2; ++n) bv[bj][n] = bias ? *(const f32x4*)(bias + bcol0 + bj * HALF + 4 * n) : (f32x4){0.f, 0.f, 0.f, 0.f};
#pragma unroll
        for (int ai = 0; ai < 2; ++ai)
#pragma unroll
            for (int m = 0; m < 4; ++m) { bf16_t* rowp = base + (size_t)(row0 + ai * HALF + m * 16) * ldc + col0;
#pragma unroll
                for (int bj = 0; bj < 2; ++bj) { f32x4 v0 = acc[ai][bj][m][0] + bv[bj][0], v1 = acc[ai][bj][m][1] + bv[bj][1];
                    if (ACT == 1) { f32x2 a = gelu_pk((f32x2){v0[0], v0[1]}), b = gelu_pk((f32x2){v0[2], v0[3]}), c = gelu_pk((f32x2){v1[0], v1[1]}), d = gelu_pk((f32x2){v1[2], v1[3]});
                        v0 = (f32x4){a.x, a.y, b.x, b.y}; v1 = (f32x4){c.x, c.y, d.x, d.y}; }
                    v0 = v0 * sc; v1 = v1 * sc; u32x4 w; w.x = cvt_pk_bf16(v0[0], v0[1]); w.y = cvt_pk_bf16(v0[2], v0[3]); w.z = cvt_pk_bf16(v1[0], v1[1]); w.w = cvt_pk_bf16(v1[2], v1[3]);
                    *(u32x4*)(rowp + bj * HALF) = w; } }
    }
};
struct EpiRes {
    static constexpr bool PERM = false, AFTER_DRAIN = false;
    const float* base; float* out; int ldc; const float* gm; const float* gb;
    __device__ __forceinline__ void operator()(const f32x4 (&acc)[2][2][4][2], const Unit& u, int wr, int wc, int fr, int fq) const {
        const int col0 = u.pn * BM + wc * 32 + 4 * fq; const int b = u.pm >> 6;
        const float* gmb = gm + (size_t)b * 12288;
        const size_t rowoff = (size_t)(u.pm * BM + wr * 64 + fr) * ldc;
#pragma unroll
        for (int bj = 0; bj < 2; ++bj)
#pragma unroll
          for (int ai = 0; ai < 2; ++ai) {
            f32x4 gt[2], bs[4][2];
#pragma unroll
            for (int n = 0; n < 2; ++n) { const int c = col0 + bj * HALF + n * 16; gt[n] = *(const f32x4*)(gmb + c) + *(const f32x4*)(gb + c); }
#pragma unroll
                for (int m = 0; m < 4; ++m)
#pragma unroll
                    for (int n = 0; n < 2; ++n) bs[m][n] = __builtin_nontemporal_load((const f32x4*)(base + rowoff + (size_t)(ai * HALF + m * 16) * ldc + col0 + bj * HALF + n * 16));
#pragma unroll
                for (int m = 0; m < 4; ++m)
#pragma unroll
                    for (int n = 0; n < 2; ++n) __builtin_nontemporal_store(bs[m][n] + gt[n] * acc[ai][bj][m][n], (f32x4*)(out + rowoff + (size_t)(ai * HALF + m * 16) * ldc + col0 + bj * HALF + n * 16));
            asm volatile("" ::: "memory"); }
    }
};
struct EpiGlu {
    static constexpr bool PERM = true, AFTER_DRAIN = false;
    const bf16_t* G; bf16_t* U; int ldc; const float* cw; const float* cb;
    __device__ __forceinline__ void operator()(const f32x4 (&acc)[2][2][4][2], const Unit& u, int wr, int wc, int fr, int fq) const {
        typedef unsigned u32x2 __attribute__((ext_vector_type(2)));
        const int row0 = u.pm * BM + wr * 64 + fr;
#pragma unroll
        for (int bj = 0; bj < 2; ++bj)
#pragma unroll
            for (int n = 0; n < 2; ++n) { const int c0 = u.pn * BM + bj * HALF + wc * 32 + 8 * fq + 4 * n;
                const f32x4 w0 = *(const f32x4*)(cw + c0), w1 = *(const f32x4*)(cw + ldc + c0), w2 = *(const f32x4*)(cw + 2 * ldc + c0), bb = *(const f32x4*)(cb + c0);
                u32x2 g0[8], gm[8], gn[8];
#pragma unroll
                for (int it = 0; it < 8; ++it) { const int row = row0 + (it >> 2) * HALF + (it & 3) * 16; const int t = row & 16383;
                    const bf16_t* gp = G + (size_t)row * ldc + c0;
                    g0[it] = *(const u32x2*)gp; gm[it] = *(const u32x2*)(t > 0 ? gp - ldc : gp); gn[it] = *(const u32x2*)(t < 16383 ? gp + ldc : gp); }
#pragma unroll
                for (int it = 0; it < 8; ++it) { const int ai = it >> 2, m = it & 3; const int row = row0 + ai * HALF + m * 16; const int t = row & 16383;
                    const float fm = t > 0 ? 1.f : 0.f, fn = t < 16383 ? 1.f : 0.f;
                    u32x2 o;
#pragma unroll
                    for (int e = 0; e < 2; ++e) {
                        float r2[2];
#pragma unroll
                        for (int hh = 0; hh < 2; ++hh) {
                            const float a0 = hh ? __uint_as_float(g0[it][e] & 0xffff0000u) : __uint_as_float(g0[it][e] << 16);
                            const float am = (hh ? __uint_as_float(gm[it][e] & 0xffff0000u) : __uint_as_float(gm[it][e] << 16)) * fm;
                            const float an = (hh ? __uint_as_float(gn[it][e] & 0xffff0000u) : __uint_as_float(gn[it][e] << 16)) * fn;
                            const float g = w0[2 * e + hh] * am + w1[2 * e + hh] * a0 + w2[2 * e + hh] * an + bb[2 * e + hh];
                            const float ex = __builtin_amdgcn_exp2f(-2.3022082f * g * (1.f + 0.044715f * g * g));
                            r2[hh] = g * __builtin_amdgcn_rcpf(1.f + ex) * acc[ai][bj][m][n][2 * e + hh];
                        }
                        o[e] = cvt_pk_bf16(r2[0], r2[1]);
                    }
                    *(u32x2*)(U + (size_t)row * ldc + c0) = o; }
                asm volatile("" ::: "memory");
            }
    }
};
struct EpiGV {
    static constexpr bool PERM = true, AFTER_DRAIN = false;
    bf16_t* U; int ldu; const float* cw; const float* cb; float* EG; float* EV; PG8_LAS float* XL;
    __device__ __forceinline__ static f32x4 shfl4(const f32x4 v, int src) { f32x4 r; r[0] = __shfl(v[0], src); r[1] = __shfl(v[1], src); r[2] = __shfl(v[2], src); r[3] = __shfl(v[3], src); return r; }
    __device__ __forceinline__ void operator()(const f32x4 (&acc)[2][2][4][2], const Unit& u, int wr, int wc, int fr, int fq) const {
        const int lane = (int)(threadIdx.x & 63u);
        const int cl = wc * 32 + 8 * fq;
#pragma unroll
        for (int ai = 0; ai < 2; ++ai) { const int blk = 2 * ai + wr;
            if (fr == 0) {
#pragma unroll
                for (int n = 0; n < 2; ++n) *(PG8_LAS f32x4*)(XL + (blk * 2 + 0) * 128 + cl + 4 * n) = acc[ai][0][0][n]; }
            if (fr == 15) {
#pragma unroll
                for (int n = 0; n < 2; ++n) *(PG8_LAS f32x4*)(XL + (blk * 2 + 1) * 128 + cl + 4 * n) = acc[ai][0][3][n]; } }
        asm volatile("s_waitcnt lgkmcnt(0)" ::: "memory"); __builtin_amdgcn_s_barrier(); asm volatile("" ::: "memory");
        const int c0 = u.pn * HALF + cl;
        f32x4 w0[2], w1[2], w2[2], bb[2];
#pragma unroll
        for (int n = 0; n < 2; ++n) { w0[n] = *(const f32x4*)(cw + c0 + 4 * n); w1[n] = *(const f32x4*)(cw + ldu + c0 + 4 * n); w2[n] = *(const f32x4*)(cw + 2 * ldu + c0 + 4 * n); bb[n] = *(const f32x4*)(cb + c0 + 4 * n); }
#pragma unroll
        for (int ai = 0; ai < 2; ++ai) { const int blk = 2 * ai + wr;
#pragma unroll
            for (int m = 0; m < 4; ++m) { const int rt = ai * HALF + wr * 64 + m * 16 + fr;
                u32x4 o;
#pragma unroll
                for (int n = 0; n < 2; ++n) {
                    const f32x4 g = acc[ai][0][m][n], v = acc[ai][1][m][n];
                    f32x4 a = shfl4(g, lane - 1), b;
                    if (m > 0) b = shfl4(acc[ai][0][m - 1][n], lane + 15);
                    else b = blk > 0 ? *(const PG8_LAS f32x4*)(XL + ((blk - 1) * 2 + 1) * 128 + cl + 4 * n) : (f32x4){0.f, 0.f, 0.f, 0.f};
                    const f32x4 up = fr == 0 ? b : a;
                    f32x4 a2 = shfl4(g, lane + 1), b2;
                    if (m < 3) b2 = shfl4(acc[ai][0][m + 1][n], lane - 15);
                    else b2 = blk < 3 ? *(const PG8_LAS f32x4*)(XL + ((blk + 1) * 2 + 0) * 128 + cl + 4 * n) : (f32x4){0.f, 0.f, 0.f, 0.f};
                    const f32x4 dn = fr == 15 ? b2 : a2;
                    const f32x4 gc = w0[n] * up + w1[n] * g + w2[n] * dn + bb[n];
                    float r[4];
#pragma unroll
                    for (int e = 0; e < 4; ++e) { const float x = gc[e]; const float ex = __builtin_amdgcn_exp2f(-2.3022082f * x * (1.f + 0.044715f * x * x)); r[e] = x * __builtin_amdgcn_rcpf(1.f + ex) * v[e]; }
                    o[2 * n] = cvt_pk_bf16(r[0], r[1]); o[2 * n + 1] = cvt_pk_bf16(r[2], r[3]);
                    if (rt <= 1 || rt >= 254) {
                        const int slot = rt <= 1 ? rt : rt - 252;
                        *(f32x4*)(EG + ((size_t)u.pm * 4 + slot) * ldu + c0 + 4 * n) = g;
                        if (rt == 0 || rt == 255) *(f32x4*)(EV + ((size_t)u.pm * 2 + (rt == 255)) * ldu + c0 + 4 * n) = v;
                    }
                }
                *(u32x4*)(U + (size_t)(u.pm * BM + rt) * ldu + c0) = o;
                if (m & 1) asm volatile("" ::: "memory"); }
        }
    }
};
template <class Epi, class Sched, bool ALIGN_EPI = false, bool SP2 = false>
__device__ __forceinline__ void gemm_phase(PG8_LAS unsigned char* lds, const Gemm g, const Sched& S, const Epi& E) {
    const int tid = threadIdx.x, wid = __builtin_amdgcn_readfirstlane(tid >> 6), lane = tid & 63, wr = wid >> 2, wc = wid & 3, fr = lane & 15, fq = lane >> 4;
    const int K = g.K, nt = K / BK;
    unsigned voffA[2], voffB[2];
#pragma unroll
    for (int i = 0; i < 2; ++i) { int R, C; stage_rc(tid * 16 + i * 8192, R, C); const int Rb = Epi::PERM ? ((R & ~31) + perm32(R & 31)) : R;
        voffA[i] = (unsigned)(R * K + C) * 2u; voffB[i] = (unsigned)(Rb * K + C) * 2u; }
    const size_t kstep = (size_t)(BK * 2);
    const size_t hstep = (size_t)HALF * K * 2;
    const size_t tstep = 2 * hstep;
    const unsigned ldsw = (unsigned)wid * 1024u;
    const int aoff = lds_byte(wr * 64 + fr, fq * 8), boff = lds_byte(wc * 32 + fr, fq * 8);
#define PG8_SA(b, h) (((b) * 2 + (h)) * HTB)
#define PG8_SB(b, h) ((4 + (b) * 2 + (h)) * HTB)
#define PG8_STAGE(bufoff, gbase, voff) do { _Pragma("unroll") for (int _i = 0; _i < 2; ++_i) \
        __builtin_amdgcn_global_load_lds((const unsigned*)((const char*)(gbase) + (voff)[_i]), (PG8_LAS unsigned*)(lds + (bufoff) + ldsw + _i * 8192), 16, 0, 0); } while (0)
#define PG8_LDA(dst, b, h) do { _Pragma("unroll") for (int m = 0; m < 4; ++m) _Pragma("unroll") for (int k = 0; k < 2; ++k) dst[m][k] = *(const PG8_LAS bf16x8*)(lds + PG8_SA(b, h) + aoff + m * 2048 + k * 1024); } while (0)
#define PG8_LDB(dst, b, h) do { _Pragma("unroll") for (int n = 0; n < 2; ++n) _Pragma("unroll") for (int k = 0; k < 2; ++k) dst[n][k] = *(const PG8_LAS bf16x8*)(lds + PG8_SB(b, h) + boff + n * 2048 + k * 1024); } while (0)
#define PG8_MMA(ai, bj, At, Bt) do { __builtin_amdgcn_s_setprio(1); _Pragma("unroll") for (int m = 0; m < 4; ++m) _Pragma("unroll") for (int n = 0; n < 2; ++n) _Pragma("unroll") for (int k = 0; k < 2; ++k) \
        acc[ai][bj][m][n] = __builtin_amdgcn_mfma_f32_16x16x32_bf16(Bt[n][k], At[m][k], acc[ai][bj][m][n], 0, 0, 0); __builtin_amdgcn_s_setprio(0); } while (0)
#define PG8_WAIT_V(n) asm volatile("s_waitcnt vmcnt(" #n ")" ::: "memory")
#define PG8_WAIT_L(n) asm volatile("s_waitcnt lgkmcnt(" #n ")" ::: "memory")
#define PG8_BAR __builtin_amdgcn_s_barrier()
#define PG8_SCHED __builtin_amdgcn_sched_barrier(0)
    Unit cur, nxt; int ui = 0;
    if (!S.next(0, cur)) return;
    f32x4 acc[2][2][4][2];
#pragma unroll
    for (int a = 0; a < 2; ++a)
#pragma unroll
        for (int b = 0; b < 2; ++b)
#pragma unroll
            for (int m = 0; m < 4; ++m)
#pragma unroll
                for (int n = 0; n < 2; ++n) acc[a][b][m][n] = (f32x4){0.f, 0.f, 0.f, 0.f};
    bf16x8 At[4][2], B0[2][2], B1[2][2];
    const char* cA = (const char*)g.A + (size_t)cur.pm * tstep; const char* cB = (const char*)g.Bt + (size_t)cur.pn * tstep;
    S.a_ready(cur);
    if constexpr (SP2) {
        PG8_STAGE(PG8_SB(0, 0), cB, voffB); PG8_STAGE(PG8_SB(0, 1), cB + hstep, voffB); PG8_STAGE(PG8_SA(0, 0), cA, voffA); PG8_STAGE(PG8_SA(0, 1), cA + hstep, voffA);
        if (wr == 1) PG8_BAR;
        PG8_WAIT_V(2); PG8_BAR;
        PG8_STAGE(PG8_SB(1, 0), cB + kstep, voffB); PG8_STAGE(PG8_SA(1, 0), cA + kstep, voffA); PG8_STAGE(PG8_SB(1, 1), cB + hstep + kstep, voffB);
        PG8_WAIT_V(6); PG8_BAR;
    } else {
        PG8_STAGE(PG8_SB(0, 0), cB, voffB); PG8_STAGE(PG8_SA(0, 0), cA, voffA); PG8_STAGE(PG8_SB(0, 1), cB + hstep, voffB); PG8_STAGE(PG8_SA(0, 1), cA + hstep, voffA);
        if (wr == 1) PG8_BAR;
        PG8_WAIT_V(4); PG8_BAR;
        PG8_STAGE(PG8_SB(1, 0), cB + kstep, voffB); PG8_STAGE(PG8_SA(1, 0), cA + kstep, voffA); PG8_STAGE(PG8_SB(1, 1), cB + hstep + kstep, voffB);
        PG8_WAIT_V(6); PG8_BAR;
    }
    for (;;) {
        const bool has_next = S.next(ui + 1, nxt);
        const char* nA = has_next ? (const char*)g.A + (size_t)nxt.pm * tstep : cA; const char* nB = has_next ? (const char*)g.Bt + (size_t)nxt.pn * tstep : cB;
        for (int t = 0; t < nt; t += 2) {
            const bool last = (t == nt - 2);
            const char* a1 = cA + (size_t)(t + 1) * kstep;
            const char* a2 = last ? nA : cA + (size_t)(t + 2) * kstep; const char* b2 = last ? nB : cB + (size_t)(t + 2) * kstep;
            const char* a3 = a2 + kstep; const char* b3 = b2 + kstep;
            if (last && has_next) S.a_ready(nxt);
            if constexpr (SP2) {
            PG8_LDB(B0, 0, 0); PG8_LDB(B1, 0, 1); PG8_SCHED; PG8_LDA(At, 0, 0); PG8_STAGE(PG8_SA(1, 1), a1 + hstep, voffA);
            PG8_WAIT_V(8); PG8_WAIT_L(0); PG8_BAR; PG8_MMA(0, 0, At, B0); PG8_MMA(0, 1, At, B1); PG8_BAR; PG8_SCHED;
            PG8_LDA(At, 0, 1); PG8_STAGE(PG8_SB(0, 0), b2, voffB); PG8_STAGE(PG8_SB(0, 1), b2 + hstep, voffB); PG8_STAGE(PG8_SA(0, 0), a2, voffA);
            PG8_WAIT_V(8); PG8_WAIT_L(0); PG8_BAR; PG8_MMA(1, 0, At, B0); PG8_MMA(1, 1, At, B1); PG8_BAR; PG8_SCHED;
            PG8_LDB(B0, 1, 0); PG8_LDB(B1, 1, 1); PG8_SCHED; PG8_LDA(At, 1, 0); PG8_STAGE(PG8_SA(0, 1), a2 + hstep, voffA);
            PG8_WAIT_V(8); PG8_WAIT_L(0); PG8_BAR; PG8_MMA(0, 0, At, B0); PG8_MMA(0, 1, At, B1); PG8_BAR; PG8_SCHED;
            PG8_LDA(At, 1, 1); PG8_STAGE(PG8_SB(1, 0), b3, voffB); PG8_STAGE(PG8_SB(1, 1), b3 + hstep, voffB); PG8_STAGE(PG8_SA(1, 0), a3, voffA);
            PG8_WAIT_V(8); PG8_WAIT_L(0); PG8_BAR; PG8_MMA(1, 0, At, B0); PG8_MMA(1, 1, At, B1); PG8_BAR; PG8_SCHED;
            } else {
            PG8_LDB(B0, 0, 0); PG8_SCHED; PG8_LDA(At, 0, 0); PG8_STAGE(PG8_SA(1, 1), a1 + hstep, voffA);
            PG8_WAIT_L(8); PG8_BAR; PG8_WAIT_L(0); PG8_MMA(0, 0, At, B0); PG8_BAR; PG8_SCHED;
            PG8_LDB(B1, 0, 1); PG8_STAGE(PG8_SB(0, 0), b2, voffB);
            PG8_BAR; PG8_WAIT_L(0); PG8_MMA(0, 1, At, B1); PG8_BAR;
            PG8_LDA(At, 0, 1); PG8_STAGE(PG8_SA(0, 0), a2, voffA);
            PG8_BAR; PG8_WAIT_L(0); PG8_MMA(1, 0, At, B0); PG8_BAR; PG8_SCHED;
            PG8_STAGE(PG8_SB(0, 1), b2 + hstep, voffB);
            PG8_WAIT_V(6); PG8_BAR; PG8_MMA(1, 1, At, B1); PG8_BAR;
            PG8_LDB(B0, 1, 0); PG8_SCHED; PG8_LDA(At, 1, 0); PG8_STAGE(PG8_SA(0, 1), a2 + hstep, voffA);
            PG8_WAIT_L(8); PG8_BAR; PG8_WAIT_L(0); PG8_MMA(0, 0, At, B0); PG8_BAR; PG8_SCHED;
            PG8_LDB(B1, 1, 1); PG8_STAGE(PG8_SB(1, 0), b3, voffB);
            PG8_BAR; PG8_WAIT_L(0); PG8_MMA(0, 1, At, B1); PG8_BAR;
            PG8_LDA(At, 1, 1); PG8_STAGE(PG8_SA(1, 0), a3, voffA);
            PG8_BAR; PG8_WAIT_L(0); PG8_MMA(1, 0, At, B0); PG8_BAR; PG8_SCHED;
            PG8_STAGE(PG8_SB(1, 1), b3 + hstep, voffB);
            PG8_WAIT_V(6); PG8_BAR; PG8_MMA(1, 1, At, B1); PG8_BAR;
            }
        }
        if constexpr (ALIGN_EPI) { if (wr == 0) PG8_BAR; }
        if constexpr (!Epi::AFTER_DRAIN) { E(acc, cur, wr, wc, fr, fq); S.done(cur); }
        if (!has_next) break;
#pragma unroll
        for (int a = 0; a < 2; ++a)
#pragma unroll
            for (int b = 0; b < 2; ++b)
#pragma unroll
                for (int m = 0; m < 4; ++m)
#pragma unroll
                    for (int n = 0; n < 2; ++n) acc[a][b][m][n] = (f32x4){0.f, 0.f, 0.f, 0.f};
        cur = nxt; cA = nA; cB = nB; ++ui;
        if constexpr (ALIGN_EPI) { if (wr == 1) PG8_BAR; }
    }
    PG8_WAIT_V(0);
    if constexpr (!ALIGN_EPI) { if (wr == 0) PG8_BAR; }
    PG8_BAR;
    if constexpr (Epi::AFTER_DRAIN) { E.fused(acc, cur, wr, wc, fr, fq, lds, wid, lane); S.done(cur); }
#undef PG8_SA
#undef PG8_SB
#undef PG8_STAGE
#undef PG8_LDA
#undef PG8_LDB
#undef PG8_MMA
#undef PG8_WAIT_V
#undef PG8_WAIT_L
#undef PG8_BAR
#undef PG8_SCHED
}
}
#include <hip/hip_cooperative_groups.h>
namespace cg = cooperative_groups;

constexpr int DM = 2048, NBATCH = 2, SEQ = 16384, CTXL = 256, MT = NBATCH * SEQ, MC = NBATCH * CTXL, MALL = MT + MC;
constexpr int INA = 4608, DFF = 5632, HY3 = 6144, NKEY = CTXL + SEQ  , NVH = 10;
constexpr float EPSN = 1e-6f, LOG2E = 1.4426950408889634f;
constexpr size_t MiB = 1u << 20;
constexpr size_t WS_M = 0;
constexpr size_t CTL_ZERO_BYTES = 512 * 1024;
constexpr size_t WS_LAM = 1 * MiB;
constexpr size_t WS_A3 = 2 * MiB;
constexpr size_t WS_W3T = 1008 * MiB;
constexpr size_t WS_W = 12 * MiB;
constexpr size_t WS_H = 110 * MiB;
constexpr size_t WS_P = 240 * MiB;
constexpr size_t WS_VT = 533 * MiB;
constexpr size_t WS_U = 592 * MiB;
constexpr size_t WS_T = 624 * MiB;
constexpr size_t WS_FILT = 238 * MiB + 2 * MiB;
constexpr size_t WS_SPEC = 500 * MiB;
constexpr size_t SPEC_SLOT = 135168;
constexpr size_t WS_END = 1024 * MiB;
static_assert(WS_FILT == WS_P, "filters overlay Z");
static_assert(WS_W + 98 * MiB <= WS_H && WS_H + (size_t)MALL * DM * 2 <= WS_P && WS_P + (size_t)MALL * INA * 2 <= WS_VT, "ws map 1");
static_assert(WS_VT + (size_t)NBATCH * NVH * 128 * NKEY * 2 <= WS_U + 30 * MiB, "ws map 2");
static_assert(WS_P + (size_t)MT * DFF * 2 <= WS_U && WS_U + (size_t)MT * DFF * 2 <= WS_END, "ws map 3");
static_assert(WS_P + (size_t)MT * HY3 * 2 <= WS_T && WS_T + (size_t)3 * MT * DM * 2 <= WS_END, "ws map 4");
static_assert(WS_FILT + (size_t)4 * DM * SEQ * 2 <= WS_SPEC && WS_SPEC + 256 * SPEC_SLOT <= WS_T, "ws map 5");
constexpr size_t W0_IN = 0, W0_OUT = W0_IN + (size_t)INA * DM, W0_G = W0_OUT + (size_t)DM * DM, W0_V = W0_G + (size_t)DFF * DM, W0_D = W0_V + (size_t)DFF * DM;
constexpr size_t W1_IN = 0, W1_OUT = W1_IN + (size_t)HY3 * DM, W1_G = W1_OUT + (size_t)DM * DM, W1_V = W1_G + (size_t)DFF * DM, W1_D = W1_V + (size_t)DFF * DM;
static_assert((W1_D + (size_t)DFF * DM) * 2 <= 98 * MiB, "weights region");

constexpr int RING_BYTES = 131072, MISC_OFF = 147456, LDS_BYTES = 147456 + 256;
constexpr size_t WS_BAR = 384 * 1024;
#define LAS __attribute__((address_space(3)))
typedef unsigned short bf16;
typedef unsigned v4u __attribute__((ext_vector_type(4)));
typedef unsigned v2u __attribute__((ext_vector_type(2)));
typedef float f32x4 __attribute__((ext_vector_type(4)));
typedef float f32x16 __attribute__((ext_vector_type(16)));
typedef short bf16x8 __attribute__((ext_vector_type(8)));
typedef float f32x2_t __attribute__((ext_vector_type(2))); typedef __bf16 bf16x2_t __attribute__((ext_vector_type(2)));
#define DI __device__ __forceinline__
DI unsigned cvtpk(float lo, float hi) { f32x2_t v = {lo, hi}; bf16x2_t b = __builtin_convertvector(v, bf16x2_t); return __builtin_bit_cast(unsigned, b); }
DI float bflo(unsigned w) { return __uint_as_float(w << 16); }
DI float bfhi(unsigned w) { return __uint_as_float(w & 0xffff0000u); }
DI float bf1(unsigned short v) { return __uint_as_float((unsigned)v << 16); }
DI float wave_sum(float v) {
#pragma unroll
    for (int o = 1; o < 64; o <<= 1) v += __shfl_xor(v, o);
    return v;
}
DI float fsin_rev(float r) { return __builtin_amdgcn_sinf(r); }
DI float fcos_rev(float r) { return __builtin_amdgcn_cosf(r); }
DI float fsin_rad(float x) { return __builtin_amdgcn_sinf(x * 0.15915494309189535f); }

struct Args { const float* in[39]; float* out; unsigned char* ws; int ph_lo, ph_hi; };
struct Frame {
    unsigned char* lds; int tid, lane, wave, gw, NGW;
    const Args* a; float* out; unsigned char* ws;
};
#define WSF(off) ((float*)(F.ws + (off)))
#define WSB(off) ((bf16*)(F.ws + (off)))

DI void transpose_item(const float* W, int K, int N, bf16* WT, float* scr, int item, int lane, int mode) {
    const int nblk = N / 32, kb = item / nblk, nb = item % nblk, k0 = 64 * kb, n0 = 32 * nb;
    const int d0 = mode == 0 ? n0 : (n0 >> 7) * 256 + (mode == 2 ? 128 : 0) + (n0 & 127);
#pragma unroll 8
    for (int i = 0; i < 32; ++i) { const int kk = 2 * i + (lane >> 5); scr[kk * 33 + (lane & 31)] = W[(size_t)(k0 + kk) * N + n0 + (lane & 31)]; }
    __builtin_amdgcn_fence(__ATOMIC_RELEASE, "wavefront"); asm volatile("s_waitcnt lgkmcnt(0)" ::: "memory");
    const int c = lane & 7;
#pragma unroll
    for (int j = 0; j < 4; ++j) { const int n = (lane >> 3) + 8 * j; const float* s = scr + (8 * c) * 33 + n;
        v4u o; o.x = cvtpk(s[0 * 33], s[1 * 33]); o.y = cvtpk(s[2 * 33], s[3 * 33]); o.z = cvtpk(s[4 * 33], s[5 * 33]); o.w = cvtpk(s[6 * 33], s[7 * 33]);
        *(v4u*)(WT + (size_t)(d0 + n) * K + k0 + 8 * c) = o; }
    asm volatile("s_waitcnt lgkmcnt(0)" ::: "memory");
}
struct TJob { const float* W; int K, N; bf16* WT; int mode; };
template <int NJ> DI void transpose_jobs(Frame& F, const TJob (&jobs)[NJ]) {
    float* scr = (float*)(F.lds + F.wave * 16384);
    int tot = 0;
#pragma unroll
    for (int j = 0; j < NJ; ++j) tot += (jobs[j].K / 64) * (jobs[j].N / 32);
    for (int it = F.gw; it < tot; it += F.NGW) {
        int r = it;
#pragma unroll
        for (int j = 0; j < NJ; ++j) { const int n = (jobs[j].K / 64) * (jobs[j].N / 32);
            if (r >= 0 && r < n) transpose_item(jobs[j].W, jobs[j].K, jobs[j].N, jobs[j].WT, scr, r, F.lane, jobs[j].mode);
            r -= n; }
    }
}
DI float silu(float x) { return x / (1.f + __expf(-x)); }

DI void p0_ada(Frame& F) {
    const float* ada_w = F.a->in[4]; const float* c = F.a->in[1]; const float* cctx = F.a->in[3]; float* M = WSF(WS_M);
    for (int it = F.gw; it < 1536; it += F.NGW) {
        const int l = it / 768, rem = it % 768, kc = rem / 48, ng = rem % 48;
        const float* W = ada_w + (size_t)l * DM * 12288 + (size_t)(kc * 128) * 12288 + ng * 256 + F.lane * 4;
        f32x4 a0 = {0, 0, 0, 0}, a1 = a0, a2 = a0;
#pragma unroll 8
        for (int k = 0; k < 128; ++k) { const f32x4 w = *(const f32x4*)(W + (size_t)k * 12288); const int kk = kc * 128 + k;
            const float s0 = silu(c[kk]), s1 = silu(c[DM + kk]), s2 = silu(cctx[kk]);
            a0 += w * s0; a1 += w * s1; a2 += w * s2; }
        float* m0 = M + (size_t)(l * 3) * 12288 + ng * 256 + F.lane * 4;
#pragma unroll
        for (int e = 0; e < 4; ++e) { unsafeAtomicAdd(m0 + e, a0[e]); unsafeAtomicAdd(m0 + 12288 + e, a1[e]); unsafeAtomicAdd(m0 + 2 * 12288 + e, a2[e]); }
    }
}
DI void p0_hyena_mlp(Frame& F) {
    const float *w0 = F.a->in[24], *b0 = F.a->in[25], *w1 = F.a->in[26], *b1 = F.a->in[27], *w2 = F.a->in[28], *b2 = F.a->in[29], *fq = F.a->in[30];
    bf16* a3 = WSB(WS_A3); const int lane = F.lane; const float freq = fq[lane];
    for (int pg = F.gw; pg < 2048; pg += F.NGW) {
        float a[8], acc[8];
#pragma unroll
        for (int q = 0; q < 8; ++q) { const float pos = (float)(pg * 8 + q); float z = 0.f;
            if (lane == 0) z = pos / 16383.f;
            else if (lane <= 32) { const int i = (lane - 1) & 15; const float f = 1e-4f + (float)i * ((15.f - 1e-4f) / 15.f); const float rev = f * pos * (1.f / 16384.f);
                z = lane <= 16 ? fcos_rev(rev) : -fsin_rev(rev); }
            a[q] = z; acc[q] = b0[lane]; }
        for (int i = 0; i < 33; ++i) { const float w = w0[i * 64 + lane];
#pragma unroll
            for (int q = 0; q < 8; ++q) acc[q] += __shfl(a[q], i) * w; }
#pragma unroll
        for (int q = 0; q < 8; ++q) { a[q] = fsin_rad(freq * acc[q]); acc[q] = b1[lane]; }
        for (int i = 0; i < 64; ++i) { const float w = w1[i * 64 + lane];
#pragma unroll
            for (int q = 0; q < 8; ++q) acc[q] += __shfl(a[q], i) * w; }
#pragma unroll
        for (int q = 0; q < 8; ++q) { a[q] = fsin_rad(freq * acc[q]); acc[q] = b2[lane]; }
        for (int i = 0; i < 64; ++i) { const float w = w2[i * 64 + lane];
#pragma unroll
            for (int q = 0; q < 8; ++q) acc[q] += __shfl(a[q], i) * w; }
#pragma unroll
        for (int q = 0; q < 8; ++q) { const float v = fsin_rad(freq * acc[q]); const unsigned hi = cvtpk(v, 0.f) & 0xffffu; const unsigned lo = cvtpk(v - __uint_as_float(hi << 16), 0.f) & 0xffffu;
            bf16* o = a3 + (size_t)(pg * 8 + q) * 256 + lane; o[0] = (bf16)hi; o[64] = (bf16)lo; o[128] = (bf16)hi; o[192] = 0; }
    }
    { const float* w3 = F.a->in[31]; bf16* w3t = WSB(WS_W3T);
      for (int idx = blockIdx.x * 512 + F.tid; idx < 64 * 8192; idx += gridDim.x * 512) { const int j = idx >> 13, n = idx & 8191; const float v = w3[idx];
          const unsigned hi = cvtpk(v, 0.f) & 0xffffu; const unsigned lo = cvtpk(v - __uint_as_float(hi << 16), 0.f) & 0xffffu;
          bf16* o = w3t + (size_t)n * 256 + j; o[0] = (bf16)hi; o[64] = (bf16)hi; o[128] = (bf16)lo; o[192] = 0; } }
}
DI void p0_lam(Frame& F) {
    if (blockIdx.x == 0 && F.wave == 0) {
        const float s1 = wave_sum(F.a->in[12][F.lane] * F.a->in[13][F.lane]), s2 = wave_sum(F.a->in[14][F.lane] * F.a->in[15][F.lane]);
        if (F.lane == 0) WSF(WS_LAM)[0] = __expf(s1) - __expf(s2) + 0.2f;
    }
}
DI void norm_rows(Frame& F, const float* src, int srow0, int nrows, bf16* dst, int drow0, const float* g, const float* msc, const float* bsc, const float* msh, const float* bsh) {
    int lane = F.lane; asm volatile("" : "+v"(lane));
    f32x4 A[8], B[8];
#pragma unroll
    for (int j = 0; j < 8; ++j) { const int c = 4 * lane + 256 * j;
        const f32x4 sc = *(const f32x4*)(msc + c) + *(const f32x4*)(bsc + c); A[j] = *(const f32x4*)(g + c) * (sc + 1.0f); B[j] = *(const f32x4*)(msh + c) + *(const f32x4*)(bsh + c); }
#ifndef NORM_REP
#define NORM_REP 1
#endif
#pragma unroll 1
    for (int rep = 0; rep < NORM_REP; ++rep)
    for (int r = F.gw; r < nrows; r += F.NGW) {
        const f32x4* xr = (const f32x4*)(src + (size_t)(srow0 + r) * DM) + lane;
        f32x4 v[8]; float ss = 0.f;
#pragma unroll
        for (int j = 0; j < 8; ++j) { v[j] = __builtin_nontemporal_load(xr + 64 * j); ss += (v[j].x * v[j].x + v[j].y * v[j].y) + (v[j].z * v[j].z + v[j].w * v[j].w); }
        const float rstd = rsqrtf(wave_sum(ss) * (1.f / DM) + EPSN);
        v2u* o = (v2u*)(dst + (size_t)(drow0 + r) * DM) + lane;
#pragma unroll
        for (int j = 0; j < 8; ++j) { const f32x4 y = v[j] * rstd * A[j] + B[j]; v2u w; w.x = cvtpk(y.x, y.y); w.y = cvtpk(y.z, y.w); o[64 * j] = w; }
    }
}
DI void norm_phase(Frame& F, const float* src, int l, int which, bool with_ctx) {
    const float* M = WSF(WS_M) + (size_t)l * 3 * 12288; const float* ab = F.a->in[5] + (size_t)l * 12288;
    const float* g = (which ? F.a->in[7] : F.a->in[6]) + (size_t)l * DM; const int csh = which ? 3 : 0, csc = which ? 4 : 1;
    for (int b = 0; b < NBATCH; ++b)
        norm_rows(F, src, b * SEQ, SEQ, WSB(WS_H), b * SEQ, g, M + b * 12288 + csc * DM, ab + csc * DM, M + b * 12288 + csh * DM, ab + csh * DM);
    if (with_ctx) norm_rows(F, F.a->in[2], 0, MC, WSB(WS_H), MT, g, M + 2 * 12288 + csc * DM, ab + csc * DM, M + 2 * 12288 + csh * DM, ab + csh * DM);
}
template <int SEGL> DI void qk_step(bf16* p, const float* gain, float scale, bool rope, int prow, int pcol, int lane, bool store) {
    const v4u raw = *(const v4u*)p;
    float x[8];
#pragma unroll
    for (int e = 0; e < 4; ++e) { x[2 * e] = bflo(raw[e]); x[2 * e + 1] = bfhi(raw[e]); }
    float ss = 0.f;
#pragma unroll
    for (int e = 0; e < 8; ++e) ss += x[e] * x[e];
#pragma unroll
    for (int o = 1; o < SEGL; o <<= 1) ss += __shfl_xor(ss, o);
    const float rstd = rsqrtf(ss * (1.f / (8 * SEGL)) + EPSN);
    const int k = lane & (SEGL - 1);
    const f32x4 g0 = *(const f32x4*)(gain + 8 * k), g1 = *(const f32x4*)(gain + 8 * k + 4);
#pragma unroll
    for (int e = 0; e < 8; ++e) x[e] *= rstd * (e < 4 ? g0[e & 3] : g1[e & 3]);
    if (rope) {
        constexpr int NF = 2 * SEGL;
        const int axis = k / (SEGL / 2), half = (k / (SEGL / 4)) & 1, f0 = 8 * (k & (SEGL / 4 - 1));
        const float pos = (float)(axis ? pcol : prow);
#pragma unroll
        for (int e = 0; e < 8; ++e) {
            const float xp = __shfl_xor(x[e], SEGL / 4);
            const float inv = __builtin_amdgcn_exp2f(-(float)(f0 + e) * (13.287712379549449f / NF));
            const float rev = pos * inv * 0.15915494309189535f;
            const float c = fcos_rev(rev), s = fsin_rev(rev);
            x[e] = half ? (x[e] * c + xp * s) : (x[e] * c - xp * s);
        }
    }
    if (store) { v4u o;
#pragma unroll
        for (int e = 0; e < 4; ++e) o[e] = cvtpk(x[2 * e] * scale, x[2 * e + 1] * scale);
        *(v4u*)p = o; }
}
DI int vt_perm_key(int pos) { const int gq = pos >> 4, h = (pos >> 3) & 1, j = pos & 7; return 16 * gq + 8 * (j >> 2) + 4 * h + (j & 3); }
DI void p3_rope(Frame& F, bool dry) {
    bf16* P = WSB(WS_P); const int lane = F.lane;
    const float *aq = F.a->in[10], *ak = F.a->in[11], *bq = F.a->in[17], *bk = F.a->in[18];
    for (int r = F.gw; r < MALL; r += F.NGW) {
        bf16* row = P + (size_t)r * INA + 8 * lane;
        if (r < MT) { const int t = r & (SEQ - 1), prow = t >> 6, pcol = t & 63;
            qk_step<8>(row, aq, 0.125f * LOG2E, true, prow, pcol, lane, !dry); qk_step<8>(row + 512, aq, 0.125f * LOG2E, true, prow, pcol, lane, !dry);
            qk_step<16>(row + 1024, bq, 0.08838834764831845f * LOG2E, true, prow, pcol, lane, !dry); qk_step<16>(row + 1536, bq, 0.08838834764831845f * LOG2E, true, prow, pcol, lane, !dry);
            qk_step<8>(row + 2048, ak, 1.f, true, prow, pcol, lane, !dry); qk_step<8>(row + 2560, ak, 1.f, true, prow, pcol, lane, !dry);
            qk_step<16>(row + 4096, bk, 1.f, true, prow, pcol, lane, !dry && lane < 32);
        } else {
            qk_step<8>(row + 2048, ak, 1.f, false, 0, 0, lane, !dry); qk_step<8>(row + 2560, ak, 1.f, false, 0, 0, lane, !dry);
            qk_step<16>(row + 4096, bk, 1.f, false, 0, 0, lane, !dry && lane < 32);
        }
    }
    unsigned char* scr = F.lds + F.wave * 17408;
    bf16* VT = WSB(WS_VT);
    for (int it = F.gw; it < NBATCH * 260 * NVH; it += F.NGW) {
        const int vh = it % NVH, kc = (it / NVH) % 260, b = it / (NVH * 260);
        const int srow0 = kc < 4 ? MT + b * CTXL + kc * 64 : b * SEQ + (kc - 4) * 64;
        const int scol = vh < 8 ? 3072 + vh * 128 : 4352 + (vh - 8) * 128;
#pragma unroll 4
        for (int i = 0; i < 16; ++i) { const int rr = 4 * i + (lane >> 4), ch = lane & 15;
            *(v4u*)(scr + rr * 272 + ch * 16) = *(const v4u*)(P + (size_t)(srow0 + rr) * INA + scol + ch * 8); }
        asm volatile("s_waitcnt vmcnt(0) lgkmcnt(0)" ::: "memory");
#pragma unroll 4
        for (int i = 0; i < 16; ++i) { const int pair = i * 64 + lane, d = pair >> 3, oct = pair & 7;
            unsigned short e[8];
#pragma unroll
            for (int j = 0; j < 8; ++j) e[j] = *(const unsigned short*)(scr + vt_perm_key(8 * oct + j) * 272 + 2 * d);
            v4u o; o.x = e[0] | ((unsigned)e[1] << 16); o.y = e[2] | ((unsigned)e[3] << 16); o.z = e[4] | ((unsigned)e[5] << 16); o.w = e[6] | ((unsigned)e[7] << 16);
            *(v4u*)(VT + ((size_t)(b * NVH + vh) * 128 + d) * NKEY + kc * 64 + 8 * oct) = o; }
        asm volatile("s_waitcnt lgkmcnt(0)" ::: "memory");
    }
}
#define MFMA32(a, b, c) __builtin_amdgcn_mfma_f32_32x32x16_bf16((a), (b), (c), 0, 0, 0)
DI int crow(int r, int hi) { return (r & 3) + 8 * (r >> 2) + 4 * hi; }
template <int DQK, bool WIN> DI void attn_pass(Frame& F, const bf16* P, const bf16* VTh, int b, int q0, int qcol, int kcol, f32x16 (&o)[4], float& lsum) {
    constexpr int KS = DQK / 16, KROWB = DQK * 2 + 16, KT_BYTES = 64 * KROWB, VROWB = 144, STG = KT_BYTES + 128 * VROWB, KLD = DQK / 64;
    const int tid = F.tid, lane = F.lane, r32 = lane & 31, hi = lane >> 5, wid = F.wave;
    unsigned char* lds = F.lds;
    bf16x8 qf[KS];
    { const bf16* qp = P + (size_t)(b * SEQ + q0 + wid * 32 + r32) * INA + qcol + 8 * hi;
#pragma unroll
      for (int s = 0; s < KS; ++s) qf[s] = *(const bf16x8*)(qp + 16 * s); }
#pragma unroll
    for (int d = 0; d < 4; ++d)
#pragma unroll
        for (int i = 0; i < 16; ++i) o[d][i] = 0.f;
    float l = 0.f;
    int band0 = 0, NT;
    if (WIN) { band0 = q0 - 128 < 0 ? 0 : q0 - 128; const int band1 = q0 + 384 > SEQ ? SEQ : q0 + 384; NT = 4 + (band1 - band0) / 64; } else NT = NKEY / 64;
    v4u kreg[KLD], vreg[2];
    int koff[KLD], voff[2];
#pragma unroll
    for (int i = 0; i < KLD; ++i) { const int idx = tid + 512 * i, rr = idx / (DQK / 8), ch = idx % (DQK / 8); koff[i] = rr * INA + ch * 8; }
#pragma unroll
    for (int i = 0; i < 2; ++i) { const int idx = tid + 512 * i, d = idx >> 3, ch = idx & 7; voff[i] = d * NKEY + ch * 8; }
#define ATT_ISSUE(t_) do { const int t__ = (t_); \
        const int kk0 = WIN ? (t__ < 4 ? 64 * t__ : CTXL + band0 + 64 * (t__ - 4)) : 64 * t__; \
        const int rowbase = kk0 < CTXL ? MT + b * CTXL + kk0 : b * SEQ + kk0 - CTXL; \
        const bf16* tk_ = P + (size_t)rowbase * INA + kcol; const bf16* tv_ = VTh + kk0; \
        _Pragma("unroll") for (int i = 0; i < KLD; ++i) kreg[i] = *(const v4u*)(tk_ + koff[i]); \
        _Pragma("unroll") for (int i = 0; i < 2; ++i) vreg[i] = *(const v4u*)(tv_ + voff[i]); } while (0)
#define ATT_COMMIT(st_) do { unsigned char* kb_ = lds + (st_) * STG; unsigned char* vb_ = kb_ + KT_BYTES; \
        _Pragma("unroll") for (int i = 0; i < KLD; ++i) { const int idx = tid + 512 * i, rr = idx / (DQK / 8), ch = idx % (DQK / 8); *(v4u*)(kb_ + rr * KROWB + ch * 16) = kreg[i]; } \
        _Pragma("unroll") for (int i = 0; i < 2; ++i) { const int idx = tid + 512 * i, d = idx >> 3, ch = idx & 7; *(v4u*)(vb_ + d * VROWB + ch * 16) = vreg[i]; } } while (0)
    __syncthreads();
    ATT_ISSUE(0); ATT_COMMIT(0); __syncthreads();
    const int qpos = q0 + wid * 32 + r32;
    for (int t = 0; t < NT; ++t) {
        if (t + 1 < NT) ATT_ISSUE(t + 1);
        const unsigned char* kb = lds + (t & 1) * STG; const unsigned char* vb = kb + KT_BYTES;
        f32x16 p0, p1;
#pragma unroll
        for (int i = 0; i < 16; ++i) { p0[i] = 0.f; p1[i] = 0.f; }
#pragma unroll
        for (int s = 0; s < KS; ++s) {
            const bf16x8 a0 = *(const bf16x8*)(kb + r32 * KROWB + (16 * s + 8 * hi) * 2);
            const bf16x8 a1 = *(const bf16x8*)(kb + (32 + r32) * KROWB + (16 * s + 8 * hi) * 2);
            p0 = MFMA32(a0, qf[s], p0); p1 = MFMA32(a1, qf[s], p1);
        }
        if (WIN && t >= 4) { const int kp0 = band0 + 64 * (t - 4);
#pragma unroll
            for (int i = 0; i < 16; ++i) { const int d0 = kp0 + crow(i, hi) - qpos, d1 = d0 + 32;
                p0[i] = (d0 >= -128 && d0 <= 128) ? __builtin_amdgcn_exp2f(p0[i]) : 0.f; p1[i] = (d1 >= -128 && d1 <= 128) ? __builtin_amdgcn_exp2f(p1[i]) : 0.f; }
        } else {
#pragma unroll
            for (int i = 0; i < 16; ++i) { p0[i] = __builtin_amdgcn_exp2f(p0[i]); p1[i] = __builtin_amdgcn_exp2f(p1[i]); }
        }
        float sa = 0.f, sb = 0.f;
#pragma unroll
        for (int i = 0; i < 16; ++i) { sa += p0[i]; sb += p1[i]; asm("" : "+v"(sb)); }
        l += sa + sb;
        bf16x8 pb[4];
#pragma unroll
        for (int s = 0; s < 2; ++s) {
            v4u w0, w1;
#pragma unroll
            for (int e = 0; e < 4; ++e) { w0[e] = cvtpk(p0[8 * s + 2 * e], p0[8 * s + 2 * e + 1]); w1[e] = cvtpk(p1[8 * s + 2 * e], p1[8 * s + 2 * e + 1]); }
            pb[s] = __builtin_bit_cast(bf16x8, w0); pb[2 + s] = __builtin_bit_cast(bf16x8, w1);
        }
#pragma unroll
        for (int db = 0; db < 4; ++db)
#pragma unroll
            for (int ks = 0; ks < 4; ++ks) {
                const bf16x8 a = *(const bf16x8*)(vb + (32 * db + r32) * VROWB + (16 * ks + 8 * hi) * 2);
                o[db] = MFMA32(a, pb[ks], o[db]);
            }
        if (t + 1 < NT) ATT_COMMIT((t + 1) & 1);
        __syncthreads();
    }
    lsum = l + __shfl_xor(l, 32);
#undef ATT_ISSUE
#undef ATT_COMMIT
}
DI void p4_attention(Frame& F) {
    const bf16* P = WSB(WS_P); const bf16* VT = WSB(WS_VT); bf16* O = WSB(WS_H);
    const int lane = F.lane, r32 = lane & 31, hi = lane >> 5, wid = F.wave;
    const float lam = WSF(WS_LAM)[0];
    for (int u = blockIdx.x; u < 2048; u += gridDim.x) {
        if (u < 1024) {
            const int b = u >> 9, head = (u >> 6) & 7, q0 = (u & 63) * 256;
            const bf16* VTh = VT + (size_t)(b * NVH + head) * 128 * NKEY;
            f32x16 o[4]; float l;
            attn_pass<64, false>(F, P, VTh, b, q0, head * 128, 2048 + head * 128, o, l);
            v4u* stash = (v4u*)(F.lds + 73728 + F.tid * 128);
            { const float rl = 1.f / l;
#pragma unroll
              for (int d = 0; d < 4; ++d)
#pragma unroll
                  for (int e4 = 0; e4 < 2; ++e4) { v4u w;
#pragma unroll
                      for (int e = 0; e < 4; ++e) w[e] = cvtpk(o[d][8 * e4 + 2 * e] * rl, o[d][8 * e4 + 2 * e + 1] * rl);
                      stash[d * 2 + e4] = w; } }
            attn_pass<64, false>(F, P, VTh, b, q0, head * 128 + 64, 2048 + head * 128 + 64, o, l);
            const float rl2 = lam / l; float ss = 0.f;
#pragma unroll
            for (int d = 0; d < 4; ++d)
#pragma unroll
                for (int e4 = 0; e4 < 2; ++e4) { const v4u w = stash[d * 2 + e4];
#pragma unroll
                    for (int e = 0; e < 4; ++e) { const float v0 = bflo(w[e]) - rl2 * o[d][8 * e4 + 2 * e], v1 = bfhi(w[e]) - rl2 * o[d][8 * e4 + 2 * e + 1]; o[d][8 * e4 + 2 * e] = v0; o[d][8 * e4 + 2 * e + 1] = v1; ss += v0 * v0 + v1 * v1; } }
            ss += __shfl_xor(ss, 32);
            const float rstd = rsqrtf(ss * (1.f / 128.f) + EPSN) * 0.8f;
            const float* sg = F.a->in[16];
            bf16* orow = O + (size_t)(b * SEQ + q0 + wid * 32 + r32) * DM + head * 128;
#pragma unroll
            for (int d = 0; d < 4; ++d)
#pragma unroll
                for (int g4 = 0; g4 < 4; ++g4) { const int dd = 32 * d + 8 * g4 + 4 * hi; const f32x4 gg = *(const f32x4*)(sg + dd);
                    v2u w; w.x = cvtpk(o[d][4 * g4] * rstd * gg.x, o[d][4 * g4 + 1] * rstd * gg.y); w.y = cvtpk(o[d][4 * g4 + 2] * rstd * gg.z, o[d][4 * g4 + 3] * rstd * gg.w);
                    *(v2u*)(orow + dd) = w; }
        } else {
            const int uu = u - 1024, b = uu >> 9, qh = (uu >> 6) & 7, q0 = (uu & 63) * 256, g = qh >> 2;
            const bf16* VTh = VT + (size_t)(b * NVH + 8 + g) * 128 * NKEY;
            f32x16 o[4]; float l;
            attn_pass<128, true>(F, P, VTh, b, q0, 1024 + qh * 128, 4096 + g * 128, o, l);
            const float rl = 1.f / (l + __expf(F.a->in[19][qh]));
            bf16* orow = O + (size_t)(b * SEQ + q0 + wid * 32 + r32) * DM + 1024 + qh * 128;
#pragma unroll
            for (int d = 0; d < 4; ++d)
#pragma unroll
                for (int g4 = 0; g4 < 4; ++g4) { const int dd = 32 * d + 8 * g4 + 4 * hi;
                    v2u w; w.x = cvtpk(o[d][4 * g4] * rl, o[d][4 * g4 + 1] * rl); w.y = cvtpk(o[d][4 * g4 + 2] * rl, o[d][4 * g4 + 3] * rl);
                    *(v2u*)(orow + dd) = w; }
        }
    }
}
DI void p12_shortconv(Frame& F) {
    const bf16* Z = WSB(WS_P); bf16* T = WSB(WS_T); const float* cw = F.a->in[22]; const float* cb = F.a->in[23]; const int lane = F.lane;
    unsigned char* scr = F.lds + F.wave * 18432;
    for (int it = F.gw; it < NBATCH * 256 * 48; it += F.NGW) {
        const int cc = it % 48, tc = (it / 48) & 255, b = it / (48 * 256); const int t0 = tc * 64, c0 = cc * 128;
        for (int i = 0; i < 17; ++i) { const int rr = 4 * i + (lane >> 4), ch = lane & 15; const int t = t0 - 1 + rr;
            if (rr < 66) { v4u v = {0, 0, 0, 0}; if (t >= 0 && t < SEQ) v = *(const v4u*)(Z + (size_t)(b * SEQ + t) * HY3 + c0 + ch * 8); *(v4u*)(scr + rr * 272 + ch * 16) = v; } }
        asm volatile("s_waitcnt vmcnt(0) lgkmcnt(0)" ::: "memory");
#pragma unroll 2
        for (int i = 0; i < 16; ++i) { const int pair = i * 64 + lane, c = pair >> 3, oct = pair & 7; const int col = c0 + c;
            const float w0 = cw[col], w1 = cw[HY3 + col], w2 = cw[2 * HY3 + col], bb = cb[col];
            float z[10];
#pragma unroll
            for (int j = 0; j < 10; ++j) z[j] = bf1(*(const unsigned short*)(scr + (8 * oct + j) * 272 + 2 * c));
            v4u o;
#pragma unroll
            for (int e = 0; e < 4; ++e) { const float y0 = w0 * z[2 * e] + w1 * z[2 * e + 1] + w2 * z[2 * e + 2] + bb, y1 = w0 * z[2 * e + 1] + w1 * z[2 * e + 2] + w2 * z[2 * e + 3] + bb; o[e] = cvtpk(y0, y1); }
            const int which = col >> 11, ch = col & 2047;
            *(v4u*)(T + (((size_t)which * NBATCH + b) * DM + ch) * SEQ + t0 + 8 * oct) = o; }
        asm volatile("s_waitcnt lgkmcnt(0)" ::: "memory");
    }
}
typedef float2 cf;
constexpr int FM = 16384;
#define FPAD(i) ((i) + (((i) >> 6) << 2))
#define NOSLP(v) asm("" : "+v"((v).y))
DI cf cmul(cf a, cf b) { cf r = make_float2(a.x * b.x - a.y * b.y, a.x * b.y + a.y * b.x); NOSLP(r); return r; }
DI cf cmulc(cf a, cf b) { cf r = make_float2(a.x * b.x + a.y * b.y, a.y * b.x - a.x * b.y); NOSLP(r); return r; }
DI cf cadd(cf a, cf b) { cf r = make_float2(a.x + b.x, a.y + b.y); NOSLP(r); return r; }
DI cf csub(cf a, cf b) { cf r = make_float2(a.x - b.x, a.y - b.y); NOSLP(r); return r; }
template <bool INV> DI void r4(cf& a0, cf& a1, cf& a2, cf& a3) {
    const cf t0 = cadd(a0, a2), t1 = csub(a0, a2), t2 = cadd(a1, a3), t3 = csub(a1, a3);
    a0 = cadd(t0, t2); a2 = csub(t0, t2);
    if (!INV) { a1 = make_float2(t1.x + t3.y, t1.y - t3.x); a3 = make_float2(t1.x - t3.y, t1.y + t3.x); }
    else      { a1 = make_float2(t1.x - t3.y, t1.y + t3.x); a3 = make_float2(t1.x + t3.y, t1.y - t3.x); }
    NOSLP(a1); NOSLP(a3);
}
template <bool INV> DI void fft16(cf (&v)[16]) {
    constexpr float C1 = 0.9238795325112867f, S1 = 0.3826834323650898f, C2 = 0.7071067811865476f;
    const cf W[10] = {make_float2(1.f, 0.f), make_float2(C1, -S1), make_float2(C2, -C2), make_float2(S1, -C1), make_float2(0.f, -1.f), make_float2(-S1, -C1), make_float2(-C2, -C2), make_float2(-C1, -S1), make_float2(-1.f, 0.f), make_float2(-C1, S1)};
    if (!INV) {
#pragma unroll
        for (int i0 = 0; i0 < 4; ++i0) r4<false>(v[i0], v[4 + i0], v[8 + i0], v[12 + i0]);
#pragma unroll
        for (int m = 1; m < 4; ++m)
#pragma unroll
            for (int i0 = 1; i0 < 4; ++i0) v[4 * m + i0] = cmul(v[4 * m + i0], W[i0 * m]);
#pragma unroll
        for (int m = 0; m < 4; ++m) r4<false>(v[4 * m], v[4 * m + 1], v[4 * m + 2], v[4 * m + 3]);
    } else {
#pragma unroll
        for (int m = 0; m < 4; ++m) r4<true>(v[4 * m], v[4 * m + 1], v[4 * m + 2], v[4 * m + 3]);
#pragma unroll
        for (int m = 1; m < 4; ++m)
#pragma unroll
            for (int i0 = 1; i0 < 4; ++i0) v[4 * m + i0] = cmulc(v[4 * m + i0], W[i0 * m]);
#pragma unroll
        for (int i0 = 0; i0 < 4; ++i0) r4<true>(v[i0], v[4 + i0], v[8 + i0], v[12 + i0]);
    }
}
template <int S, bool INV, bool HALF = false> DI void fft_pass16(cf* cx, int tid) {
    constexpr int stride = S / 16;
    constexpr int estr = stride + (stride >= 64 ? 4 * (stride / 64) : 0);
    asm volatile("" : "+v"(tid));
#pragma unroll 2
    for (int u = tid; u < FM / 16; u += 512) {
        const int blk = u / stride, i = u % stride, base = blk * S + i;
        cf* p = cx + FPAD(base);
        const float rev = (float)i * (1.f / S);
        const cf w1 = make_float2(fcos_rev(rev), -fsin_rev(rev));
        cf v[16];
        if (!INV) {
#pragma unroll
            for (int j = 0; j < 16; ++j) v[j] = (HALF && j >= 8) ? make_float2(0.f, 0.f) : p[j * estr];
            fft16<false>(v);
            cf w = w1; p[0] = v[0];
#pragma unroll
            for (int f = 1; f < 16; ++f) { const int q = 4 * (f & 3) + (f >> 2); p[f * estr] = cmul(v[q], w); w = cmul(w, w1); }
        } else {
            cf w = w1; v[0] = p[0];
#pragma unroll
            for (int f = 1; f < 16; ++f) { const int q = 4 * (f & 3) + (f >> 2); v[q] = cmulc(p[f * estr], w); w = cmul(w, w1); }
            fft16<true>(v);
#pragma unroll
            for (int j = 0; j < (HALF ? 8 : 16); ++j) p[j * estr] = v[j];
        }
    }
}
template <bool INV> DI void fft_pass4(cf* cx, int tid) {
    asm volatile("" : "+v"(tid));
#pragma unroll 1
    for (int u = tid; u < FM / 4; u += 512) { cf* p = cx + FPAD(4 * u);
        cf a0 = p[0], a1 = p[1], a2 = p[2], a3 = p[3];
        r4<INV>(a0, a1, a2, a3);
        p[0] = a0; p[1] = a1; p[2] = a2; p[3] = a3; }
}
template <bool HALF> DI void fft_fwd(cf* cx, int tid) {
    fft_pass16<16384, false, HALF>(cx, tid); __syncthreads(); fft_pass16<1024, false>(cx, tid); __syncthreads(); fft_pass16<64, false>(cx, tid); __syncthreads(); fft_pass4<false>(cx, tid); __syncthreads();
}
template <bool HALF> DI void fft_inv(cf* cx, int tid) {
    fft_pass4<true>(cx, tid); __syncthreads(); fft_pass16<64, true>(cx, tid); __syncthreads(); fft_pass16<1024, true>(cx, tid); __syncthreads(); fft_pass16<16384, true, HALF>(cx, tid); __syncthreads();
}
DI int fposu(int k) { return ((k & 15) << 10) | (((k >> 4) & 15) << 6) | (((k >> 8) & 15) << 2) | (k >> 12); }
DI void rsplit(cf Zk, cf Zm, cf w, cf& Uk, cf& Um) {
    cf E = make_float2(0.5f * (Zk.x + Zm.x), 0.5f * (Zk.y - Zm.y)), O = make_float2(0.5f * (Zk.y + Zm.y), -0.5f * (Zk.x - Zm.x));
    NOSLP(E); NOSLP(O);
    const cf T = cmul(w, O);
    Uk = cadd(E, T); Um = make_float2(E.x - T.x, -(E.y - T.y)); NOSLP(Um);
}
DI void p14_longconv(Frame& F, bool dry) {
    cf* cx = (cf*)F.lds; float* red = (float*)(F.lds + 139264); int tid = F.tid;
    const bf16* FILT = WSB(WS_FILT); bf16* T = WSB(WS_T); const float* dsk = F.a->in[32];
    cf* spec = (cf*)(F.ws + WS_SPEC + (size_t)blockIdx.x * SPEC_SLOT);
    for (int c = blockIdx.x; c < DM; c += gridDim.x) {
        const float delta = fabsf(-3.0701134573253944f + (float)c * ((-15.350567286626972f + 3.0701134573253944f) / 2047.f));
        const float dk = delta * (1.f / 16383.f) * LOG2E;
        for (int ord = 0; ord < 2; ++ord) {
            const bf16* hf = FILT + ((size_t)(ord * 2 + 0) * DM + c) * SEQ; const bf16* hb = FILT + ((size_t)(ord * 2 + 1) * DM + c) * SEQ;
            __syncthreads();
            asm volatile("" : "+v"(tid));
            float asum = 0.f;
#pragma unroll 8
            for (int n = tid; n < FM; n += 512) {
                float v0, v1;
                if (n < FM / 2) { const unsigned w = *(const unsigned*)(hf + 2 * n); v0 = bflo(w) * __builtin_amdgcn_exp2f(-(float)(2 * n) * dk); v1 = bfhi(w) * __builtin_amdgcn_exp2f(-(float)(2 * n + 1) * dk); }
                else { const int m0 = 2 * n, m1 = 2 * n + 1;
                    const int s0 = 2 * SEQ - m0, s1 = 2 * SEQ - m1;
                    v0 = (m0 == SEQ) ? 0.f : bf1(hb[s0]) * __builtin_amdgcn_exp2f(-(float)s0 * dk); v1 = bf1(hb[s1]) * __builtin_amdgcn_exp2f(-(float)s1 * dk); }
                asum += fabsf(v0) + fabsf(v1); cx[FPAD(n)] = make_float2(v0, v1);
            }
            asum = wave_sum(asum); if (F.lane == 0) red[F.wave] = asum;
            __syncthreads();
            float tot = 0.f;
#pragma unroll
            for (int w = 0; w < 8; ++w) tot += red[w];
            const float fscale = 1.f / (tot * (float)FM);
            fft_fwd<false>(cx, tid);
#pragma unroll 8
            for (int e = tid; e < FM / 2; e += 512) {
                const int pu = 4 * (e >> 1) + (e & 1), k = 4096 * (e & 1) + 256 * ((e >> 1) & 15) + 16 * ((e >> 5) & 15) + (e >> 9);
                if (e == 0) { const cf z = cx[0]; spec[0] = make_float2((z.x + z.y) * fscale, 0.f); spec[FM] = make_float2((z.x - z.y) * fscale, 0.f);
                    const cf z2 = cx[2]; spec[2] = make_float2(z2.x * fscale, -z2.y * fscale); }
                else { const int km = FM - k, pmu = fposu(km); const float rev = (float)k * (1.f / (2 * FM)); const cf w = make_float2(fcos_rev(rev), -fsin_rev(rev)); cf Uk, Um;
                    rsplit(cx[FPAD(pu)], cx[FPAD(pmu)], w, Uk, Um); spec[pu] = make_float2(Uk.x * fscale, Uk.y * fscale); spec[pmu] = make_float2(Um.x * fscale, Um.y * fscale); }
            }
            __threadfence_block();
            const float dskip = dsk[ord * DM + c];
            for (int b = 0; b < NBATCH; ++b) {
                bf16* u = T + ((size_t)(0 * NBATCH + b) * DM + c) * SEQ;
                const bf16* gate = T + ((size_t)((1 + ord) * NBATCH + b) * DM + c) * SEQ;
                __syncthreads();
                asm volatile("" : "+v"(tid));
                unsigned uw[16], gw[16]; cf s1[16], s2[16];
#pragma unroll
                for (int q = 0; q < 16; ++q) uw[q] = *(const unsigned*)(u + 2 * (tid + 512 * q));
#pragma unroll
                for (int q = 0; q < 16; ++q) cx[FPAD(tid + 512 * q)] = make_float2(bflo(uw[q]), bfhi(uw[q]));
#pragma unroll
                for (int q = 0; q < 16; ++q) {
                    const int e = tid + 512 * q; gw[q] = *(const unsigned*)(gate + 2 * e);
                    const int pu = 4 * (e >> 1) + (e & 1), k = 4096 * (e & 1) + 256 * ((e >> 1) & 15) + 16 * ((e >> 5) & 15) + (e >> 9);
                    s1[q] = spec[pu]; }
                const cf sx = spec[2];
                __syncthreads();
                fft_fwd<true>(cx, tid);
#pragma unroll
                for (int q = 0; q < 16; ++q) { const int e = tid + 512 * q; const int k = 4096 * (e & 1) + 256 * ((e >> 1) & 15) + 16 * ((e >> 5) & 15) + (e >> 9); s2[q] = spec[e == 0 ? FM : fposu(FM - k)]; }
#pragma unroll
                for (int q = 0; q < 16; ++q) {
                    const int e = tid + 512 * q;
                    const int pu = 4 * (e >> 1) + (e & 1), k = 4096 * (e & 1) + 256 * ((e >> 1) & 15) + 16 * ((e >> 5) & 15) + (e >> 9);
                    if (q == 0 && e == 0) { const cf z = cx[0]; const float y0 = (z.x + z.y) * s1[0].x, ym = (z.x - z.y) * s2[0].x; cx[0] = make_float2(0.5f * (y0 + ym), 0.5f * (y0 - ym));
                        const cf z2 = cx[2]; const cf y2 = cmul(make_float2(z2.x, -z2.y), sx); cx[2] = make_float2(y2.x, -y2.y); }
                    else { const int km = FM - k, pmu = fposu(km); const float rev = (float)k * (1.f / (2 * FM)); const cf w = make_float2(fcos_rev(rev), -fsin_rev(rev)); cf Uk, Um;
                        const int pk = FPAD(pu), pm = FPAD(pmu);
                        rsplit(cx[pk], cx[pm], w, Uk, Um);
                        const cf Yk = cmul(Uk, s1[q]), Ym = cmul(Um, s2[q]);
                        cf E = make_float2(0.5f * (Yk.x + Ym.x), 0.5f * (Yk.y - Ym.y)), D = make_float2(0.5f * (Yk.x - Ym.x), 0.5f * (Yk.y + Ym.y)); NOSLP(E); NOSLP(D);
                        const cf O = cmulc(D, w);
                        cx[pk] = make_float2(E.x - O.y, E.y + O.x); cx[pm] = make_float2(E.x + O.y, -E.y + O.x); }
                    if (q & 1) asm volatile("" ::: "memory");
                }
                __syncthreads();
                fft_inv<true>(cx, tid);
#pragma unroll
                for (int q = 0; q < 16; ++q) { const int n = tid + 512 * q; const cf y = cx[FPAD(n)];
                    const float r0 = (y.x + dskip * bflo(uw[q])) * bflo(gw[q]), r1 = (y.y + dskip * bfhi(uw[q])) * bfhi(gw[q]);
                    if (!dry) *(unsigned*)(u + 2 * n) = cvtpk(r0, r1); }
                __threadfence_block();
            }
        }
    }
}
DI void p15_transpose_y(Frame& F) {
    const bf16* T = WSB(WS_T); bf16* Y = WSB(WS_H); const int lane = F.lane;
    unsigned char* scr = F.lds + F.wave * 9216;
    for (int it = F.gw; it < NBATCH * 256 * 32; it += F.NGW) {
        const int cc = it & 31, tc = (it >> 5) & 255, b = it >> 13; const int c0 = cc * 64, t0 = tc * 64;
#pragma unroll
        for (int i = 0; i < 8; ++i) { const int rr = 8 * i + (lane >> 3), ch = lane & 7;
            *(v4u*)(scr + rr * 144 + ch * 16) = *(const v4u*)(T + ((size_t)b * DM + c0 + rr) * SEQ + t0 + ch * 8); }
        asm volatile("s_waitcnt vmcnt(0) lgkmcnt(0)" ::: "memory");
#pragma unroll 2
        for (int i = 0; i < 8; ++i) { const int pair = i * 64 + lane, t = pair >> 3, oct = pair & 7;
            unsigned short e[8];
#pragma unroll
            for (int j = 0; j < 8; ++j) e[j] = *(const unsigned short*)(scr + (8 * oct + j) * 144 + 2 * t);
            v4u o; o.x = e[0] | ((unsigned)e[1] << 16); o.y = e[2] | ((unsigned)e[3] << 16); o.z = e[4] | ((unsigned)e[5] << 16); o.w = e[6] | ((unsigned)e[7] << 16);
            *(v4u*)(Y + (size_t)(b * SEQ + t0 + t) * DM + c0 + 8 * oct) = o; }
        asm volatile("s_waitcnt lgkmcnt(0)" ::: "memory");
    }
}
#define GAS __attribute__((address_space(1)))
#define RLX_AGENT __ATOMIC_RELAXED, __HIP_MEMORY_SCOPE_AGENT
#define XB_TMO      128
#define XB_XCNT(j)  (256  + 64 * (j))
#define XB_XSUB(j)  (1280 + 64 * (j))
#define XB_XGEN(j)  (2304 + 64 * (j))
#define XB_TOP      3328
#define XB_TOPGEN   3392
#define XCD_BAR_WORDS 3456
#define XB_SPIN_CAP (1u << 18)

__device__ __forceinline__ unsigned xb_ld(unsigned* p)              { return __hip_atomic_load(p, __ATOMIC_RELAXED, __HIP_MEMORY_SCOPE_AGENT); }
__device__ __forceinline__ unsigned xb_add(unsigned* p, unsigned v) { return __hip_atomic_fetch_add(p, v, __ATOMIC_RELAXED, __HIP_MEMORY_SCOPE_AGENT); }
__device__ __forceinline__ unsigned xb_xcc_id() { return (unsigned)__builtin_amdgcn_s_getreg((3 << 11) | 20) & 0xFu; }
#define XB_SPIN(cond, bar) do { unsigned _sp = 0; while (cond) { __builtin_amdgcn_s_sleep(1); \
    if ((++_sp & 255u) == 0u) { if (xb_ld(&(bar)[XB_TMO])) break; if (_sp > XB_SPIN_CAP) { atomicAdd(&(bar)[XB_TMO], 1u); break; } } } } while (0)

struct XcdBarrier {
    unsigned* bar; unsigned x;
    volatile LAS unsigned* st;
};

__device__ __forceinline__ XcdBarrier xcd_barrier_post(unsigned* bar, volatile LAS unsigned* st) {
    XcdBarrier b; b.bar = bar; b.x = xb_xcc_id(); b.st = st;
    if (threadIdx.x == 0) (void)xb_add(&bar[XB_XCNT(b.x)], 1u);
    return b;
}
__device__ __forceinline__ void xcd_barrier_complete(unsigned* bar, unsigned x, unsigned& nloc, unsigned& nx) {
    const unsigned G = gridDim.x * gridDim.y * gridDim.z;
    unsigned sum, cnt, mine, sp = 0u;
    for (;;) {
        sum = 0u; cnt = 0u; mine = 0u;
#pragma unroll
        for (unsigned j = 0; j < 16; ++j) { const unsigned c = xb_ld(&bar[XB_XCNT(j)]); sum += c; cnt += (c > 0u) ? 1u : 0u; mine = (j == x) ? c : mine; }
        if (sum == G) break;
        __builtin_amdgcn_s_sleep(1);
        if ((++sp & 255u) == 0u) { if (xb_ld(&bar[XB_TMO])) break; if (sp > XB_SPIN_CAP) { atomicAdd(&bar[XB_TMO], 1u); break; } }
    }
    nloc = mine > 0u ? mine : 1u; nx = cnt > 0u ? cnt : 1u;
}

__device__ __forceinline__ void xcd_barrier(const XcdBarrier& b) {
    asm volatile("s_waitcnt vmcnt(0)" ::: "memory");
    __syncthreads();
    if (threadIdx.x == 0) {
        unsigned* bar = b.bar;
        __builtin_amdgcn_s_waitcnt(0);
        unsigned nloc = b.st[0], nx = b.st[1];
        if (nloc == 0u) { xcd_barrier_complete(bar, b.x, nloc, nx); b.st[0] = nloc; b.st[1] = nx; }
        const unsigned old = xb_add(&bar[XB_XSUB(b.x)], 1u);
        const unsigned gen = old / nloc;
        if (old + 1u == (gen + 1u) * nloc) {
            __builtin_amdgcn_fence(__ATOMIC_RELEASE, "agent");
            asm volatile("s_waitcnt vmcnt(0)" ::: "memory");
            const unsigned og = xb_add(&bar[XB_TOP], 1u);
            const unsigned tg = og / nx;
            if (og + 1u == (tg + 1u) * nx) xb_add(&bar[XB_TOPGEN], 1u);
            else XB_SPIN(xb_ld(&bar[XB_TOPGEN]) == tg, bar);
            __builtin_amdgcn_fence(__ATOMIC_ACQUIRE, "agent");
            xb_add(&bar[XB_XGEN(b.x)], 1u);
            asm volatile("s_waitcnt vmcnt(0)" ::: "memory");
        } else {
            XB_SPIN(xb_ld(&bar[XB_XGEN(b.x)]) == gen, bar);
            __builtin_amdgcn_fence(__ATOMIC_ACQUIRE, "agent");
            asm volatile("s_waitcnt vmcnt(0)" ::: "memory");
        }
    }
    __syncthreads();
}

#ifndef STAGGER_TICKS
#define STAGGER_TICKS 0
#endif
template <class Epi> DI void run_gemm(Frame& F, const bf16* A, const bf16* Bt, int M, int N, int K, const Epi& E, bool stagger = false) {
    if (STAGGER_TICKS > 0 && stagger && (blockIdx.x & 8)) {
        const unsigned long long t0 = __builtin_amdgcn_s_memrealtime();
        while (__builtin_amdgcn_s_memrealtime() - t0 < (unsigned long long)STAGGER_TICKS) __builtin_amdgcn_s_sleep(32);
    }
    __syncthreads();
    pg8::Gemm g{A, Bt, M, N, K}; pg8::StaticOrder S; S.init(M, N, (int)gridDim.x, (int)blockIdx.x);
    pg8::gemm_phase<Epi, pg8::StaticOrder, true, true>((PG8_LAS unsigned char*)F.lds, g, S, E);
    __syncthreads();
}
constexpr size_t WS_EG = WS_P, WS_EV = WS_P + 16 * MiB;
DI void glu_fixup(Frame& F, int l) {
    const float* EG = WSF(WS_EG); const float* EV = WSF(WS_EV); bf16* U = WSB(WS_U);
    const float* cw = F.a->in[36] + (size_t)l * 3 * DFF; const float* cb = F.a->in[37] + (size_t)l * DFF;
    for (int idx = blockIdx.x * 512 + F.tid; idx < 128 * 2 * (DFF / 4); idx += gridDim.x * 512) {
        const int c = (idx % (DFF / 4)) * 4, which = (idx / (DFF / 4)) & 1, pm = idx / (2 * (DFF / 4));
        const int row = pm * 256 + (which ? 255 : 0), t = row & (SEQ - 1);
        const f32x4 z = {0.f, 0.f, 0.f, 0.f};
        const f32x4 g = *(const f32x4*)(EG + ((size_t)pm * 4 + (which ? 3 : 0)) * DFF + c);
        const f32x4 up = which ? *(const f32x4*)(EG + ((size_t)pm * 4 + 2) * DFF + c) : (t == 0 ? z : *(const f32x4*)(EG + ((size_t)(pm - 1) * 4 + 3) * DFF + c));
        const f32x4 dn = which ? (t == SEQ - 1 ? z : *(const f32x4*)(EG + ((size_t)(pm + 1) * 4 + 0) * DFF + c)) : *(const f32x4*)(EG + ((size_t)pm * 4 + 1) * DFF + c);
        const f32x4 v = *(const f32x4*)(EV + ((size_t)pm * 2 + which) * DFF + c);
        const f32x4 gc = *(const f32x4*)(cw + c) * up + *(const f32x4*)(cw + DFF + c) * g + *(const f32x4*)(cw + 2 * DFF + c) * dn + *(const f32x4*)(cb + c);
        float r[4];
#pragma unroll
        for (int e = 0; e < 4; ++e) { const float x = gc[e]; const float ex = __builtin_amdgcn_exp2f(-2.3022082f * x * (1.f + 0.044715f * x * x)); r[e] = x * __builtin_amdgcn_rcpf(1.f + ex) * v[e]; }
        v2u o; o.x = cvtpk(r[0], r[1]); o.y = cvtpk(r[2], r[3]);
        *(v2u*)(U + (size_t)row * DFF + c) = o;
    }
}
DI void ffn_phases(Frame& F, int l, int sub, size_t wg, size_t wv, size_t wd) {
    const bf16* W = WSB(WS_W);
    if (sub == 0) { pg8::EpiGV E{WSB(WS_U), DFF, F.a->in[36] + (size_t)l * 3 * DFF, F.a->in[37] + (size_t)l * DFF, WSF(WS_EG), WSF(WS_EV), (PG8_LAS float*)((PG8_LAS unsigned char*)F.lds + RING_BYTES)};
        run_gemm(F, WSB(WS_H), W + wg, MT, 2 * DFF, DM, E); }
    else if (sub == 1) glu_fixup(F, l);
    else { pg8::EpiRes E{F.out, F.out, DM, WSF(WS_M) + (size_t)l * 3 * 12288 + 5 * DM, F.a->in[5] + (size_t)l * 12288 + 5 * DM}; run_gemm(F, WSB(WS_U), W + wd, MT, DM, DFF, E); }
}
constexpr int NPHASE = 21;
__global__ void __launch_bounds__(512, 2) mega_fwd(Args args) {
    extern __shared__ __attribute__((aligned(16))) unsigned char lds_raw[];
    cg::grid_group grid = cg::this_grid();
    Frame F;
    F.lds = lds_raw; F.tid = threadIdx.x; F.lane = F.tid & 63; F.wave = __builtin_amdgcn_readfirstlane(F.tid >> 6);
    F.gw = blockIdx.x * 8 + F.wave; F.NGW = gridDim.x * 8;
    F.a = &args;
    F.out = args.out; F.ws = args.ws;
    const int lo = args.ph_lo, hi = args.ph_hi;
    volatile LAS unsigned* MISC = (volatile LAS unsigned*)((LAS unsigned char*)lds_raw + MISC_OFF);
    if (F.tid < 64) MISC[F.tid] = 0u;
    __syncthreads();
    XcdBarrier bar = xcd_barrier_post((unsigned*)(F.ws + WS_BAR), MISC + 8);
#ifndef DUP_PHASE
#define DUP_PHASE -1
#endif
#ifndef ONLY_PHASE
#define ONLY_PHASE -1
#endif
#define IN(k) ((ONLY_PHASE < 0 || ONLY_PHASE == (k)) && lo <= (k) && (k) < hi)
#define SEAM(k) do { if (IN(k) && IN((k) + 1)) { if ((k) == 0 && lo > hi) grid.sync(); else xcd_barrier(bar); } } while (0)
    bf16* W = WSB(WS_W);
    if (IN(0)) {
        const TJob jobs[5] = {{F.a->in[8], DM, INA, W + W0_IN, 0}, {F.a->in[9], DM, DM, W + W0_OUT, 0}, {F.a->in[34], DM, DFF, W + W0_G, 1}, {F.a->in[35], DM, DFF, W + W0_G, 2}, {F.a->in[38], DFF, DM, W + W0_D, 0}};
        transpose_jobs<5>(F, jobs); p0_ada(F); p0_lam(F); p0_hyena_mlp(F);
#if DUP_PHASE == 99 || DUP_PHASE == 100
        transpose_jobs<5>(F, jobs); p0_hyena_mlp(F);
#endif
    }
    SEAM(0);
#if DUP_PHASE == 200
#pragma unroll 1
    for (int rep = 0; rep < 20; ++rep) grid.sync();
#endif
    if (IN(1)) norm_phase(F, F.a->in[0], 0, 0, true);
#if DUP_PHASE == 99 || DUP_PHASE == 101
    if (IN(1)) norm_phase(F, F.a->in[0], 0, 0, true);
#endif
    SEAM(1);
    if (IN(2)) { pg8::EpiBf16<0> E{WSB(WS_P), INA, nullptr, 0, 0, 1.f}; run_gemm(F, WSB(WS_H), W + W0_IN, MALL, INA, DM, E); }
#if DUP_PHASE == 2
    if (IN(2)) { pg8::EpiBf16<0> E{WSB(WS_P), INA, nullptr, 0, 0, 1.f}; run_gemm(F, WSB(WS_H), W + W0_IN, MALL, INA, DM, E); }
#endif
    SEAM(2);
#if DUP_PHASE == 3
    if (IN(3)) p3_rope(F, true);
#endif
    if (IN(3)) p3_rope(F, false);
    SEAM(3);
    if (IN(4)) p4_attention(F);
#if DUP_PHASE == 4
    if (IN(4)) { __syncthreads(); p4_attention(F); }
#endif
    SEAM(4);
    if (IN(5)) { pg8::EpiRes E{F.a->in[0], F.out, DM, WSF(WS_M) + 2 * DM, F.a->in[5] + 2 * DM}; run_gemm(F, WSB(WS_H), W + W0_OUT, MT, DM, DM, E); }
#if DUP_PHASE == 5
    if (IN(5)) { pg8::EpiRes E{F.a->in[0], F.out, DM, WSF(WS_M) + 2 * DM, F.a->in[5] + 2 * DM}; run_gemm(F, WSB(WS_H), W + W0_OUT, MT, DM, DM, E); }
#endif
    SEAM(5);
    if (IN(6)) norm_phase(F, F.out, 0, 1, false);
#if DUP_PHASE == 99 || DUP_PHASE == 101
    if (IN(6)) norm_phase(F, F.out, 0, 1, false);
#endif
    SEAM(6);
    if (IN(7)) ffn_phases(F, 0, 0, W0_G, W0_V, W0_D);
    SEAM(7);
    if (IN(8)) ffn_phases(F, 0, 1, W0_G, W0_V, W0_D);
    SEAM(8);
    if (IN(9)) ffn_phases(F, 0, 2, W0_G, W0_V, W0_D);
    SEAM(9);
    if (IN(10)) {
        const TJob jobs[5] = {{F.a->in[20], DM, HY3, W + W1_IN, 0}, {F.a->in[33], DM, DM, W + W1_OUT, 0}, {F.a->in[34] + (size_t)DM * DFF, DM, DFF, W + W1_G, 1}, {F.a->in[35] + (size_t)DM * DFF, DM, DFF, W + W1_G, 2}, {F.a->in[38] + (size_t)DFF * DM, DFF, DM, W + W1_D, 0}};
        transpose_jobs<5>(F, jobs); norm_phase(F, F.out, 1, 0, false);
#if DUP_PHASE == 99 || DUP_PHASE == 100
        transpose_jobs<5>(F, jobs);
#endif
#if DUP_PHASE == 99 || DUP_PHASE == 101
        norm_phase(F, F.out, 1, 0, false);
#endif
    }
    SEAM(10);
    if (IN(11)) { pg8::EpiBf16<0> E{WSB(WS_P), HY3, F.a->in[21], 0, 0, 1.f}; run_gemm(F, WSB(WS_H), W + W1_IN, MT, HY3, DM, E); }
#if DUP_PHASE == 11
    if (IN(11)) { pg8::EpiBf16<0> E{WSB(WS_P), HY3, F.a->in[21], 0, 0, 1.f}; run_gemm(F, WSB(WS_H), W + W1_IN, MT, HY3, DM, E); }
#endif
    SEAM(11);
    if (IN(12)) p12_shortconv(F);
#if DUP_PHASE == 12 || DUP_PHASE == 99
    if (IN(12)) p12_shortconv(F);
#endif
    SEAM(12);
    if (IN(13)) { pg8::EpiBf16<0> E{WSB(WS_FILT), SEQ, nullptr, 0, 0, 1.f}; run_gemm(F, WSB(WS_W3T), WSB(WS_A3), 8192, SEQ, 256, E); }
    SEAM(13);
#if DUP_PHASE == 14
    if (IN(14)) p14_longconv(F, true);
#endif
    if (IN(14)) p14_longconv(F, false);
    SEAM(14);
    if (IN(15)) p15_transpose_y(F);
#if DUP_PHASE == 99 || DUP_PHASE == 15
    if (IN(15)) p15_transpose_y(F);
#endif
    SEAM(15);
    if (IN(16)) { pg8::EpiRes E{F.out, F.out, DM, WSF(WS_M) + 3 * 12288 + 2 * DM, F.a->in[5] + 12288 + 2 * DM}; run_gemm(F, WSB(WS_H), W + W1_OUT, MT, DM, DM, E); }
    SEAM(16);
    if (IN(17)) norm_phase(F, F.out, 1, 1, false);
#if DUP_PHASE == 99 || DUP_PHASE == 101
    if (IN(17)) norm_phase(F, F.out, 1, 1, false);
#endif
    SEAM(17);
    if (IN(18)) ffn_phases(F, 1, 0, W1_G, W1_V, W1_D);
    SEAM(18);
    if (IN(19)) ffn_phases(F, 1, 1, W1_G, W1_V, W1_D);
    SEAM(19);
    if (IN(20)) ffn_phases(F, 1, 2, W1_G, W1_V, W1_D);
#undef IN
#undef SEAM
}
#ifndef MK_MULTI
#define MK_MULTI 0
#endif
extern "C" void kernel_launch(void* const* d_in, const int* in_sizes, int n_in, void* d_out, int out_size, void* d_ws, size_t ws_size, hipStream_t stream) {
    static int grid = 0;
    if (grid == 0) {
        if (n_in != 39 || in_sizes[0] != MT * DM || out_size != MT * DM || ws_size < WS_END) { fprintf(stderr, "kernel_launch: unexpected shapes (n_in %d in0 %d out %d ws %zu)\n", n_in, n_in > 0 ? in_sizes[0] : -1, out_size, ws_size); grid = -1; return; }
        int dev = 0, cus = 0, per_cu = 0;
        hipGetDevice(&dev); hipDeviceGetAttribute(&cus, hipDeviceAttributeMultiprocessorCount, dev);
        if (hipFuncSetAttribute((const void*)mega_fwd, hipFuncAttributeMaxDynamicSharedMemorySize, LDS_BYTES) != hipSuccess) { fprintf(stderr, "kernel_launch: hipFuncSetAttribute failed\n"); grid = -1; return; }
        if (hipOccupancyMaxActiveBlocksPerMultiprocessor(&per_cu, (const void*)mega_fwd, 512, LDS_BYTES) != hipSuccess || per_cu < 1) { fprintf(stderr, "kernel_launch: occupancy query says %d\n", per_cu); per_cu = 1; }
        (void)hipGetLastError();
        grid = cus * per_cu;
    }
    if (grid < 0) return;
    hipMemsetAsync((char*)d_ws + WS_M, 0, CTL_ZERO_BYTES, stream);
    Args a{};
    for (int i = 0; i < 39; ++i) a.in[i] = (const float*)d_in[i];
    a.out = (float*)d_out; a.ws = (unsigned char*)d_ws;
#if MK_MULTI
    for (int p = 0; p < NPHASE; ++p) { a.ph_lo = p; a.ph_hi = p + 1; hipLaunchKernelGGL(mega_fwd, dim3(grid), dim3(512), LDS_BYTES, stream, a); }
#else
    a.ph_lo = 0; a.ph_hi = NPHASE;
    void* kargs[] = {&a};
    hipError_t e = hipLaunchCooperativeKernel((const void*)mega_fwd, dim3(grid), dim3(512), kargs, LDS_BYTES, stream);
    if (e != hipSuccess) fprintf(stderr, "cooperative launch failed: %s (grid %d)\n", hipGetErrorString(e), grid);
#endif
}
```
